# Optimizing an MI355X kernel written in HIP

```python
import math
import jax, jax.numpy as jnp
from jax import lax
import numpy as np

D_MODEL = 1024
BATCH = 2
SEQ = 16384
DEPTH = 1

N_MEM = 256

NSA_WIDTH = D_MODEL // 2
HG_WIDTH = D_MODEL - NSA_WIDTH

NSA_HEAD_DIM = 64
NSA_HEADS = NSA_WIDTH // NSA_HEAD_DIM
NSA_KV_GROUPS = 2
NSA_HPG = NSA_HEADS // NSA_KV_GROUPS
CMP_BLOCK = 32
CMP_STRIDE = 16
CMP_HIDDEN = 256
SEL_BLOCK = 64
SEL_TOP_N = 16
WINDOW = 512
Q_BLOCK = 128
FORCE_BONUS = 1.0e4

HG_KEY_DIM = 128
HG_VAL_DIM = 128
HG_HEADS = HG_WIDTH // HG_VAL_DIM
HG_CHUNK = 64

XA_HEADS = 4
XA_HEAD_DIM = D_MODEL // XA_HEADS

MOE_GROUPS = 4
MOE_EXPERTS_PER_GROUP = 8
MOE_N_EXPERTS = MOE_GROUPS * MOE_EXPERTS_PER_GROUP
MOE_TOP_K = 2
MOE_D_FF = 512
MOE_BLOCK = 128

DEEPNORM_ALPHA = (2.0 * DEPTH) ** 0.25
DEEPNORM_BETA = (8.0 * DEPTH) ** -0.25

LN_EPS = 1e-5
RMS_EPS = 1e-6
NEG_INF = -1e30

NSA_Q_COLS = NSA_HEADS * NSA_HEAD_DIM
NSA_KV_COLS = NSA_KV_GROUPS * NSA_HEAD_DIM
NSA_GATE_COLS = NSA_HEADS * 3
HG_QF_COLS = HG_HEADS * HG_KEY_DIM
HG_IV_COLS = HG_HEADS * HG_VAL_DIM
IN_SPLITS = (NSA_Q_COLS, NSA_KV_COLS, NSA_KV_COLS, NSA_KV_COLS, NSA_KV_COLS, NSA_KV_COLS, NSA_KV_COLS,
             NSA_GATE_COLS, HG_QF_COLS, HG_QF_COLS, HG_IV_COLS, HG_IV_COLS)
VALUE_SPLITS = (False, False, True, False, True, False, True, False, False, False, True, False)
IN_COLS = NSA_Q_COLS + 6 * NSA_KV_COLS + NSA_GATE_COLS + 2 * HG_QF_COLS + 2 * HG_IV_COLS

kernel_name = "hybrid_nsa_hgrn2_hmoe_layer"


def layer_norm(x, g, b):
    xf = x.astype(jnp.float32)
    mu = jnp.mean(xf, axis=-1, keepdims=True)
    var = jnp.mean(jnp.square(xf - mu), axis=-1, keepdims=True)
    return ((xf - mu) * lax.rsqrt(var + LN_EPS) * g + b).astype(x.dtype)


def rms_norm(x, g):
    xf = x.astype(jnp.float32)
    return xf * lax.rsqrt(jnp.mean(xf * xf, axis=-1, keepdims=True) + RMS_EPS) * g


def masked_softmax(s, mask):
    s = jnp.where(mask, s.astype(jnp.float32), NEG_INF)
    p = jax.nn.softmax(s, axis=-1)
    return jnp.where(mask, p, 0.0)


def split_cols(h):
    offs = np.cumsum((0,) + IN_SPLITS)
    return [h[..., int(offs[i]):int(offs[i + 1])] for i in range(len(IN_SPLITS))]


def nsa_compress(k, pe, w1, w2):
    b, s, g, d = k.shape
    n_sub = CMP_BLOCK // CMP_STRIDE
    n_ch = s // CMP_STRIDE
    ncmp = n_ch - n_sub + 1
    ch = k.reshape(b, n_ch, CMP_STRIDE, g, d)
    blocks = jnp.concatenate([ch[:, i:i + ncmp] for i in range(n_sub)], axis=2)
    blocks = blocks + pe[None, None, :, None, :]
    blocks = jnp.moveaxis(blocks, 3, 1).reshape(b, g, ncmp, CMP_BLOCK * d)
    return jax.nn.gelu(blocks @ w1) @ w2


def cmp_to_sel(p, n_sel):
    n_sub = CMP_BLOCK // CMP_STRIDE
    r = SEL_BLOCK // CMP_STRIDE
    ncmp = p.shape[-1]
    pp = jnp.pad(p, [(0, 0)] * (p.ndim - 1) + [(n_sub - 1, r * n_sel - ncmp)])
    return sum(pp[..., m:m + r * n_sel:r] for m in range(r + n_sub - 1))


def nsa_attention(q, kc, vc, ks, vs, kw, vw, gates):
    b, h, s, d = q.shape
    g = NSA_KV_GROUPS
    ncmp = kc.shape[2]
    n_sel = s // SEL_BLOCK
    top_n = min(SEL_TOP_N, n_sel)
    scale = d ** -0.5
    kw_pad = jnp.pad(kw, ((0, 0), (0, 0), (WINDOW, 0), (0, 0)))
    vw_pad = jnp.pad(vw, ((0, 0), (0, 0), (WINDOW, 0), (0, 0)))
    cmp_end = jnp.arange(ncmp) * CMP_STRIDE + CMP_BLOCK - 1
    blk_ids = jnp.arange(n_sel)
    bi = jnp.arange(b)[:, None, None, None]
    gi = jnp.arange(g)[None, :, None, None]
    offs = jnp.arange(SEL_BLOCK)

    def one_block(qb):
        s0 = qb * Q_BLOCK
        t = s0 + jnp.arange(Q_BLOCK)
        qq = lax.dynamic_slice_in_dim(q, s0, Q_BLOCK, axis=2)
        qq = qq.reshape(b, g, NSA_HPG, Q_BLOCK, d) * scale
        sc = jnp.einsum('bgrtd,bgnd->bgrtn', qq, kc)
        pc = masked_softmax(sc, cmp_end[None, :] <= t[:, None])
        o_c = jnp.einsum('bgrtn,bgnd->bgrtd', pc.astype(vc.dtype), vc)
        imp = cmp_to_sel(jnp.sum(pc, axis=2), n_sel)
        cur = t // SEL_BLOCK
        valid = blk_ids[None, :] <= cur[:, None]
        forced = ((blk_ids[None, :] == 0) | (blk_ids[None, :] == cur[:, None])
                  | (blk_ids[None, :] == cur[:, None] - 1))
        score = jnp.where(valid, imp + jnp.where(forced, FORCE_BONUS, 0.0), -1.0)
        _, idx = lax.top_k(score, top_n)
        pos = (idx[..., None] * SEL_BLOCK + offs).reshape(b, g, Q_BLOCK, top_n * SEL_BLOCK)
        k_sel = ks[bi, gi, pos]
        v_sel = vs[bi, gi, pos]
        ss = jnp.einsum('bgrtd,bgtkd->bgrtk', qq, k_sel)
        ps = masked_softmax(ss, (pos <= t[None, None, :, None])[:, :, None])
        o_s = jnp.einsum('bgrtk,bgtkd->bgrtd', ps.astype(v_sel.dtype), v_sel)
        kwb = lax.dynamic_slice_in_dim(kw_pad, s0, WINDOW + Q_BLOCK, axis=2)
        vwb = lax.dynamic_slice_in_dim(vw_pad, s0, WINDOW + Q_BLOCK, axis=2)
        kpos = s0 - WINDOW + jnp.arange(WINDOW + Q_BLOCK)
        m_w = ((kpos[None, :] <= t[:, None]) & (kpos[None, :] > t[:, None] - WINDOW)
               & (kpos[None, :] >= 0))
        sw = jnp.einsum('bgrtd,bgkd->bgrtk', qq, kwb)
        pw = masked_softmax(sw, m_w)
        o_w = jnp.einsum('bgrtk,bgkd->bgrtd', pw.astype(vwb.dtype), vwb)
        gb = lax.dynamic_slice_in_dim(gates, s0, Q_BLOCK, axis=2).reshape(b, g, NSA_HPG, Q_BLOCK, 3)
        o = gb[..., 0:1] * o_c + gb[..., 1:2] * o_s + gb[..., 2:3] * o_w
        return o.reshape(b, h, Q_BLOCK, d)

    out = lax.map(one_block, jnp.arange(s // Q_BLOCK))
    return jnp.transpose(out, (1, 0, 3, 2, 4)).reshape(b, s, h * d)


def hgrn2_recurrence(q, f_logit, i, lb):
    b, s, h, dk = q.shape
    dv = i.shape[-1]
    lb = lb.reshape(h, dk)
    log_f = jnp.logaddexp(jnp.log(lb), jnp.log1p(-lb) + jax.nn.log_sigmoid(f_logit.astype(jnp.float32)))
    k = -jnp.expm1(log_f)
    nc = s // HG_CHUNK

    def to_chunks(a):
        return jnp.transpose(a.astype(jnp.float32).reshape(b, nc, HG_CHUNK, h, a.shape[-1]), (1, 0, 3, 2, 4))

    qc, kc, vc, lc = to_chunks(q), to_chunks(k), to_chunks(i), to_chunks(log_f)
    bc = jnp.cumsum(lc, axis=3)
    causal = jnp.tril(jnp.ones((HG_CHUNK, HG_CHUNK), dtype=bool))

    def step(state, xs):
        qt, kt, vt, bt = xs
        inter = jnp.einsum('bhtk,bhkv->bhtv', qt * jnp.exp(bt), state)
        diff = bt[:, :, :, None, :] - bt[:, :, None, :, :]
        decay = jnp.where(causal[:, :, None], jnp.exp(jnp.minimum(diff, 0.0)), 0.0)
        att = jnp.einsum('bhtk,bhsk,bhtsk->bhts', qt, kt, decay)
        intra = jnp.einsum('bhts,bhsv->bhtv', att, vt)
        b_last = bt[:, :, -1:, :]
        new_state = (jnp.exp(b_last[:, :, 0, :])[..., None] * state
                     + jnp.einsum('bhsk,bhsv->bhkv', kt * jnp.exp(b_last - bt), vt))
        return new_state, inter + intra

    s_init = jnp.zeros((b, h, dk, dv), jnp.float32)
    _, o = lax.scan(step, s_init, (qc, kc, vc, bc))
    return jnp.transpose(o, (1, 0, 3, 2, 4)).reshape(b, s, h, dv)


def memory_cross_attention(x, mem, wq, wk, wv, wo):
    b, s, d = x.shape
    m = mem.shape[1]
    q = (x @ wq).reshape(b, s, XA_HEADS, XA_HEAD_DIM)
    k = (mem @ wk).reshape(b, m, XA_HEADS, XA_HEAD_DIM)
    v = (mem @ wv).reshape(b, m, XA_HEADS, XA_HEAD_DIM)
    sc = jnp.einsum('bshd,bmhd->bhsm', q, k).astype(jnp.float32) * (XA_HEAD_DIM ** -0.5)
    p = jax.nn.softmax(sc, axis=-1).astype(v.dtype)
    o = jnp.einsum('bhsm,bmhd->bshd', p, v).reshape(b, s, d)
    return o @ wo


def hierarchical_moe(x, w_group, b_group, w_expert, b_expert, w_gate, w_up, w_down):
    b, s, d = x.shape
    xt = x.reshape(-1, d)
    n_tok = xt.shape[0]
    g_prob = jax.nn.softmax((xt @ w_group + b_group).astype(jnp.float32), axis=-1)
    g_w, g_idx = lax.top_k(g_prob, 1)
    e_logits = (xt @ w_expert + b_expert).astype(jnp.float32).reshape(n_tok, MOE_GROUPS, MOE_EXPERTS_PER_GROUP)
    e_logits = e_logits[jnp.arange(n_tok), g_idx[:, 0]]
    top_p, top_i = lax.top_k(jax.nn.softmax(e_logits, axis=-1), MOE_TOP_K)
    top_p = top_p / jnp.sum(top_p, axis=-1, keepdims=True)
    weights = (g_w * top_p).reshape(-1)
    experts = (g_idx * MOE_EXPERTS_PER_GROUP + top_i).reshape(-1)
    tokens = jnp.repeat(jnp.arange(n_tok, dtype=jnp.int32), MOE_TOP_K)
    n_assign = n_tok * MOE_TOP_K
    order = jnp.argsort(experts)
    e_sorted, tok_sorted, w_sorted = experts[order], tokens[order], weights[order]
    counts = jnp.bincount(experts, length=MOE_N_EXPERTS)
    padded = ((counts + MOE_BLOCK - 1) // MOE_BLOCK) * MOE_BLOCK
    start = jnp.cumsum(counts) - counts
    pend = jnp.cumsum(padded)
    pstart = pend - padded
    dest = pstart[e_sorted] + (jnp.arange(n_assign) - start[e_sorted])
    cap = n_assign + MOE_N_EXPERTS * MOE_BLOCK
    n_blocks = cap // MOE_BLOCK
    slot_tok = jnp.full((cap,), n_tok, jnp.int32).at[dest].set(tok_sorted)
    slot_w = jnp.zeros((cap,), jnp.float32).at[dest].set(w_sorted)
    block_expert = jnp.minimum(jnp.searchsorted(pend, jnp.arange(n_blocks) * MOE_BLOCK, side='right'),
                               MOE_N_EXPERTS - 1)
    x_pad = jnp.concatenate([xt, jnp.zeros((1, d), xt.dtype)], axis=0)
    xb = x_pad[slot_tok].reshape(n_blocks, MOE_BLOCK, d)

    def run_block(args):
        xblk, e = args
        hid = jax.nn.silu(xblk @ w_gate[e]) * (xblk @ w_up[e])
        return hid @ w_down[e]

    yb = lax.map(run_block, (xb, block_expert)).reshape(cap, d)
    y = yb * slot_w[:, None].astype(yb.dtype)
    out = jax.ops.segment_sum(y, slot_tok, num_segments=n_tok + 1)[:n_tok]
    return out.reshape(b, s, d)


def setup_inputs(seed: int = 0) -> dict:
    key = jax.random.key(seed)
    ks = jax.random.split(key, 32)
    f32 = jnp.float32
    nrm = lambda k, shape, sc: jax.random.normal(k, shape, f32) * sc
    beta = DEEPNORM_BETA
    col_scale = jnp.concatenate([jnp.full((n,), beta if v else 1.0, f32) for n, v in zip(IN_SPLITS, VALUE_SPLITS)])
    ln_g = lambda k: 1.0 + nrm(k, (DEPTH, D_MODEL), 0.02)
    ln_b = lambda k: nrm(k, (DEPTH, D_MODEL), 0.02)
    return {
        "x": nrm(ks[0], (BATCH, SEQ, D_MODEL), 1.0),
        "mem": nrm(ks[1], (BATCH, N_MEM, D_MODEL), 1.0),
        "w_in": nrm(ks[2], (DEPTH, D_MODEL, IN_COLS), D_MODEL ** -0.5) * col_scale,
        "cmp_pe_k": nrm(ks[3], (DEPTH, CMP_BLOCK, NSA_HEAD_DIM), 0.1),
        "cmp_pe_v": nrm(ks[4], (DEPTH, CMP_BLOCK, NSA_HEAD_DIM), 0.1),
        "cmp_w1_k": nrm(ks[5], (DEPTH, CMP_BLOCK * NSA_HEAD_DIM, CMP_HIDDEN), (CMP_BLOCK * NSA_HEAD_DIM) ** -0.5),
        "cmp_w2_k": nrm(ks[6], (DEPTH, CMP_HIDDEN, NSA_HEAD_DIM), CMP_HIDDEN ** -0.5),
        "cmp_w1_v": nrm(ks[7], (DEPTH, CMP_BLOCK * NSA_HEAD_DIM, CMP_HIDDEN), (CMP_BLOCK * NSA_HEAD_DIM) ** -0.5),
        "cmp_w2_v": nrm(ks[8], (DEPTH, CMP_HIDDEN, NSA_HEAD_DIM), CMP_HIDDEN ** -0.5),
        "nsa_norm_g": 1.0 + nrm(ks[9], (DEPTH, NSA_WIDTH), 0.02),
        "hg_lb_logits": nrm(ks[10], (DEPTH + 1, HG_HEADS * HG_KEY_DIM), 0.5),
        "hg_norm_g": 1.0 + nrm(ks[11], (DEPTH, HG_VAL_DIM), 0.02),
        "w_out": nrm(ks[12], (DEPTH, D_MODEL, D_MODEL), D_MODEL ** -0.5 * beta),
        "ln1_g": ln_g(ks[13]),
        "ln1_b": ln_b(ks[14]),
        "xa_wq": nrm(ks[15], (DEPTH, D_MODEL, D_MODEL), D_MODEL ** -0.5),
        "xa_wk": nrm(ks[16], (DEPTH, D_MODEL, D_MODEL), D_MODEL ** -0.5),
        "xa_wv": nrm(ks[17], (DEPTH, D_MODEL, D_MODEL), D_MODEL ** -0.5 * beta),
        "xa_wo": nrm(ks[18], (DEPTH, D_MODEL, D_MODEL), D_MODEL ** -0.5 * beta),
        "ln2_g": ln_g(ks[19]),
        "ln2_b": ln_b(ks[20]),
        "moe_w_group": nrm(ks[21], (DEPTH, D_MODEL, MOE_GROUPS), D_MODEL ** -0.5),
        "moe_b_group": nrm(ks[22], (DEPTH, MOE_GROUPS), 0.01),
        "moe_w_expert": nrm(ks[23], (DEPTH, D_MODEL, MOE_N_EXPERTS), D_MODEL ** -0.5),
        "moe_b_expert": nrm(ks[24], (DEPTH, MOE_N_EXPERTS), 0.01),
        "moe_w_gate": nrm(ks[25], (DEPTH, MOE_N_EXPERTS, D_MODEL, MOE_D_FF), D_MODEL ** -0.5),
        "moe_w_up": nrm(ks[26], (DEPTH, MOE_N_EXPERTS, D_MODEL, MOE_D_FF), D_MODEL ** -0.5 * beta),
        "moe_w_down": nrm(ks[27], (DEPTH, MOE_N_EXPERTS, MOE_D_FF, D_MODEL), MOE_D_FF ** -0.5 * beta),
        "ln3_g": ln_g(ks[28]),
        "ln3_b": ln_b(ks[29]),
    }


def reference(x, mem, w_in, cmp_pe_k, cmp_pe_v, cmp_w1_k, cmp_w2_k, cmp_w1_v, cmp_w2_v, nsa_norm_g,
              hg_lb_logits, hg_norm_g, w_out, ln1_g, ln1_b, xa_wq, xa_wk, xa_wv, xa_wo, ln2_g, ln2_b,
              moe_w_group, moe_b_group, moe_w_expert, moe_b_expert, moe_w_gate, moe_w_up, moe_w_down,
              ln3_g, ln3_b):
    b, s, _ = x.shape
    lb_all = jnp.cumsum(jax.nn.softmax(hg_lb_logits.astype(jnp.float32), axis=0), axis=0)
    for l in range(DEPTH):
        h = x @ w_in[l]
        (nq, nkc, nvc, nks, nvs, nkw, nvw, ngate, hq, hf, hi, hgate) = split_cols(h)
        kv = lambda a: a.reshape(b, s, NSA_KV_GROUPS, NSA_HEAD_DIM)
        kc = nsa_compress(kv(nkc), cmp_pe_k[l], cmp_w1_k[l], cmp_w2_k[l])
        vc = nsa_compress(kv(nvc), cmp_pe_v[l], cmp_w1_v[l], cmp_w2_v[l])
        tr = lambda a: jnp.transpose(kv(a), (0, 2, 1, 3))
        q_nsa = jnp.transpose(nq.reshape(b, s, NSA_HEADS, NSA_HEAD_DIM), (0, 2, 1, 3))
        gates = jnp.transpose(jax.nn.sigmoid(ngate.reshape(b, s, NSA_HEADS, 3)), (0, 2, 1, 3))
        o_nsa = nsa_attention(q_nsa, kc, vc, tr(nks), tr(nvs), tr(nkw), tr(nvw), gates)
        o_nsa = rms_norm(o_nsa, nsa_norm_g[l])
        o_hg = hgrn2_recurrence(hq.reshape(b, s, HG_HEADS, HG_KEY_DIM),
                                hf.reshape(b, s, HG_HEADS, HG_KEY_DIM),
                                hi.reshape(b, s, HG_HEADS, HG_VAL_DIM), lb_all[l])
        o_hg = rms_norm(o_hg, hg_norm_g[l]) * jax.nn.silu(
            hgate.reshape(b, s, HG_HEADS, HG_VAL_DIM).astype(jnp.float32))
        o_hg = o_hg.reshape(b, s, HG_WIDTH)
        mix = jnp.concatenate([o_nsa.astype(x.dtype), o_hg.astype(x.dtype)], axis=-1) @ w_out[l]
        x = layer_norm(DEEPNORM_ALPHA * x + mix, ln1_g[l], ln1_b[l])
        xa = memory_cross_attention(x, mem, xa_wq[l], xa_wk[l], xa_wv[l], xa_wo[l])
        x = layer_norm(DEEPNORM_ALPHA * x + xa, ln2_g[l], ln2_b[l])
        ff = hierarchical_moe(x, moe_w_group[l], moe_b_group[l], moe_w_expert[l], moe_b_expert[l],
                              moe_w_gate[l], moe_w_up[l], moe_w_down[l])
        x = layer_norm(DEEPNORM_ALPHA * x + ff, ln3_g[l], ln3_b[l])
    return x
```

```cpp
#include <hip/hip_runtime.h>
#include <hip/hip_cooperative_groups.h>
#include <cstdio>
#include <cstdint>
namespace cg = cooperative_groups;

#define LAS __attribute__((address_space(3)))
typedef unsigned short bf16_t;
typedef short bf16x8 __attribute__((ext_vector_type(8)));
typedef short s16x4 __attribute__((ext_vector_type(4)));
typedef float f32x2 __attribute__((ext_vector_type(2)));
typedef float f32x4 __attribute__((ext_vector_type(4)));
typedef float f32x16 __attribute__((ext_vector_type(16)));
typedef unsigned u32x2 __attribute__((ext_vector_type(2)));
typedef unsigned u32x4 __attribute__((ext_vector_type(4)));
typedef __bf16 bf16x2_t __attribute__((ext_vector_type(2)));

constexpr int NB = 2, SEQ = 16384, NTOK = NB * SEQ, DM = 1024;
constexpr int NIN = 3584;
constexpr int NSELB = SEQ / 64;
constexpr int MOE_E = 32, MOE_FF = 512, MOE_CAP = 73728;
constexpr float ALPHA = 1.189207115002721f;
constexpr float QSCALE = 0.125f * 1.4426950408889634f;
constexpr float XSCALE = 0.0625f * 1.4426950408889634f;

constexpr size_t MiB = 1u << 20;
constexpr size_t WS_CTL = 0;
constexpr size_t WS_WIN = 1 * MiB;
constexpr size_t WS_WOUT = 8 * MiB, WS_WQ = 10 * MiB, WS_WK = 12 * MiB, WS_WV = 14 * MiB, WS_WO = 16 * MiB;
constexpr size_t WS_W1K = 18 * MiB, WS_W1V = 19 * MiB;
constexpr size_t WS_SMALL = 20 * MiB;
constexpr size_t WS_W2K = WS_SMALL, WS_W2V = WS_SMALL + 32768;
constexpr size_t WS_BIASK = WS_SMALL + 65536, WS_BIASV = WS_BIASK + 1024;
constexpr size_t WS_LB = WS_BIASV + 1024;
constexpr size_t WS_WRH = WS_SMALL + 512 * 1024, WS_WRL = WS_WRH + 128 * 1024;
constexpr size_t WS_QCS = WS_SMALL + 256 * 1024, WS_QBQ = WS_QCS + 4096;
constexpr size_t WS_MEMB = 21 * MiB;
constexpr size_t WS_MEMK = 22 * MiB, WS_MEMV = 23 * MiB;
constexpr size_t WS_RA = 24 * MiB;
constexpr size_t WS_RB = 88 * MiB;
constexpr size_t WS_RC = 152 * MiB;
constexpr size_t WS_RD = 296 * MiB;
constexpr size_t WS_RE = 400 * MiB;
constexpr size_t WS_QN = WS_RC;
constexpr size_t WS_KS = WS_RC + 32 * MiB, WS_VS = WS_KS + 8 * MiB, WS_KW = WS_VS + 8 * MiB, WS_VW = WS_KW + 8 * MiB;
constexpr size_t WS_HQ = WS_RC + 64 * MiB;
constexpr size_t WS_HI = WS_RC + 96 * MiB;
constexpr size_t WS_KCIN = WS_RC + 128 * MiB, WS_VCIN = WS_RC + 136 * MiB;
constexpr size_t WS_PRE = WS_RC;
constexpr size_t WS_XG = WS_RC;
constexpr size_t WS_LOGF = WS_RD;
constexpr size_t WS_HGS = WS_RD + 64 * MiB;
constexpr size_t WS_GATE = WS_RD + 96 * MiB;
constexpr size_t WS_HID = WS_RD + 99 * MiB;
constexpr size_t WS_KC = WS_RD + 103 * MiB, WS_VC = WS_KC + 512 * 1024;
constexpr size_t WS_HIDM = WS_RD;
constexpr size_t WS_WGU = WS_RE;
constexpr size_t WS_WD = WS_RE + 64 * MiB;
constexpr int CW_Q2 = 64, CW_Q4 = 128, CW_Q4B = 192;
constexpr int CW_ECNT = 2048;
constexpr int CW_BAR = 8192;
constexpr int CW_TILECNT = 1024;
constexpr size_t WS_HD = 496 * MiB;
constexpr size_t WS_ROUTE = 497 * MiB;
constexpr size_t WS_ROUTEW = WS_ROUTE + 512 * 1024;
constexpr size_t WS_TOKSLOT = WS_ROUTEW + 256 * 1024;
constexpr size_t WS_SLOTW = 498 * MiB;
constexpr size_t WS_STAT1 = 499 * MiB, WS_STAT2 = WS_STAT1 + 256 * 1024;
constexpr size_t WS_TOTAL = 507 * MiB;

__device__ __forceinline__ unsigned cvtpk(float lo, float hi) { f32x2 v = {lo, hi}; bf16x2_t b = __builtin_convertvector(v, bf16x2_t); return __builtin_bit_cast(unsigned, b); }
__device__ __forceinline__ float bf2f(unsigned short h) { return __uint_as_float((unsigned)h << 16); }
__device__ __forceinline__ float bflo(unsigned w) { return __uint_as_float(w << 16); }
__device__ __forceinline__ float bfhi(unsigned w) { return __uint_as_float(w & 0xffff0000u); }
__device__ __forceinline__ unsigned short f2bf(float f) { return (unsigned short)(cvtpk(f, 0.f) & 0xffffu); }
#define DPPADDW_(v, ctrl, rm) v += __int_as_float(__builtin_amdgcn_update_dpp(0, __float_as_int(v), ctrl, rm, 0xF, true))
__device__ __forceinline__ float wave_sum(float v) {
    DPPADDW_(v, 0x111, 0xF); DPPADDW_(v, 0x112, 0xF); DPPADDW_(v, 0x114, 0xF); DPPADDW_(v, 0x118, 0xF); DPPADDW_(v, 0x142, 0xA); DPPADDW_(v, 0x143, 0xC);
    return __int_as_float(__builtin_amdgcn_readlane(__float_as_int(v), 63));
}
__device__ __forceinline__ float fast_exp2(float x) { return __builtin_amdgcn_exp2f(x); }
__device__ __forceinline__ float sigmoidf_(float z) { return __builtin_amdgcn_rcpf(1.0f + __expf(-z)); }
namespace pg8 {
constexpr int BM = 256, BK = 64, HALF = 128, HTB = HALF * BK * 2, STAGE_BYTES = 8 * HTB;
__device__ __forceinline__ int lds_byte(int r, int c) { const int st = (r >> 4) * 2 + (c >> 5), rr = r & 15, cc = c & 31, ob = rr * 64 + cc * 2; return st * 1024 + (ob ^ (((ob >> 9) & 1) << 5)); }
__device__ __forceinline__ void stage_rc(int b, int& R, int& C) { const int st = b / 1024, sb = b % 1024, swz = sb ^ (((sb >> 9) & 1) << 5); R = (st >> 1) * 16 + swz / 64; C = (st & 1) * 32 + (swz % 64) / 2; }
__device__ __forceinline__ int perm32(int rho) { const int n = rho >> 4, i = rho & 15; return 8 * (i >> 2) + 4 * n + (i & 3); }

struct Unit { const char* a; const char* b; int pm, pn, aux; };

template <class Epi, class Sched>
__device__ __forceinline__ void gemm_phase(LAS unsigned char* lds, const int K, const int lda, const int ldb, const Sched& S, const Epi& E) {
    const int tid = threadIdx.x, wid = __builtin_amdgcn_readfirstlane(tid >> 6), lane = tid & 63, wr = wid >> 2, wc = wid & 3, fr = lane & 15, fq = lane >> 4;
    const int nt = K / BK;
    unsigned voffA[2], voffB[2];
#pragma unroll
    for (int i = 0; i < 2; ++i) { int R, C; stage_rc(tid * 16 + i * 8192, R, C); const int Rb = Epi::PERM ? ((R & ~31) + perm32(R & 31)) : R;
        voffA[i] = (unsigned)(R * lda + C) * 2u; voffB[i] = (unsigned)(Rb * ldb + C) * 2u; }
    const size_t kstep = (size_t)(BK * 2);
    const size_t hstepA = (size_t)HALF * lda * 2, hstepB = (size_t)HALF * ldb * 2;
    const unsigned ldsw = (unsigned)wid * 1024u;
    const int aoff = lds_byte(wr * 64 + fr, fq * 8), boff = lds_byte(wc * 32 + fr, fq * 8);
#define PG8_SA(b, h) (((b) * 2 + (h)) * HTB)
#define PG8_SB(b, h) ((4 + (b) * 2 + (h)) * HTB)
#define PG8_STAGE(bufoff, gbase, voff) do { _Pragma("unroll") for (int _i = 0; _i < 2; ++_i) \
        __builtin_amdgcn_global_load_lds((const unsigned*)((const char*)(gbase) + (voff)[_i]), (LAS unsigned*)(lds + (bufoff) + ldsw + _i * 8192), 16, 0, 0); } while (0)
#define PG8_LDA(dst, b, h) do { _Pragma("unroll") for (int m = 0; m < 4; ++m) _Pragma("unroll") for (int k = 0; k < 2; ++k) dst[m][k] = *(const LAS bf16x8*)(lds + PG8_SA(b, h) + aoff + m * 2048 + k * 1024); } while (0)
#define PG8_LDB(dst, b, h) do { _Pragma("unroll") for (int n = 0; n < 2; ++n) _Pragma("unroll") for (int k = 0; k < 2; ++k) dst[n][k] = *(const LAS bf16x8*)(lds + PG8_SB(b, h) + boff + n * 2048 + k * 1024); } while (0)
#define PG8_MMA(ai, bj, At, Bt) do { __builtin_amdgcn_s_setprio(1); _Pragma("unroll") for (int m = 0; m < 4; ++m) _Pragma("unroll") for (int n = 0; n < 2; ++n) _Pragma("unroll") for (int k = 0; k < 2; ++k) \
        acc[ai][bj][m][n] = __builtin_amdgcn_mfma_f32_16x16x32_bf16(Bt[n][k], At[m][k], acc[ai][bj][m][n], 0, 0, 0); __builtin_amdgcn_s_setprio(0); } while (0)
#define PG8_WAIT_V(n) asm volatile("s_waitcnt vmcnt(" #n ")" ::: "memory")
#define PG8_WAIT_L(n) asm volatile("s_waitcnt lgkmcnt(" #n ")" ::: "memory")
#define PG8_BAR __builtin_amdgcn_s_barrier()
#define PG8_SCHED __builtin_amdgcn_sched_barrier(0)
    Unit cur, nxt; int ui = 0;
    if (!S.next(0, cur)) return;
    f32x4 acc[2][2][4][2];
#pragma unroll
    for (int a = 0; a < 2; ++a)
#pragma unroll
        for (int b = 0; b < 2; ++b)
#pragma unroll
            for (int m = 0; m < 4; ++m)
#pragma unroll
                for (int n = 0; n < 2; ++n) acc[a][b][m][n] = (f32x4){0.f, 0.f, 0.f, 0.f};
    bf16x8 At[4][2], B0[2][2], B1[2][2];
    const char* cA = cur.a; const char* cB = cur.b;
    PG8_STAGE(PG8_SB(0, 0), cB, voffB); PG8_STAGE(PG8_SB(0, 1), cB + hstepB, voffB); PG8_STAGE(PG8_SA(0, 0), cA, voffA); PG8_STAGE(PG8_SA(0, 1), cA + hstepA, voffA);
    if (wr == 1) PG8_BAR;
    PG8_WAIT_V(2); PG8_BAR;
    PG8_STAGE(PG8_SB(1, 0), cB + kstep, voffB); PG8_STAGE(PG8_SA(1, 0), cA + kstep, voffA); PG8_STAGE(PG8_SB(1, 1), cB + hstepB + kstep, voffB);
    PG8_WAIT_V(6); PG8_BAR;
    for (;;) {
        const bool has_next = S.next(ui + 1, nxt);
        const char* nA = has_next ? nxt.a : cA; const char* nB = has_next ? nxt.b : cB;
        for (int t = 0; t < nt; t += 2) {
            const bool last = (t == nt - 2);
            const char* a1 = cA + (size_t)(t + 1) * kstep;
            const char* a2 = last ? nA : cA + (size_t)(t + 2) * kstep; const char* b2 = last ? nB : cB + (size_t)(t + 2) * kstep;
            const char* a3 = a2 + kstep; const char* b3 = b2 + kstep;
            PG8_LDB(B0, 0, 0); PG8_LDB(B1, 0, 1); PG8_SCHED; PG8_LDA(At, 0, 0); PG8_STAGE(PG8_SA(1, 1), a1 + hstepA, voffA);
            PG8_WAIT_V(8); PG8_WAIT_L(0); PG8_BAR; PG8_MMA(0, 0, At, B0); PG8_MMA(0, 1, At, B1); PG8_BAR; PG8_SCHED;
            PG8_LDA(At, 0, 1); PG8_STAGE(PG8_SB(0, 0), b2, voffB); PG8_STAGE(PG8_SB(0, 1), b2 + hstepB, voffB); PG8_STAGE(PG8_SA(0, 0), a2, voffA);
            PG8_WAIT_V(8); PG8_WAIT_L(0); PG8_BAR; PG8_MMA(1, 0, At, B0); PG8_MMA(1, 1, At, B1); PG8_BAR; PG8_SCHED;
            PG8_LDB(B0, 1, 0); PG8_LDB(B1, 1, 1); PG8_SCHED; PG8_LDA(At, 1, 0); PG8_STAGE(PG8_SA(0, 1), a2 + hstepA, voffA);
            PG8_WAIT_V(8); PG8_WAIT_L(0); PG8_BAR; PG8_MMA(0, 0, At, B0); PG8_MMA(0, 1, At, B1); PG8_BAR; PG8_SCHED;
            PG8_LDA(At, 1, 1); PG8_STAGE(PG8_SB(1, 0), b3, voffB); PG8_STAGE(PG8_SB(1, 1), b3 + hstepB, voffB); PG8_STAGE(PG8_SA(1, 0), a3, voffA);
            PG8_WAIT_V(8); PG8_WAIT_L(0); PG8_BAR; PG8_MMA(1, 0, At, B0); PG8_MMA(1, 1, At, B1); PG8_BAR; PG8_SCHED;
        }
        if (wr == 0) PG8_BAR;
        E(acc, cur, wr, wc, fr, fq);
        if (!has_next) break;
#pragma unroll
        for (int a = 0; a < 2; ++a)
#pragma unroll
            for (int b = 0; b < 2; ++b)
#pragma unroll
                for (int m = 0; m < 4; ++m)
#pragma unroll
                    for (int n = 0; n < 2; ++n) acc[a][b][m][n] = (f32x4){0.f, 0.f, 0.f, 0.f};
        cur = nxt; cA = nA; cB = nB; ++ui;
        if (wr == 1) PG8_BAR;
    }
    PG8_WAIT_V(0);
    PG8_BAR;
#undef PG8_SA
#undef PG8_SB
#undef PG8_STAGE
#undef PG8_LDA
#undef PG8_LDB
#undef PG8_MMA
#undef PG8_WAIT_V
#undef PG8_WAIT_L
#undef PG8_BAR
#undef PG8_SCHED
}

struct GridOrder {
    const char* A; const char* Bt; size_t atile, btile; int nM, nN, nwg, G, c;
    __device__ __forceinline__ bool next(int i, Unit& u) const {
        const long L = (long)i * G + c; if (L >= nwg) return false;
        int wgid = (int)L; { const int q = nwg / 8, r = nwg % 8, xcd = wgid % 8, off = wgid / 8; wgid = (xcd < r ? xcd * (q + 1) : r * (q + 1) + (xcd - r) * q) + off; }
        const int nig = 8 * nN, gid = wgid / nig, fm = gid * 8, gsz = (nM - fm) < 8 ? (nM - fm) : 8;
        u.pm = fm + ((wgid % nig) % gsz); u.pn = (wgid % nig) / gsz; u.aux = 0;
        u.a = A + (size_t)u.pm * atile; u.b = Bt + (size_t)u.pn * btile; return true;
    }
};
}
__device__ __forceinline__ float gelu_tanh(float x) {
    const float u = 0.7978845608028654f * (x + 0.044715f * x * x * x);
    const float e = __expf(2.0f * u);
    const float th = 1.0f - 2.0f * __builtin_amdgcn_rcpf(1.0f + e);
    return 0.5f * x * (1.0f + th);
}
__device__ __forceinline__ float silu_(float z) { return z * __builtin_amdgcn_rcpf(1.0f + __expf(-z)); }
__device__ __forceinline__ u32x4 pack8(const f32x4 a, const f32x4 b) { u32x4 w; w.x = cvtpk(a[0], a[1]); w.y = cvtpk(a[2], a[3]); w.z = cvtpk(b[0], b[1]); w.w = cvtpk(b[2], b[3]); return w; }

__device__ __forceinline__ int kimg_off(int key, int dim) { return (dim >> 3) * 1024 + key * 16; }
__device__ __forceinline__ int vimg_off(int key, int dim) { return (dim >> 5) * 4096 + ((key >> 4) & 3) * 1024 + ((key >> 3) & 1) * 512 + (key & 7) * 64 + (dim & 31) * 2; }

__device__ __forceinline__ int kf_off(int key, int dim) { return ((((key >> 4) * 2 + (dim >> 5)) * 64 + (key & 15) + 16 * ((dim >> 3) & 3)) * 16) + (dim & 7) * 2; }
__device__ __forceinline__ int vf_off(int key, int dim) { return ((((dim >> 4) * 2 + (key >> 5)) * 64 + (dim & 15) + 16 * ((key >> 2) & 3)) * 16) + (((key >> 4) & 1) * 4 + (key & 3)) * 2; }
__device__ __forceinline__ void vf_store8(unsigned char* img, int key, int dim, const u32x4 w) {
    unsigned char* p = img + vf_off(key, dim);
    *(bf16_t*)(p) = (bf16_t)(w.x & 0xffffu); *(bf16_t*)(p + 16) = (bf16_t)(w.x >> 16); *(bf16_t*)(p + 32) = (bf16_t)(w.y & 0xffffu); *(bf16_t*)(p + 48) = (bf16_t)(w.y >> 16);
    *(bf16_t*)(p + 64) = (bf16_t)(w.z & 0xffffu); *(bf16_t*)(p + 80) = (bf16_t)(w.z >> 16); *(bf16_t*)(p + 96) = (bf16_t)(w.w & 0xffffu); *(bf16_t*)(p + 112) = (bf16_t)(w.w >> 16);
}
struct EpiInproj {
    static constexpr bool PERM = true;
    unsigned char* ws; const float* lb; int skip;
    __device__ __forceinline__ void operator()(const f32x4 (&acc)[2][2][4][2], const pg8::Unit& u, int wr, int wc, int fr, int fq) const {
        if (skip) { if (acc[0][0][0][0][0] == 12345.678f) ws[0] = 1; return; }
        const int pn = u.pn;
        const int rbase = u.pm * 256 + wr * 64 + fr;
        const int cwl = wc * 32 + fq * 8;
        if (pn == 2) {
            const int g = wc >> 1, dim = (wc & 1) * 32 + fq * 8;
#pragma unroll
            for (int ai = 0; ai < 2; ++ai)
#pragma unroll
                for (int m = 0; m < 4; ++m) { const int row = rbase + ai * 128 + m * 16, b = row >> 14, t = row & 16383;
                    const size_t e = ((size_t)((b * 2 + g) * 16384 + t)) * 64 + dim;
                    *(u32x4*)((bf16_t*)(ws + WS_KCIN) + e) = pack8(acc[ai][0][m][0], acc[ai][0][m][1]);
                    *(u32x4*)((bf16_t*)(ws + WS_VCIN) + e) = pack8(acc[ai][1][m][0], acc[ai][1][m][1]); }
        } else if (pn == 3 || pn == 4) {
            unsigned char* Kimg = ws + (pn == 3 ? WS_KS : WS_KW); unsigned char* Vimg = ws + (pn == 3 ? WS_VS : WS_VW);
            const int g = wc >> 1, dim = (wc & 1) * 32 + fq * 8;
#pragma unroll
            for (int ai = 0; ai < 2; ++ai)
#pragma unroll
                for (int m = 0; m < 4; ++m) { const int row = rbase + ai * 128 + m * 16, b = row >> 14, t = row & 16383, blk = t >> 6, key = t & 63;
                    const size_t ib = (size_t)((b * 2 + g) * 256 + blk) * 8192;
                    *(u32x4*)(Kimg + ib + kf_off(key, dim)) = pack8(acc[ai][0][m][0], acc[ai][0][m][1]);
                    vf_store8(Vimg + ib, key, dim, pack8(acc[ai][1][m][0], acc[ai][1][m][1])); }
        } else if (pn == 7 || pn == 8) {
            float* LOGF = (float*)(ws + WS_LOGF);
#pragma unroll
            for (int bj = 0; bj < 2; ++bj) { const int col = (pn - 7) * 256 + bj * 128 + cwl;
                const f32x4 l0 = *(const f32x4*)(lb + col), l1 = *(const f32x4*)(lb + col + 4);
#pragma unroll
                for (int ai = 0; ai < 2; ++ai)
#pragma unroll
                    for (int m = 0; m < 4; ++m) { const int row = rbase + ai * 128 + m * 16; f32x4 o0, o1;
#pragma unroll
                        for (int j = 0; j < 4; ++j) { o0[j] = __logf(l0[j] + (1.0f - l0[j]) * sigmoidf_(acc[ai][bj][m][0][j])); o1[j] = __logf(l1[j] + (1.0f - l1[j]) * sigmoidf_(acc[ai][bj][m][1][j])); }
                        *(f32x4*)(LOGF + (size_t)row * 512 + col) = o0; *(f32x4*)(LOGF + (size_t)row * 512 + col + 4) = o1; } }
        } else if (pn == 13) {
            if (cwl < 24) { float* GATE = (float*)(ws + WS_GATE);
#pragma unroll
                for (int ai = 0; ai < 2; ++ai)
#pragma unroll
                    for (int m = 0; m < 4; ++m) { const int row = rbase + ai * 128 + m * 16; f32x4 o0, o1;
#pragma unroll
                        for (int j = 0; j < 4; ++j) { o0[j] = sigmoidf_(acc[ai][0][m][0][j]); o1[j] = sigmoidf_(acc[ai][0][m][1][j]); }
                        *(f32x4*)(GATE + (size_t)row * 24 + cwl) = o0; *(f32x4*)(GATE + (size_t)row * 24 + cwl + 4) = o1; } }
        } else {
            bf16_t* base; int coff; int mode;
            if (pn <= 1) { base = (bf16_t*)(ws + WS_QN); coff = pn * 256; mode = 0; }
            else if (pn <= 6) { base = (bf16_t*)(ws + WS_HQ); coff = (pn - 5) * 256; mode = 1; }
            else if (pn <= 10) { base = (bf16_t*)(ws + WS_HI); coff = (pn - 9) * 256; mode = 1; }
            else { base = (bf16_t*)(ws + WS_HGS); coff = (pn - 11) * 256; mode = 2; }
#pragma unroll
            for (int ai = 0; ai < 2; ++ai)
#pragma unroll
                for (int m = 0; m < 4; ++m) { const int row = rbase + ai * 128 + m * 16;
#pragma unroll
                    for (int bj = 0; bj < 2; ++bj) { f32x4 v0 = acc[ai][bj][m][0], v1 = acc[ai][bj][m][1];
                        if (mode == 0) { v0 = v0 * QSCALE; v1 = v1 * QSCALE; }
                        else if (mode == 2) {
#pragma unroll
                            for (int j = 0; j < 4; ++j) { v0[j] = silu_(v0[j]); v1[j] = silu_(v1[j]); } }
                        *(u32x4*)(base + (size_t)row * 512 + coff + bj * 128 + cwl) = pack8(v0, v1); } }
        }
    }
};

struct EpiMemKV {
    static constexpr bool PERM = true;
    unsigned char* ws;
    __device__ __forceinline__ void operator()(const f32x4 (&acc)[2][2][4][2], const pg8::Unit& u, int wr, int wc, int fr, int fq) const {
        const int isv = u.pn >> 2, head = u.pn & 3, b = u.pm;
        unsigned char* img = ws + (isv ? WS_MEMV : WS_MEMK) + (size_t)(b * 4 + head) * 4 * 32768;
#pragma unroll
        for (int ai = 0; ai < 2; ++ai)
#pragma unroll
            for (int m = 0; m < 4; ++m) { const int key = ai * 128 + wr * 64 + m * 16 + fr, kb = key >> 6, kl = key & 63;
#pragma unroll
                for (int bj = 0; bj < 2; ++bj) { const int dim = bj * 128 + wc * 32 + fq * 8;
                    const int off = isv ? vimg_off(kl, dim) : kimg_off(kl, dim);
                    *(u32x4*)(img + (size_t)kb * 32768 + off) = pack8(acc[ai][bj][m][0], acc[ai][bj][m][1]); } }
    }
};

struct EpiCmp1 {
    static constexpr bool PERM = true;
    unsigned char* ws;
    __device__ __forceinline__ void operator()(const f32x4 (&acc)[2][2][4][2], const pg8::Unit& u, int wr, int wc, int fr, int fq) const {
        const int kv = u.aux; const float* bias = (const float*)(ws + (kv ? WS_BIASV : WS_BIASK));
        bf16_t* HID = (bf16_t*)(ws + WS_HID) + (size_t)kv * 4096 * 256;
#pragma unroll
        for (int bj = 0; bj < 2; ++bj) { const int col = bj * 128 + wc * 32 + fq * 8;
            const f32x4 b0 = *(const f32x4*)(bias + col), b1 = *(const f32x4*)(bias + col + 4);
#pragma unroll
            for (int ai = 0; ai < 2; ++ai)
#pragma unroll
                for (int m = 0; m < 4; ++m) { const int row = u.pm * 256 + ai * 128 + wr * 64 + m * 16 + fr; f32x4 v0, v1;
#pragma unroll
                    for (int j = 0; j < 4; ++j) { v0[j] = gelu_tanh(acc[ai][bj][m][0][j] + b0[j]); v1[j] = gelu_tanh(acc[ai][bj][m][1][j] + b1[j]); }
                    *(u32x4*)(HID + (size_t)row * 256 + col) = pack8(v0, v1); } }
    }
};

__device__ __forceinline__ void row_stats(const float* stat, size_t row, float& mean, float& rstd) {
    const f32x2 v = *(const f32x2*)(stat + row * 2);
    mean = v[0] * (1.f / 1024.f); rstd = 1.0f / sqrtf(fmaxf(v[1] * (1.f / 1024.f) - mean * mean, 0.f) + 1e-5f);
}
template <int MODE>
struct EpiRes {
    static constexpr bool PERM = false;
    const float* base; const bf16_t* baseb; bf16_t* outb; float* stat; const float* pstat; const float* lg; const float* lb;
    __device__ __forceinline__ void operator()(const f32x4 (&acc)[2][2][4][2], const pg8::Unit& u, int wr, int wc, int fr, int fq) const {
        const int col0 = u.pn * 256 + wc * 32 + 4 * fq;
        f32x4 gv[2][2], bv[2][2];
        if (MODE == 1) {
#pragma unroll
            for (int bj = 0; bj < 2; ++bj)
#pragma unroll
                for (int n = 0; n < 2; ++n) { gv[bj][n] = *(const f32x4*)(lg + col0 + bj * 128 + n * 16); bv[bj][n] = *(const f32x4*)(lb + col0 + bj * 128 + n * 16); } }
#pragma unroll
        for (int ai = 0; ai < 2; ++ai) {
            f32x2 st[4]; f32x4 bsf[4][2][2]; u32x2 bsw[4][2][2];
#pragma unroll
            for (int m = 0; m < 4; ++m) { const size_t row = (size_t)(u.pm * 256 + ai * 128 + wr * 64 + m * 16 + fr); const size_t off = row * 1024 + col0;
                if (MODE == 1) st[m] = *(const f32x2*)(pstat + row * 2);
#pragma unroll
                for (int bj = 0; bj < 2; ++bj)
#pragma unroll
                    for (int n = 0; n < 2; ++n) { if (MODE == 0) bsf[m][bj][n] = *(const f32x4*)(base + off + bj * 128 + n * 16); else bsw[m][bj][n] = *(const u32x2*)(baseb + off + bj * 128 + n * 16); } }
#pragma unroll
            for (int m = 0; m < 4; ++m) { const size_t row = (size_t)(u.pm * 256 + ai * 128 + wr * 64 + m * 16 + fr); const size_t off = row * 1024 + col0;
                float mean = 0.f, rstd = 1.f;
                if (MODE == 1) { mean = st[m][0] * (1.f / 1024.f); rstd = 1.0f / sqrtf(fmaxf(st[m][1] * (1.f / 1024.f) - mean * mean, 0.f) + 1e-5f); }
                float s1 = 0.f, s2 = 0.f;
#pragma unroll
                for (int bj = 0; bj < 2; ++bj)
#pragma unroll
                    for (int n = 0; n < 2; ++n) { f32x4 bs;
                        if (MODE == 0) bs = bsf[m][bj][n];
                        else { const u32x2 bw = bsw[m][bj][n]; bs = ((f32x4){bflo(bw.x), bfhi(bw.x), bflo(bw.y), bfhi(bw.y)} - mean) * rstd * gv[bj][n] + bv[bj][n]; }
                        const f32x4 o = bs * ALPHA + acc[ai][bj][m][n];
                        u32x2 w; w.x = cvtpk(o[0], o[1]); w.y = cvtpk(o[2], o[3]); *(u32x2*)(outb + off + bj * 128 + n * 16) = w;
                        s1 += (o[0] + o[1]) + (o[2] + o[3]); s2 += (o[0] * o[0] + o[1] * o[1]) + (o[2] * o[2] + o[3] * o[3]); }
                s1 += __shfl_xor(s1, 16); s1 += __shfl_xor(s1, 32); s2 += __shfl_xor(s2, 16); s2 += __shfl_xor(s2, 32);
                if (fq == 0) { atomicAdd(stat + row * 2, s1); atomicAdd(stat + row * 2 + 1, s2); } } }
    }
};

struct EpiQLn {
    static constexpr bool PERM = true;
    bf16_t* O; const float* stat; const float* cs; const float* bq; int skip;
    __device__ __forceinline__ void operator()(const f32x4 (&acc)[2][2][4][2], const pg8::Unit& u, int wr, int wc, int fr, int fq) const {
        if (skip) { if (acc[0][0][0][0][0] == 12345.678f) O[0] = 1; return; }
        const int col0 = u.pn * 256 + wc * 32 + 8 * fq;
        f32x4 c0[2], c1[2], b0[2], b1[2]; f32x2 st[2][4];
#pragma unroll
        for (int bj = 0; bj < 2; ++bj) { c0[bj] = *(const f32x4*)(cs + col0 + bj * 128); c1[bj] = *(const f32x4*)(cs + col0 + bj * 128 + 4); b0[bj] = *(const f32x4*)(bq + col0 + bj * 128); b1[bj] = *(const f32x4*)(bq + col0 + bj * 128 + 4); }
#pragma unroll
        for (int ai = 0; ai < 2; ++ai)
#pragma unroll
            for (int m = 0; m < 4; ++m) st[ai][m] = *(const f32x2*)(stat + (size_t)(u.pm * 256 + ai * 128 + wr * 64 + m * 16 + fr) * 2);
#pragma unroll
        for (int ai = 0; ai < 2; ++ai)
#pragma unroll
            for (int m = 0; m < 4; ++m) { const size_t row = (size_t)(u.pm * 256 + ai * 128 + wr * 64 + m * 16 + fr);
                const float mean = st[ai][m][0] * (1.f / 1024.f), rstd = 1.0f / sqrtf(fmaxf(st[ai][m][1] * (1.f / 1024.f) - mean * mean, 0.f) + 1e-5f);
                bf16_t* rowp = O + row * 1024 + col0;
#pragma unroll
                for (int bj = 0; bj < 2; ++bj) {
                    const f32x4 v0 = ((acc[ai][bj][m][0] - c0[bj] * mean) * rstd + b0[bj]) * XSCALE, v1 = ((acc[ai][bj][m][1] - c1[bj] * mean) * rstd + b1[bj]) * XSCALE;
                    *(u32x4*)(rowp + bj * 128) = pack8(v0, v1); } }
    }
};

struct EpiScaleBf16 {
    static constexpr bool PERM = true;
    bf16_t* O; int ldc; float scale;
    __device__ __forceinline__ void operator()(const f32x4 (&acc)[2][2][4][2], const pg8::Unit& u, int wr, int wc, int fr, int fq) const {
#pragma unroll
        for (int ai = 0; ai < 2; ++ai)
#pragma unroll
            for (int m = 0; m < 4; ++m) { bf16_t* rowp = O + (size_t)(u.pm * 256 + ai * 128 + wr * 64 + m * 16 + fr) * ldc + u.pn * 256 + wc * 32 + 8 * fq;
#pragma unroll
                for (int bj = 0; bj < 2; ++bj) *(u32x4*)(rowp + bj * 128) = pack8(acc[ai][bj][m][0] * scale, acc[ai][bj][m][1] * scale); }
    }
};

struct EpiGateUp {
    static constexpr bool PERM = true;
    bf16_t* H;
    __device__ __forceinline__ void operator()(const f32x4 (&acc)[2][2][4][2], const pg8::Unit& u, int wr, int wc, int fr, int fq) const {
#pragma unroll
        for (int ai = 0; ai < 2; ++ai)
#pragma unroll
            for (int m = 0; m < 4; ++m) { f32x4 v0, v1;
#pragma unroll
                for (int j = 0; j < 4; ++j) { v0[j] = silu_(acc[ai][0][m][0][j]) * acc[ai][1][m][0][j]; v1[j] = silu_(acc[ai][0][m][1][j]) * acc[ai][1][m][1][j]; }
                *(u32x4*)(H + (size_t)(u.pm * 256 + ai * 128 + wr * 64 + m * 16 + fr) * 512 + u.pn * 128 + wc * 32 + 8 * fq) = pack8(v0, v1); }
    }
};

struct EpiDown {
    static constexpr bool PERM = true;
    bf16_t* Y; const float* sw;
    __device__ __forceinline__ void operator()(const f32x4 (&acc)[2][2][4][2], const pg8::Unit& u, int wr, int wc, int fr, int fq) const {
#pragma unroll
        for (int ai = 0; ai < 2; ++ai)
#pragma unroll
            for (int m = 0; m < 4; ++m) { const int row = u.pm * 256 + ai * 128 + wr * 64 + m * 16 + fr; const float w = sw[row];
                bf16_t* rowp = Y + (size_t)row * 1024 + u.pn * 256 + wc * 32 + 8 * fq;
#pragma unroll
                for (int bj = 0; bj < 2; ++bj) *(u32x4*)(rowp + bj * 128) = pack8(acc[ai][bj][m][0] * w, acc[ai][bj][m][1] * w); }
    }
};
struct Args { const float* in[30]; float* out; unsigned char* ws; int ph_lo, ph_hi, rep, li; };
enum { I_X = 0, I_MEM, I_WIN, I_PEK, I_PEV, I_W1K, I_W2K, I_W1V, I_W2V, I_NSAG, I_LBL, I_HGG, I_WOUT, I_LN1G, I_LN1B, I_XWQ, I_XWK, I_XWV, I_XWO, I_LN2G, I_LN2B,
       I_MWG, I_MBG, I_MWE, I_MBE, I_MGATE, I_MUP, I_MDOWN, I_LN3G, I_LN3B };
constexpr int NWAVES = 8, NTHR = 512;
constexpr int LDS_BYTES = 147456;

struct Frame {
    LAS unsigned char* lds; unsigned char* ws; unsigned* ctl; const float* const* in; float* out;
    int tid, lane, wave, G, bid;
};

template <class Src>
__device__ __forceinline__ void transpose_item(const Src& src, int K, bf16_t* dst, int nblk, LAS float* scr, int item, int lane) {
    const int kb = item / nblk, nb = item % nblk, k0 = 64 * kb, n0 = 32 * nb;
    f32x4 v[8];
#pragma unroll
    for (int i = 0; i < 8; ++i) v[i] = src.ld4(k0 + 8 * i + (lane >> 3), n0 + 4 * (lane & 7));
#pragma unroll
    for (int i = 0; i < 8; ++i) { LAS float* d = scr + (8 * i + (lane >> 3)) * 33 + 4 * (lane & 7); d[0] = v[i][0]; d[1] = v[i][1]; d[2] = v[i][2]; d[3] = v[i][3]; }
    asm volatile("s_waitcnt lgkmcnt(0)" ::: "memory");
    const int c = lane & 7;
#pragma unroll
    for (int j = 0; j < 4; ++j) { const int n = (lane >> 3) + 8 * j; const LAS float* s = scr + (8 * c) * 33 + n;
        u32x4 o; o.x = cvtpk(s[0 * 33], s[1 * 33]); o.y = cvtpk(s[2 * 33], s[3 * 33]); o.z = cvtpk(s[4 * 33], s[5 * 33]); o.w = cvtpk(s[6 * 33], s[7 * 33]);
        *(u32x4*)(dst + (size_t)(n0 + n) * K + k0 + 8 * c) = o; }
    asm volatile("s_waitcnt lgkmcnt(0)" ::: "memory");
}
struct SrcPlain { const float* w; int ldn; __device__ __forceinline__ f32x4 ld4(int k, int n) const { return *(const f32x4*)(w + (size_t)k * ldn + n); } };
struct SrcScaled { const float* w; const float* g; int ldn; __device__ __forceinline__ f32x4 ld4(int k, int n) const { return *(const f32x4*)(w + (size_t)k * ldn + n) * g[k]; } };
struct SrcWin { const float* w; __device__ __forceinline__ f32x4 ld4(int k, int n) const {
    int sc; if (n < 1280) sc = n; else if (n < 3328) sc = n + 24; else { const int j = n - 3328; sc = j < 24 ? 1280 + j : -1; }
    return sc >= 0 ? *(const f32x4*)(w + (size_t)k * 3352 + sc) : (f32x4){0.f, 0.f, 0.f, 0.f}; } };
struct SrcGU { const float* wg; const float* wu; __device__ __forceinline__ f32x4 ld4(int k, int n) const {
    const int tile = n >> 8, i = n & 255; const long long d = (long long)(wu - wg) * (long long)((i >> 7) & 1); return *(const f32x4*)(wg + d + (size_t)k * 512 + tile * 128 + (i & 127)); } };

constexpr int MOE_CONV_ITEMS = 32 * (16 * 32 + 8 * 32);
__device__ __forceinline__ void moe_conv_item(Frame& F, int it) {
    constexpr int I_GU = 16 * 32, I_D = 8 * 32;
    LAS float* scr = (LAS float*)(F.lds + F.wave * 16384);
    const int e = it / (I_GU + I_D), r = it % (I_GU + I_D);
    if (r < I_GU) transpose_item(SrcGU{F.in[I_MGATE] + (size_t)e * 1024 * 512, F.in[I_MUP] + (size_t)e * 1024 * 512}, 1024, (bf16_t*)(F.ws + WS_WGU) + (size_t)e * 1024 * 1024, 32, scr, r, F.lane);
    else transpose_item(SrcPlain{F.in[I_MDOWN] + (size_t)e * 512 * 1024, 1024}, 512, (bf16_t*)(F.ws + WS_WD) + (size_t)e * 1024 * 512, 32, scr, r - I_GU, F.lane);
}
__device__ __forceinline__ void p0_prep(Frame& F) {
    LAS float* scr = (LAS float*)(F.lds + F.wave * 16384);
    const int gw = F.bid * NWAVES + F.wave, NGW = F.G * NWAVES;
    unsigned char* ws = F.ws;
    if (F.bid == 0) { const float* l = F.in[I_LBL]; ((float*)(ws + WS_LB))[F.tid] = 1.0f / (1.0f + __expf(l[512 + F.tid] - l[F.tid])); }
    { const int job = F.bid - 1;
      if (job >= 0 && job < 48) { LAS float* red = (LAS float*)(F.lds + 100 * 1024); const int cl = F.tid & 31, sl = F.tid >> 5; float a0 = 0.f, a1 = 0.f;
        if (job < 16) { const int kv = job >> 3, n = (job & 7) * 32 + cl; const float* pe = F.in[kv ? I_PEV : I_PEK]; const float* w1 = F.in[kv ? I_W1V : I_W1K];
#pragma unroll 8
            for (int k = sl * 128; k < sl * 128 + 128; ++k) a0 += pe[k] * w1[(size_t)k * 256 + n]; }
        else { const int n = (job - 16) * 32 + cl; const float* wq = F.in[I_XWQ]; const float* g1 = F.in[I_LN1G]; const float* b1 = F.in[I_LN1B];
#pragma unroll 8
            for (int k = sl * 64; k < sl * 64 + 64; ++k) { const float wv = wq[(size_t)k * 1024 + n]; a0 += bf2f(f2bf(wv * g1[k])); a1 += b1[k] * wv; } }
        red[F.tid] = a0; red[512 + F.tid] = a1;
        __syncthreads();
        if (F.tid < 32) { float s0 = 0.f, s1 = 0.f;
#pragma unroll
            for (int i = 0; i < 16; ++i) { s0 += red[i * 32 + F.tid]; s1 += red[512 + i * 32 + F.tid]; }
            if (job < 16) ((float*)(ws + ((job >> 3) ? WS_BIASV : WS_BIASK)))[(job & 7) * 32 + F.tid] = s0;
            else { ((float*)(ws + WS_QCS))[(job - 16) * 32 + F.tid] = s0; ((float*)(ws + WS_QBQ))[(job - 16) * 32 + F.tid] = s1; } }
        __syncthreads(); } }
    constexpr int I_WINN = 16 * 112, I_SQ = 16 * 32, I_W1 = 32 * 8, I_W2 = 4 * 2;
    constexpr int NITEMS_A = I_WINN + 5 * I_SQ + 2 * I_W1 + 2 * I_W2;
    for (int it = gw; it < NITEMS_A; it += NGW) {
        int r = it;
        if (r < I_WINN) { transpose_item(SrcWin{F.in[I_WIN]}, 1024, (bf16_t*)(ws + WS_WIN), 112, scr, r, F.lane); continue; } r -= I_WINN;
        if (r < 5 * I_SQ) { const int w = r / I_SQ; const float* src = F.in[w == 0 ? I_WOUT : w == 1 ? I_XWQ : w == 2 ? I_XWK : w == 3 ? I_XWV : I_XWO];
            if (w == 1) transpose_item(SrcScaled{src, F.in[I_LN1G], 1024}, 1024, (bf16_t*)(ws + WS_WQ), 32, scr, r % I_SQ, F.lane);
            else transpose_item(SrcPlain{src, 1024}, 1024, (bf16_t*)(ws + WS_WOUT + (size_t)w * 2 * MiB), 32, scr, r % I_SQ, F.lane);
            continue; } r -= 5 * I_SQ;
        if (r < 2 * I_W1) { const int kv = r / I_W1; transpose_item(SrcPlain{F.in[kv ? I_W1V : I_W1K], 256}, 2048, (bf16_t*)(ws + (kv ? WS_W1V : WS_W1K)), 8, scr, r % I_W1, F.lane); continue; } r -= 2 * I_W1;
        { const int kv = r / I_W2; transpose_item(SrcPlain{F.in[kv ? I_W2V : I_W2K], 64}, 256, (bf16_t*)(ws + (kv ? WS_W2V : WS_W2K)), 2, scr, r % I_W2, F.lane); }
    }
    for (int it = gw; it < MOE_CONV_ITEMS; it += NGW) moe_conv_item(F, it);
    { f32x4* z = (f32x4*)(ws + WS_STAT1); for (size_t i = (size_t)F.bid * NTHR + F.tid; i < (size_t)2 * NTOK * 2 / 4; i += (size_t)F.G * NTHR) z[i] = (f32x4){0.f, 0.f, 0.f, 0.f}; }
    { bf16_t* WH = (bf16_t*)(ws + WS_WRH); bf16_t* WL = (bf16_t*)(ws + WS_WRL); const float* wg = F.in[I_MWG]; const float* we = F.in[I_MWE];
      for (size_t i = (size_t)F.bid * NTHR + F.tid; i < (size_t)48 * 1024; i += (size_t)F.G * NTHR) { const int c = (int)(i >> 10), k = (int)(i & 1023);
          const float v = c < 4 ? wg[k * 4 + c] : c < 36 ? we[k * 32 + (c - 4)] : 0.f; const bf16_t h = f2bf(v); WH[i] = h; WL[i] = f2bf(v - bf2f(h)); } }
    const size_t gt = (size_t)F.bid * NTHR + F.tid, NT = (size_t)F.G * NTHR;
    { const f32x4* x4 = (const f32x4*)F.in[I_X]; u32x4* o = (u32x4*)(ws + WS_RA);
      for (size_t i = gt; i < (size_t)NTOK * DM / 8; i += NT) o[i] = pack8(x4[2 * i], x4[2 * i + 1]); }
    { const f32x4* x4 = (const f32x4*)F.in[I_MEM]; u32x4* o = (u32x4*)(ws + WS_MEMB);
      for (size_t i = gt; i < (size_t)512 * DM / 8; i += NT) o[i] = pack8(x4[2 * i], x4[2 * i + 1]); }
}

__device__ __forceinline__ void ln_row(const float* src, const float* g, const float* b, int lane, f32x4 (&y)[4]) {
    const f32x4* xr = (const f32x4*)src + lane; f32x4 v[4]; float s = 0.f;
#pragma unroll
    for (int j = 0; j < 4; ++j) { v[j] = xr[64 * j]; s += (v[j][0] + v[j][1]) + (v[j][2] + v[j][3]); }
    const float mean = wave_sum(s) * (1.f / 1024.f); float s2 = 0.f;
#pragma unroll
    for (int j = 0; j < 4; ++j) { v[j] = v[j] - mean; s2 += (v[j][0] * v[j][0] + v[j][1] * v[j][1]) + (v[j][2] * v[j][2] + v[j][3] * v[j][3]); }
    const float rstd = 1.0f / sqrtf(wave_sum(s2) * (1.f / 1024.f) + 1e-5f);
#pragma unroll
    for (int j = 0; j < 4; ++j) { const f32x4 gg = ((const f32x4*)g)[lane + 64 * j], bb = ((const f32x4*)b)[lane + 64 * j]; y[j] = v[j] * rstd * gg + bb; }
}
__device__ __forceinline__ void store_row_f32_bf16(const f32x4 (&y)[4], float* of, bf16_t* ob, int lane) {
#pragma unroll
    for (int j = 0; j < 4; ++j) { ((f32x4*)of)[lane + 64 * j] = y[j]; u32x2 w; w.x = cvtpk(y[j][0], y[j][1]); w.y = cvtpk(y[j][2], y[j][3]); ((u32x2*)ob)[lane + 64 * j] = w; }
}
__device__ __forceinline__ int crow(int r, int hi) { return (r & 3) + 8 * (r >> 2) + 4 * hi; }
#define MFMA32(a, b, c) __builtin_amdgcn_mfma_f32_32x32x16_bf16((a), (b), (c), 0, 0, 0)

__device__ __forceinline__ void chunk_cumsum(LAS float* lf, LAS float* seg_tot, int tid) {
    const int ch = tid & 127, seg = tid >> 7; float v[16];
#pragma unroll
    for (int i = 0; i < 16; ++i) v[i] = lf[(seg * 16 + i) * 128 + ch];
#pragma unroll
    for (int i = 1; i < 16; ++i) v[i] += v[i - 1];
#pragma unroll
    for (int i = 0; i < 16; ++i) lf[(seg * 16 + i) * 128 + ch] = v[i];
    seg_tot[seg * 128 + ch] = v[15];
}
#define DPPADD_(v, ctrl, rm) v += __int_as_float(__builtin_amdgcn_update_dpp(0, __float_as_int(v), ctrl, rm, 0xF, true))
__device__ __forceinline__ float half_sum_dpp(float v) { DPPADD_(v, 0x111, 0xF); DPPADD_(v, 0x112, 0xF); DPPADD_(v, 0x114, 0xF); DPPADD_(v, 0x118, 0xF); DPPADD_(v, 0x142, 0xA); return v; }

struct HAIn { f32x4 lfr[4]; u32x2 vr[4]; };
__device__ __forceinline__ void hgrn_a_load(Frame& F, int unit, int tid, HAIn& in) {
    const int bh = unit >> 8, c = unit & 255, b = bh >> 2, h = bh & 3; const size_t m0 = (size_t)b * SEQ + 64 * c; const int tr = tid >> 5, c4 = (tid & 31) * 4;
    const float* LOGF = (const float*)(F.ws + WS_LOGF) + m0 * 512 + h * 128; const bf16_t* HI = (const bf16_t*)(F.ws + WS_HI) + m0 * 512 + h * 128;
#pragma unroll
    for (int i = 0; i < 4; ++i) { const int t = tr + 16 * i; in.lfr[i] = *(const f32x4*)(LOGF + (size_t)t * 512 + c4); in.vr[i] = *(const u32x2*)(HI + (size_t)t * 512 + c4); }
}
template <class NextFn>
__device__ __forceinline__ void hgrn_a_loop(Frame& F, const NextFn& next_unit) {
    const int w = F.wave;
    LAS float* lf = (LAS float*)F.lds; LAS bf16_t* KeT = (LAS bf16_t*)(F.lds + 32768); LAS bf16_t* Vt = (LAS bf16_t*)(F.lds + 51200); LAS float* segt = (LAS float*)(F.lds + 69632);
    int unit = next_unit(); if (unit < 0) return;
    HAIn in; hgrn_a_load(F, unit, F.tid, in);
    for (;;) {
        const int un = next_unit();
        int tid = F.tid; asm volatile("" : "+v"(tid));
        const int lane = tid & 63, r32 = lane & 31, hi = lane >> 5, tr = tid >> 5, c4 = (tid & 31) * 4;
#pragma unroll
        for (int i = 0; i < 4; ++i) *(LAS f32x4*)(lf + (tr + 16 * i) * 128 + c4) = in.lfr[i];
        __syncthreads();
        chunk_cumsum(lf, segt, tid);
        __syncthreads();
        { const f32x4 T0 = *(const LAS f32x4*)(segt + c4), T1 = *(const LAS f32x4*)(segt + 128 + c4), T2 = *(const LAS f32x4*)(segt + 256 + c4);
          const f32x4 bl = *(const LAS f32x4*)(lf + 63 * 128 + c4) + T0 + T1 + T2;
          if (tr == 0) *(f32x4*)((float*)(F.ws + WS_HD) + (size_t)unit * 128 + c4) = (f32x4){__expf(bl[0]), __expf(bl[1]), __expf(bl[2]), __expf(bl[3])};
          f32x4 off = (f32x4){0.f, 0.f, 0.f, 0.f};
#pragma unroll
          for (int i = 0; i < 4; ++i) { const int t = tr + 16 * i; const f32x4 bt = *(const LAS f32x4*)(lf + t * 128 + c4) + off;
#pragma unroll
            for (int j = 0; j < 4; ++j) { const float kk = 1.0f - __expf(in.lfr[i][j]); const float ke = kk * __expf(bl[j] - bt[j]);
                KeT[(c4 + j) * 72 + t] = f2bf(ke); }
            Vt[(c4 + 0) * 72 + t] = (bf16_t)(in.vr[i].x & 0xffffu); Vt[(c4 + 1) * 72 + t] = (bf16_t)(in.vr[i].x >> 16);
            Vt[(c4 + 2) * 72 + t] = (bf16_t)(in.vr[i].y & 0xffffu); Vt[(c4 + 3) * 72 + t] = (bf16_t)(in.vr[i].y >> 16);
            off = off + (i == 0 ? T0 : i == 1 ? T1 : T2); } }
        if (un >= 0) hgrn_a_load(F, un, tid, in);
        __syncthreads();
        { const int vt = w >> 1, kt0 = 2 * (w & 1); f32x16 a0 = {}, a1 = {};
#pragma unroll
          for (int ks = 0; ks < 4; ++ks) { const bf16x8 av = *(const LAS bf16x8*)(Vt + (vt * 32 + r32) * 72 + 16 * ks + 8 * hi);
            const bf16x8 b0 = *(const LAS bf16x8*)(KeT + (kt0 * 32 + r32) * 72 + 16 * ks + 8 * hi), b1 = *(const LAS bf16x8*)(KeT + ((kt0 + 1) * 32 + r32) * 72 + 16 * ks + 8 * hi);
            a0 = MFMA32(av, b0, a0); a1 = MFMA32(av, b1, a1); }
          bf16_t* HST = (bf16_t*)F.out + (size_t)unit * 16384;
#pragma unroll
          for (int r = 0; r < 16; ++r) { const int v = vt * 32 + crow(r, hi); HST[v * 128 + kt0 * 32 + r32] = f2bf(a0[r]); HST[v * 128 + (kt0 + 1) * 32 + r32] = f2bf(a1[r]); } }
        if (un < 0) break;
        unit = un;
    }
    __syncthreads();
}

__device__ __forceinline__ void hgrn_b(Frame& F) {
    unsigned* HST = (unsigned*)F.out; const float* HD = (const float*)(F.ws + WS_HD);
    for (int e = F.bid * NTHR + F.tid; e < 8 * 8192; e += F.G * NTHR) {
        const int bh = e >> 13, rem = e & 8191, k2 = (rem & 63) * 2; float S0 = 0.f, S1 = 0.f;
        for (int c0 = 0; c0 < 256; c0 += 16) { unsigned L[16]; f32x2 d[16];
#pragma unroll
            for (int i = 0; i < 16; ++i) { L[i] = HST[(size_t)(bh * 256 + c0 + i) * 8192 + rem]; d[i] = *(const f32x2*)(HD + (size_t)(bh * 256 + c0 + i) * 128 + k2); }
#pragma unroll
            for (int i = 0; i < 16; ++i) { HST[(size_t)(bh * 256 + c0 + i) * 8192 + rem] = cvtpk(S0, S1); S0 = d[i][0] * S0 + bflo(L[i]); S1 = d[i][1] * S1 + bfhi(L[i]); } }
    }
}

struct HCIn { f32x4 lfr[4]; u32x2 vr[4], qv[4]; u32x4 stf[8]; };
template <int PART>
__device__ __forceinline__ void hgrn_c_load(Frame& F, int unit, HCIn& in) {
    const int bh = unit >> 8, c = unit & 255, b = bh >> 2, h = bh & 3, tid = F.tid, lane = F.lane, w = F.wave, r32 = lane & 31, hi = lane >> 5;
    const size_t m0 = (size_t)b * SEQ + 64 * c; const int tr = tid >> 5, c4 = (tid & 31) * 4, vt = w & 3;
    if (PART & 1) {
    const float* LOGF = (const float*)(F.ws + WS_LOGF) + m0 * 512 + h * 128; const bf16_t* HI = (const bf16_t*)(F.ws + WS_HI) + m0 * 512 + h * 128;
    const bf16_t* HQ = (const bf16_t*)(F.ws + WS_HQ) + m0 * 512 + h * 128;
#pragma unroll
    for (int i = 0; i < 4; ++i) { const int t = tr + 16 * i; in.lfr[i] = *(const f32x4*)(LOGF + (size_t)t * 512 + c4); in.vr[i] = *(const u32x2*)(HI + (size_t)t * 512 + c4);
        in.qv[i] = *(const u32x2*)(HQ + (size_t)t * 512 + c4); } }
    if (PART & 2) { const bf16_t* ST = (const bf16_t*)F.out + (size_t)unit * 16384 + (size_t)(vt * 32 + r32) * 128 + 8 * hi;
#pragma unroll
    for (int ks = 0; ks < 8; ++ks) in.stf[ks] = *(const u32x4*)(ST + 16 * ks); }
}
template <class NextFn>
__device__ __forceinline__ void hgrn_c_loop(Frame& F, const NextFn& next_unit) {
    const int w = F.wave;
    LAS float* lf = (LAS float*)F.lds; LAS bf16_t* Qe = (LAS bf16_t*)(F.lds + 32768); LAS bf16_t* Qi = (LAS bf16_t*)(F.lds + 50176); LAS bf16_t* Ki = (LAS bf16_t*)(F.lds + 67584);
    LAS bf16_t* Vt = (LAS bf16_t*)(F.lds + 84992); LAS bf16_t* att = (LAS bf16_t*)(F.lds + 103424); LAS float* ssb = (LAS float*)(F.lds + 112640); LAS float* segt = (LAS float*)(F.lds + 113664);
    const int tt = w >> 2, vt = w & 3;
    const float gg = F.in[I_HGG][vt * 32 + (F.lane & 31)];
    int unit = next_unit(); if (unit < 0) return;
    HCIn in; hgrn_c_load<3>(F, unit, in);
    for (;;) {
        const int un = next_unit();
        int tid = F.tid; asm volatile("" : "+v"(tid));
        const int lane = tid & 63, r32 = lane & 31, hi = lane >> 5, tr = tid >> 5, c4 = (tid & 31) * 4;
        const int bh = unit >> 8, c = unit & 255, b = bh >> 2, h = bh & 3; const size_t m0 = (size_t)b * SEQ + 64 * c;
        const bf16_t* HGS = (const bf16_t*)(F.ws + WS_HGS) + m0 * 512 + h * 128 + vt * 32 + r32;
#pragma unroll
        for (int i = 0; i < 4; ++i) *(LAS f32x4*)(lf + (tr + 16 * i) * 128 + c4) = in.lfr[i];
        __syncthreads();
        chunk_cumsum(lf, segt, tid);
        __syncthreads();
        { const f32x4 T0 = *(const LAS f32x4*)(segt + c4), T1 = *(const LAS f32x4*)(segt + 128 + c4), T2 = *(const LAS f32x4*)(segt + 256 + c4);
          const f32x4 bm = *(const LAS f32x4*)(lf + 31 * 128 + c4) + T0;
          f32x4 off = (f32x4){0.f, 0.f, 0.f, 0.f};
#pragma unroll
          for (int i = 0; i < 4; ++i) { const int t = tr + 16 * i; const f32x4 bt = *(const LAS f32x4*)(lf + t * 128 + c4) + off;
            float q[4] = {bflo(in.qv[i].x), bfhi(in.qv[i].x), bflo(in.qv[i].y), bfhi(in.qv[i].y)}; float qe[4], qi[4], ki[4];
#pragma unroll
            for (int j = 0; j < 4; ++j) { const float kk = 1.0f - __expf(in.lfr[i][j]); qe[j] = q[j] * __expf(bt[j]); const float ed = __expf(fminf(fmaxf(bt[j] - bm[j], -80.f), 80.f)); qi[j] = q[j] * ed; ki[j] = kk * __builtin_amdgcn_rcpf(ed); }
            u32x2 o; o.x = cvtpk(qe[0], qe[1]); o.y = cvtpk(qe[2], qe[3]); *(LAS u32x2*)(Qe + t * 136 + c4) = o;
            o.x = cvtpk(qi[0], qi[1]); o.y = cvtpk(qi[2], qi[3]); *(LAS u32x2*)(Qi + t * 136 + c4) = o;
            o.x = cvtpk(ki[0], ki[1]); o.y = cvtpk(ki[2], ki[3]); *(LAS u32x2*)(Ki + t * 136 + c4) = o;
            Vt[(c4 + 0) * 72 + t] = (bf16_t)(in.vr[i].x & 0xffffu); Vt[(c4 + 1) * 72 + t] = (bf16_t)(in.vr[i].x >> 16);
            Vt[(c4 + 2) * 72 + t] = (bf16_t)(in.vr[i].y & 0xffffu); Vt[(c4 + 3) * 72 + t] = (bf16_t)(in.vr[i].y >> 16);
            off = off + (i == 0 ? T0 : i == 1 ? T1 : T2); } }
        __syncthreads();
        f32x16 acc = {};
#pragma unroll
        for (int ks = 0; ks < 8; ++ks) { const bf16x8 af = *(const LAS bf16x8*)(Qe + (tt * 32 + r32) * 136 + 16 * ks + 8 * hi);
            acc = MFMA32(af, __builtin_bit_cast(bf16x8, in.stf[ks]), acc); }
        unsigned short gs[16];
#pragma unroll
        for (int r = 0; r < 16; ++r) gs[r] = HGS[(size_t)(tt * 32 + crow(r, hi)) * 512];
        if (un >= 0) hgrn_c_load<1>(F, un, in);
        if (w < 4 && w != 1) { const int ti = w >> 1, si = w & 1; f32x16 a = {};
#pragma unroll
            for (int ks = 0; ks < 8; ++ks) { const bf16x8 af = *(const LAS bf16x8*)(Qi + (ti * 32 + r32) * 136 + 16 * ks + 8 * hi), bf = *(const LAS bf16x8*)(Ki + (si * 32 + r32) * 136 + 16 * ks + 8 * hi);
                a = MFMA32(af, bf, a); }
            const int sidx = si * 32 + r32;
#pragma unroll
            for (int r = 0; r < 16; ++r) { const int t = ti * 32 + crow(r, hi); att[t * 72 + sidx] = f2bf(sidx <= t ? a[r] : 0.f); } }
        __syncthreads();
#pragma unroll
        for (int ks = 0; ks < 4; ++ks) if (ks < 2 || tt == 1) { const bf16x8 af = *(const LAS bf16x8*)(att + (tt * 32 + r32) * 72 + 16 * ks + 8 * hi), bf = *(const LAS bf16x8*)(Vt + (vt * 32 + r32) * 72 + 16 * ks + 8 * hi);
            acc = MFMA32(af, bf, acc); }
#pragma unroll
        for (int r = 0; r < 16; ++r) { const float q = half_sum_dpp(acc[r] * acc[r]);
            if (r32 == 31) ssb[(tt * 32 + crow(r, hi)) * 4 + vt] = q; }
        if (un >= 0) hgrn_c_load<2>(F, un, in);
        __syncthreads();
        { bf16_t* MX = (bf16_t*)(F.ws + WS_RB) + m0 * 1024 + 512 + h * 128 + vt * 32 + r32;
#pragma unroll
          for (int r = 0; r < 16; ++r) { const int t = tt * 32 + crow(r, hi); const f32x4 s4 = *(const LAS f32x4*)(ssb + t * 4);
            const float rs = __builtin_amdgcn_rsqf(((s4[0] + s4[1]) + (s4[2] + s4[3])) * (1.f / 128.f) + 1e-6f);
            MX[(size_t)t * 1024] = f2bf(acc[r] * rs * gg * bf2f(gs[r])); } }
        if (un < 0) break;
        unit = un;
    }
    __syncthreads();
}
typedef short v4i16_t __attribute__((ext_vector_type(4)));
__device__ __forceinline__ s16x4 vtr(const LAS unsigned char* p) { return __builtin_bit_cast(s16x4, __builtin_amdgcn_ds_read_tr16_b64_v4i16((LAS v4i16_t*)p)); }
__device__ __forceinline__ float xhalf(float v) { return __shfl_xor(v, 32); }
__device__ __forceinline__ float dpp_x1(float v) { return __int_as_float(__builtin_amdgcn_update_dpp(0, __float_as_int(v), 0xB1, 0xF, 0xF, true)); }
__device__ __forceinline__ float dpp_x2(float v) { return __int_as_float(__builtin_amdgcn_update_dpp(0, __float_as_int(v), 0x4E, 0xF, 0xF, true)); }

#define DPPMAX_(v, ctrl, rm) v = fmaxf(v, __int_as_float(__builtin_amdgcn_update_dpp(__float_as_int(v), __float_as_int(v), ctrl, rm, 0xF, false)))
__device__ __forceinline__ float wave_max_bcast(float v) {
    DPPMAX_(v, 0x111, 0xF); DPPMAX_(v, 0x112, 0xF); DPPMAX_(v, 0x114, 0xF); DPPMAX_(v, 0x118, 0xF); DPPMAX_(v, 0x142, 0xA); DPPMAX_(v, 0x143, 0xC);
    return __int_as_float(__builtin_amdgcn_readlane(__float_as_int(v), 63));
}
#define LADD(p, v) (void)__hip_atomic_fetch_add((p), (v), __ATOMIC_RELAXED, __HIP_MEMORY_SCOPE_WORKGROUP)
struct FlashSt { f32x16 o0, o1; float m, l; };
__device__ __forceinline__ void flash_init(FlashSt& s) { s.o0 = (f32x16){}; s.o1 = (f32x16){}; s.m = -INFINITY; s.l = 0.f; }

__device__ __forceinline__ void qk_block64(const LAS unsigned char* Kimg, const bf16x8 (&qr)[4], f32x16& p0, f32x16& p1, int klo, int khi, bool nomask, int r32, int hi) {
    const LAS unsigned char* kb = Kimg + hi * 1024 + r32 * 16;
    p0 = (f32x16){}; p1 = (f32x16){};
#pragma unroll
    for (int d0 = 0; d0 < 4; ++d0) { const bf16x8 b0 = *(const LAS bf16x8*)(kb + d0 * 2048), b1 = *(const LAS bf16x8*)(kb + d0 * 2048 + 512);
        p0 = MFMA32(b0, qr[d0], p0); p1 = MFMA32(b1, qr[d0], p1); }
    if (!nomask) {
#pragma unroll
        for (int r = 0; r < 16; ++r) { const int k0 = crow(r, hi); if (k0 < klo || k0 > khi) p0[r] = -INFINITY; if (k0 + 32 < klo || k0 + 32 > khi) p1[r] = -INFINITY; } }
}
__device__ __forceinline__ float rowmax32(const f32x16& p0, const f32x16& p1) {
    float a = fmaxf(p0[0], p1[0]);
#pragma unroll
    for (int r = 1; r < 16; ++r) a = fmaxf(a, fmaxf(p0[r], p1[r]));
    return fmaxf(a, xhalf(a));
}
__device__ __forceinline__ void flash_block64(const LAS unsigned char* Kimg, const LAS unsigned char* Vimg, const bf16x8 (&qr)[4], FlashSt& st, int klo, int khi, bool nomask, int lane) {
    const int r32 = lane & 31, hi = lane >> 5;
    f32x16 p0, p1; qk_block64(Kimg, qr, p0, p1, klo, khi, nomask, r32, hi);
    const float mx = rowmax32(p0, p1), mnew = fmaxf(st.m, mx), msafe = (mnew == -INFINITY) ? 0.f : mnew;
    const float alpha = fast_exp2(st.m - msafe); st.m = mnew;
    float sum = 0.f;
#pragma unroll
    for (int r = 0; r < 16; ++r) { p0[r] = fast_exp2(p0[r] - msafe); p1[r] = fast_exp2(p1[r] - msafe); sum += p0[r] + p1[r]; }
    sum += xhalf(sum); st.l = st.l * alpha + sum;
    st.o0 = st.o0 * alpha; st.o1 = st.o1 * alpha;
    u32x4 pw[4];
    pw[0] = (u32x4){cvtpk(p0[0], p0[1]), cvtpk(p0[2], p0[3]), cvtpk(p0[4], p0[5]), cvtpk(p0[6], p0[7])};
    pw[1] = (u32x4){cvtpk(p0[8], p0[9]), cvtpk(p0[10], p0[11]), cvtpk(p0[12], p0[13]), cvtpk(p0[14], p0[15])};
    pw[2] = (u32x4){cvtpk(p1[0], p1[1]), cvtpk(p1[2], p1[3]), cvtpk(p1[4], p1[5]), cvtpk(p1[6], p1[7])};
    pw[3] = (u32x4){cvtpk(p1[8], p1[9]), cvtpk(p1[10], p1[11]), cvtpk(p1[12], p1[13]), cvtpk(p1[14], p1[15])};
    const LAS unsigned char* vp = Vimg + ((lane >> 4) & 1) * 32 + (lane & 3) * 8 + (4 * hi + ((lane & 15) >> 2)) * 64;
#pragma unroll
    for (int ks = 0; ks < 4; ++ks) { const bf16x8 pa = __builtin_bit_cast(bf16x8, pw[ks]);
        { const s16x4 lo = vtr(vp + ks * 1024), hh = vtr(vp + ks * 1024 + 512); const bf16x8 vf = (bf16x8){lo[0], lo[1], lo[2], lo[3], hh[0], hh[1], hh[2], hh[3]}; st.o0 = MFMA32(vf, pa, st.o0); }
        { const s16x4 lo = vtr(vp + 4096 + ks * 1024), hh = vtr(vp + 4096 + ks * 1024 + 512); const bf16x8 vf = (bf16x8){lo[0], lo[1], lo[2], lo[3], hh[0], hh[1], hh[2], hh[3]}; st.o1 = MFMA32(vf, pa, st.o1); } }
}

#define MFMA16(a, b, c) __builtin_amdgcn_mfma_f32_16x16x32_bf16((a), (b), (c), 0, 0, 0)
constexpr int LDS_MISC = 139264;
constexpr int NSA_IMPLD = 257, NSA_WREG = 8 * 4 * NSA_IMPLD * 2, NSA_SELM = 8 * NSA_WREG, NSA_QNEED = NSA_SELM + 64 * 8 * 4, NSA_ILT = NSA_QNEED + 16 * 8 * 4, NSA_MISC = NSA_ILT + 8 * 32 * 4;
static_assert(NSA_MISC + (8 + 256) * 4 <= LDS_MISC && NSA_WREG >= 8 * NSA_IMPLD * 4 && NSA_WREG >= 8192 && NSA_WREG % 16 == 0, "NSA LDS map");
struct QS { f32x4 o[4]; f32x4 lacc; float m, l; };
__device__ __forceinline__ void qs_init(QS& s) { s.o[0] = (f32x4){0.f, 0.f, 0.f, 0.f}; s.o[1] = s.o[0]; s.o[2] = s.o[0]; s.o[3] = s.o[0]; s.lacc = s.o[0]; s.m = -INFINITY; s.l = 0.f; }
__device__ __forceinline__ float x16(float v) { return __shfl_xor(v, 16); }
__device__ __forceinline__ void quad_scores(const LAS unsigned char* KF, const bf16x8 (&qf)[2], f32x4 (&sc)[4], int klo, int khi, bool nomask, int lane, float negm = 0.f) {
#pragma unroll
    for (int kt = 0; kt < 4; ++kt) { sc[kt] = (f32x4){negm, negm, negm, negm};
#pragma unroll
        for (int ks = 0; ks < 2; ++ks) { const bf16x8 kf = *(const LAS bf16x8*)(KF + ((kt * 2 + ks) * 64 + lane) * 16); sc[kt] = MFMA16(kf, qf[ks], sc[kt]); } }
    if (!nomask) { const int g4 = lane >> 4;
#pragma unroll
        for (int kt = 0; kt < 4; ++kt)
#pragma unroll
            for (int i = 0; i < 4; ++i) { const int key = 16 * kt + 4 * g4 + i; if (key < klo || key > khi) sc[kt][i] = -INFINITY; } }
}
constexpr float QTHR = 6.0f;
#ifndef NSA_QTHR_IMP
#define NSA_QTHR_IMP 6.0f
#endif
constexpr float QTHR_IMP = NSA_QTHR_IMP;
template <bool IMP, class VLoad>
__device__ __forceinline__ float quad_core(f32x4 (&sc)[4], QS& st, const VLoad& vload, float (&pa)[4], float (&pe)[4]) {
    float moved = 1.f;
    float mxl = fmaxf(fmaxf(sc[0][0], sc[0][1]), fmaxf(sc[0][2], sc[0][3]));
#pragma unroll
    for (int kt = 1; kt < 4; ++kt) mxl = fmaxf(mxl, fmaxf(fmaxf(sc[kt][0], sc[kt][1]), fmaxf(sc[kt][2], sc[kt][3])));
    if (__any(st.m == -INFINITY ? (mxl > -INFINITY) : (mxl > (IMP ? QTHR_IMP : QTHR)))) {
        float mx = fmaxf(mxl, x16(mxl)); mx = fmaxf(mx, xhalf(mx));
        const float mold = (st.m == -INFINITY) ? 0.f : st.m;
        const float dl = (mx == -INFINITY) ? 0.f : fmaxf(mx, (st.m == -INFINITY) ? mx : 0.f);
        const float alpha = (st.m == -INFINITY) ? 0.f : fast_exp2(-dl);
        if (IMP) moved = (st.m == -INFINITY) ? 1.f : alpha;
        if (mx != -INFINITY) st.m = mold + dl;
        st.lacc = st.lacc * alpha;
#pragma unroll
        for (int dt = 0; dt < 4; ++dt) st.o[dt] = st.o[dt] * alpha;
#pragma unroll
        for (int kt = 0; kt < 4; ++kt) sc[kt] = sc[kt] - dl;
    }
#pragma unroll
    for (int kt = 0; kt < 4; ++kt)
#pragma unroll
        for (int i = 0; i < 4; ++i) sc[kt][i] = fast_exp2(sc[kt][i]);
    if (IMP) {
#pragma unroll
        for (int kt = 0; kt < 4; ++kt) { pa[kt] = (sc[kt][0] + sc[kt][1]) + (sc[kt][2] + sc[kt][3]); pe[kt] = sc[kt][3]; } }
    bf16x8 pb[2];
    pb[0] = __builtin_bit_cast(bf16x8, pack8(sc[0], sc[1])); pb[1] = __builtin_bit_cast(bf16x8, pack8(sc[2], sc[3]));
    const bf16x8 ones = (bf16x8){0x3f80, 0x3f80, 0x3f80, 0x3f80, 0x3f80, 0x3f80, 0x3f80, 0x3f80};
    st.lacc = MFMA16(ones, pb[0], st.lacc); st.lacc = MFMA16(ones, pb[1], st.lacc);
#pragma unroll
    for (int dt = 0; dt < 4; ++dt)
#pragma unroll
        for (int s2 = 0; s2 < 2; ++s2) st.o[dt] = MFMA16(vload(dt * 2 + s2), pb[s2], st.o[dt]);
    return moved;
}
__device__ __forceinline__ void qs_finish(QS& st) { st.l = st.lacc[0]; }
__device__ __forceinline__ void quad_block(const LAS unsigned char* KF, const LAS unsigned char* VF, const bf16x8 (&qf)[2], QS& st, int klo, int khi, bool nomask, int lane) {
    f32x4 sc[4]; quad_scores(KF, qf, sc, klo, khi, nomask, lane, (st.m == -INFINITY) ? 0.f : -st.m);
    float pa_[4], pe_[4]; (void)quad_core<false>(sc, st, [&](int f) { return *(const LAS bf16x8*)(VF + (f * 64 + lane) * 16); }, pa_, pe_);
    __builtin_amdgcn_sched_barrier(0);
}
template <bool IMP>
__device__ __forceinline__ float quad_block_ri(const bf16x8 (&kfr)[8], const bf16x8 (&vfr)[8], const bf16x8 (&qf)[2], QS& st, int klo, int khi, int lane, float (&pa)[4], float (&pe)[4]) {
    f32x4 sc[4]; const float negm = (st.m == -INFINITY) ? 0.f : -st.m;
#pragma unroll
    for (int kt = 0; kt < 4; ++kt) { sc[kt] = (f32x4){negm, negm, negm, negm};
#pragma unroll
        for (int ks = 0; ks < 2; ++ks) sc[kt] = MFMA16(kfr[kt * 2 + ks], qf[ks], sc[kt]); }
    if (!__all(khi >= 63 && klo <= 0)) { const int g4 = lane >> 4;
#pragma unroll
        for (int kt = 0; kt < 4; ++kt)
#pragma unroll
            for (int i = 0; i < 4; ++i) { const int key = 16 * kt + 4 * g4 + i; if (key > khi || key < klo) sc[kt][i] = -INFINITY; } }
    const float mv = quad_core<IMP>(sc, st, [&](int f) { return vfr[f]; }, pa, pe);
    __builtin_amdgcn_sched_barrier(0);
    return mv;
}
__device__ __forceinline__ void quad_block_r(const bf16x8 (&kfr)[8], const bf16x8 (&vfr)[8], const bf16x8 (&qf)[2], QS& st, int klo, int khi, int lane) {
    float pa_[4], pe_[4]; (void)quad_block_ri<false>(kfr, vfr, qf, st, klo, khi, lane, pa_, pe_);
}

#define WAVE_LDS_FENCE() do { __builtin_amdgcn_wave_barrier(); asm volatile("s_waitcnt lgkmcnt(0)" ::: "memory"); } while (0)
__device__ __forceinline__ void load_frags(const unsigned char* img, int lane, bf16x8 (&fr)[8]) {
    const u32x4* p = (const u32x4*)img + lane;
#pragma unroll
    for (int f = 0; f < 8; ++f) fr[f] = __builtin_bit_cast(bf16x8, p[f * 64]);
}
__device__ __forceinline__ int nsa_lane(const Frame& F) { int l = F.lane; asm volatile("" : "+v"(l)); return l; }
__device__ __forceinline__ void nsa_unit(Frame& F, int b, int g, int c, int flags) {
    const int tid = F.tid, lane = F.lane, w = F.wave, q16 = lane & 15, g4 = lane >> 4;
    const int tq = q16 >> 2, hh = q16 & 3;
    const int tokA = 8 * w + tq, tokB = tokA + 4;
    const int tA = 64 * c + tokA, tB = tA + 4; const size_t mA = (size_t)b * SEQ + tA;
    const int bg = b * 2 + g;
    LAS unsigned char* lds = F.lds;
    LAS unsigned char* wreg = lds + w * NSA_WREG;
    LAS unsigned short* imph = (LAS unsigned short*)wreg; LAS float* ilt = (LAS float*)(lds + NSA_ILT) + w * 32;
    LAS unsigned* selm = (LAS unsigned*)(lds + NSA_SELM); LAS unsigned* qneed = (LAS unsigned*)(lds + NSA_QNEED);
    LAS unsigned* misc = (LAS unsigned*)(lds + NSA_MISC);
    unsigned char* ws = F.ws;
    bf16x8 qfA[2], qfB[2];
    { const bf16_t* Q = (const bf16_t*)(ws + WS_QN) + mA * 512 + (g * 4 + hh) * 64 + 8 * g4;
      qfA[0] = *(const bf16x8*)Q; qfA[1] = *(const bf16x8*)(Q + 32); qfB[0] = *(const bf16x8*)(Q + 4 * 512); qfB[1] = *(const bf16x8*)(Q + 4 * 512 + 32); }
    bf16_t* SO = (flags & 0x10) ? (bf16_t*)F.out : (bf16_t*)(ws + WS_RA);
#define GATE_(QD, BR) (((const float*)(ws + WS_GATE))[((size_t)b * SEQ + 64 * c + tokA + 4 * (QD)) * 24 + (g * 4 + hh) * 3 + (BR)])
#define OROW_(QD) (SO + ((size_t)b * SEQ + 64 * c + tokA + 4 * (QD)) * 512 + (g * 4 + hh) * 64)
    QS sA, sB;
    LAS f32x4* stash = (LAS f32x4*)wreg;
#define NSA_ACC1(ST, QD, GV, FIRST) do { const float sc_ = (ST).l > 0.f ? (GV) / (ST).l : 0.f; \
        _Pragma("unroll") for (int dt = 0; dt < 4; ++dt) { f32x4 a_ = (ST).o[dt] * sc_; LAS f32x4* p_ = stash + ((QD) * 4 + dt) * 64 + lane; \
            if (!(FIRST)) a_ = a_ + *p_; *p_ = a_; } } while (0)

#define NMAXA_ ((64 * c + tokA >= 31) ? ((64 * c + tokA - 31) >> 4) : -1)
#define NMAXB_ ((64 * c + tokB >= 31) ? ((64 * c + tokB - 31) >> 4) : -1)
    const int ncb = (((64 * c + 8 * w + 7 - 31) >> 4) >> 6) + 1;
    const unsigned char* KCb = ws + WS_KC + (size_t)bg * 16 * 8192; const unsigned char* VCb = ws + WS_VC + (size_t)bg * 16 * 8192;
    qs_init(sA); qs_init(sB);
    const bool want_imp = (c >= 16) && !(flags & 0x40);
    if (!(flags & 0x80)) { const int lane = nsa_lane(F), q16 = lane & 15, g4 = lane >> 4, tq = q16 >> 2, hh = q16 & 3, tokA = 8 * w + tq, tokB = tokA + 4; (void)q16; (void)g4; (void)tq; (void)hh; (void)tokA; (void)tokB; const int nmaxA = NMAXA_, nmaxB = NMAXB_;
        float carA = 0.f, carB = 0.f;
#pragma nounroll
        for (int kb = 0; kb < ncb; ++kb) { bf16x8 kfr[8], vfr[8]; load_frags(KCb + (size_t)kb * 8192, lane, kfr); load_frags(VCb + (size_t)kb * 8192, lane, vfr);
            if (want_imp) {
#pragma unroll
                for (int qd = 0; qd < 2; ++qd) { float pa[4], pe[4];
                    const float al = quad_block_ri<true>(kfr, vfr, qd ? qfB : qfA, qd ? sB : sA, 0, (qd ? nmaxB : nmaxA) - 64 * kb, lane, pa, pe);
                    float car = (qd ? carB : carA) * al; LAS unsigned short* hrow = imph + ((tq + 4 * qd) * 4 + hh) * NSA_IMPLD + g4;
                    if (__any(al != 1.f)) {
#pragma nounroll
                        for (int e = 0; e < 4 * kb; ++e) { LAS unsigned short* hp = hrow + 4 * e; *hp = __builtin_bit_cast(unsigned short, (_Float16)((float)__builtin_bit_cast(_Float16, *hp) * al)); } }
                    hrow += 16 * kb;
#pragma unroll
                    for (int kt = 0; kt < 4; ++kt) { const float offer = (g4 == 3) ? (kt == 0 ? car : pe[kt - 1]) : pe[kt];
                        const float got = __shfl(offer, (lane - 16) & 63);
                        hrow[4 * kt] = __builtin_bit_cast(unsigned short, (_Float16)(pa[kt] + got)); }
                    if (qd) carB = pe[3]; else carA = pe[3]; }
            } else { quad_block_r(kfr, vfr, qfA, sA, 0, nmaxA - 64 * kb, lane); quad_block_r(kfr, vfr, qfB, sB, 0, nmaxB - 64 * kb, lane); } } }
    qs_finish(sA); qs_finish(sB);
    if (want_imp) { const int lane = nsa_lane(F), q16 = lane & 15, g4 = lane >> 4, tq = q16 >> 2, hh = q16 & 3, tokA = 8 * w + tq, tokB = tokA + 4; (void)q16; (void)g4; (void)tq; (void)hh; (void)tokA; (void)tokB;
      if (g4 == 0) { ilt[tq * 4 + hh] = sA.l > 0.f ? 1.0f / sA.l : 0.f; ilt[(tq + 4) * 4 + hh] = sB.l > 0.f ? 1.0f / sB.l : 0.f; }
        WAVE_LDS_FENCE();
        { const int tk = lane >> 3, s8 = lane & 7; float v[32];
          { const LAS unsigned short* h0 = imph + (tk * 4) * NSA_IMPLD; const f32x4 il4 = *(const LAS f32x4*)(ilt + tk * 4);
#pragma unroll
            for (int i = 0; i < 32; ++i) { const int j = s8 + 8 * i; float a = -1.f;
                if (j >= 1 && j <= c - 2) a = ((float)__builtin_bit_cast(_Float16, h0[j]) * il4[0] + (float)__builtin_bit_cast(_Float16, h0[NSA_IMPLD + j]) * il4[1])
                                            + ((float)__builtin_bit_cast(_Float16, h0[2 * NSA_IMPLD + j]) * il4[2] + (float)__builtin_bit_cast(_Float16, h0[3 * NSA_IMPLD + j]) * il4[3]);
                v[i] = a; } }
          selm[(8 * w) * 8 + lane] = 0u;
          WAVE_LDS_FENCE();
#pragma nounroll
          for (int it = 0; it < ((flags & 0x400) ? 1 : 13); ++it) {
              float bv = v[0]; int bi = 0;
#pragma unroll
              for (int i = 1; i < 32; ++i) { const bool gt = v[i] > bv; bv = gt ? v[i] : bv; bi = gt ? i : bi; }
              const int j = s8 + 8 * bi;
              long long key = ((long long)__float_as_int(bv) << 32) | (long long)(unsigned)(255 - j);
#define KEYMAX_(ctrl) do { const int lo_ = __builtin_amdgcn_update_dpp(0, (int)(unsigned)key, ctrl, 0xF, 0xF, true), hi_ = __builtin_amdgcn_update_dpp(0, (int)(key >> 32), ctrl, 0xF, 0xF, true); \
                  const long long o_ = ((long long)hi_ << 32) | (long long)(unsigned)lo_; key = o_ > key ? o_ : key; } while (0)
              const long long mine = key;
              KEYMAX_(0xB1); KEYMAX_(0x4E); KEYMAX_(0x141);
#undef KEYMAX_
              const bool win = (mine == key);
              if (win) (void)__hip_atomic_fetch_or(selm + (8 * w + tk) * 8 + (j >> 5), 1u << (j & 31), __ATOMIC_RELAXED, __HIP_MEMORY_SCOPE_WORKGROUP);
#pragma unroll
              for (int i = 0; i < 32; ++i) v[i] = (win && i == bi) ? -1.f : v[i];
          }
          WAVE_LDS_FENCE();
          if (lane < 8) { LAS unsigned* sm = selm + (8 * w + lane) * 8; sm[0] |= 1u; sm[(c - 1) >> 5] |= 1u << ((c - 1) & 31); sm[c >> 5] |= 1u << (c & 31); } }
    } else { const int lane = nsa_lane(F), q16 = lane & 15, g4 = lane >> 4, tq = q16 >> 2, hh = q16 & 3, tokA = 8 * w + tq, tokB = tokA + 4; (void)q16; (void)g4; (void)tq; (void)hh; (void)tokA; (void)tokB;
        if (lane < 8) {
#pragma unroll
            for (int i = 0; i < 8; ++i) selm[(8 * w + lane) * 8 + i] = (i == 0) ? ((2u << (c < 16 ? c : 15)) - 1u) : 0u; }
    }
    { const int lane = nsa_lane(F), q16 = lane & 15, g4 = lane >> 4, tq = q16 >> 2, hh = q16 & 3, tokA = 8 * w + tq, tokB = tokA + 4; (void)q16; (void)g4; (void)tq; (void)hh; (void)tokA; (void)tokB;
    WAVE_LDS_FENCE();
    NSA_ACC1(sA, 0, GATE_(0, 0), true); NSA_ACC1(sB, 1, GATE_(1, 0), true);
    if (lane < 16) { const int qd = 2 * w + (lane >> 3), wi = lane & 7;
        qneed[qd * 8 + wi] = selm[(4 * qd + 0) * 8 + wi] | selm[(4 * qd + 1) * 8 + wi] | selm[(4 * qd + 2) * 8 + wi] | selm[(4 * qd + 3) * 8 + wi]; }
    WAVE_LDS_FENCE();
    }
    const unsigned char* KSb = ws + WS_KS + (size_t)bg * 256 * 8192; const unsigned char* VSb = ws + WS_VS + (size_t)bg * 256 * 8192;
    qs_init(sA); qs_init(sB);
    if (!(flags & 0x20)) { const int lane = nsa_lane(F), q16 = lane & 15, g4 = lane >> 4, tq = q16 >> 2, hh = q16 & 3, tokA = 8 * w + tq, tokB = tokA + 4; (void)q16; (void)g4; (void)tq; (void)hh; (void)tokA; (void)tokB;
#pragma nounroll
        for (int wi = 0; wi < 8; ++wi) {
            const unsigned nA = (unsigned)__builtin_amdgcn_readfirstlane((int)qneed[(2 * w) * 8 + wi]), nB = (unsigned)__builtin_amdgcn_readfirstlane((int)qneed[(2 * w + 1) * 8 + wi]);
            const unsigned swA = selm[tokA * 8 + wi], swB = selm[tokB * 8 + wi];
            unsigned mm = nA | nB;
#pragma nounroll
            while (mm) { const int bit = __builtin_ctz(mm); mm &= mm - 1u; const int j = 32 * wi + bit;
                bf16x8 kfr[8], vfr[8]; load_frags(KSb + (size_t)j * 8192, lane, kfr); load_frags(VSb + (size_t)j * 8192, lane, vfr);
                if ((nA >> bit) & 1u) { const int kh = ((swA >> bit) & 1u) ? ((j == c) ? tokA : 63) : -1; quad_block_r(kfr, vfr, qfA, sA, 0, kh, lane); }
                if ((nB >> bit) & 1u) { const int kh = ((swB >> bit) & 1u) ? ((j == c) ? tokB : 63) : -1; quad_block_r(kfr, vfr, qfB, sB, 0, kh, lane); }
            } } }
    qs_finish(sA); qs_finish(sB);
    { const int lane = nsa_lane(F), q16 = lane & 15, g4 = lane >> 4, tq = q16 >> 2, hh = q16 & 3, tokA = 8 * w + tq, tokB = tokA + 4; (void)q16; (void)g4; (void)tq; (void)hh; (void)tokA; (void)tokB;
    NSA_ACC1(sA, 0, GATE_(0, 1), false); NSA_ACC1(sB, 1, GATE_(1, 1), false); }
    const int jw0 = c >= 8 ? c - 8 : 0;
    const unsigned char* KWb = ws + WS_KW + (size_t)bg * 256 * 8192; const unsigned char* VWb = ws + WS_VW + (size_t)bg * 256 * 8192;
    qs_init(sA); qs_init(sB);
    if (!(flags & 0x100)) { const int lane = nsa_lane(F), q16 = lane & 15, g4 = lane >> 4, tq = q16 >> 2, hh = q16 & 3, tokA = 8 * w + tq, tokB = tokA + 4; (void)q16; (void)g4; (void)tq; (void)hh; (void)tokA; (void)tokB;
#pragma nounroll
        for (int j = jw0; j <= c; ++j) { bf16x8 kfr[8], vfr[8]; load_frags(KWb + (size_t)j * 8192, lane, kfr); load_frags(VWb + (size_t)j * 8192, lane, vfr);
            int klA = 0, khA = 63, klB = 0, khB = 63;
            if (j == c) { khA = tokA; khB = tokB; } else if (j == c - 8) { klA = tokA + 1; klB = tokB + 1; }
            quad_block_r(kfr, vfr, qfA, sA, klA, khA, lane); quad_block_r(kfr, vfr, qfB, sB, klB, khB, lane); } }
    qs_finish(sA); qs_finish(sB);
    { const int lane = nsa_lane(F), q16 = lane & 15, g4 = lane >> 4, tq = q16 >> 2, hh = q16 & 3, tokA = 8 * w + tq, tokB = tokA + 4; (void)q16; (void)g4; (void)tq; (void)hh; (void)tokA; (void)tokB; bf16_t* orowA = OROW_(0); bf16_t* orowB = OROW_(1);
      const float scA = sA.l > 0.f ? GATE_(0, 2) / sA.l : 0.f, scB = sB.l > 0.f ? GATE_(1, 2) / sB.l : 0.f;
#pragma unroll
      for (int dt = 0; dt < 4; ++dt) { const f32x4 a = stash[(0 * 4 + dt) * 64 + lane] + sA.o[dt] * scA, bq2 = stash[(1 * 4 + dt) * 64 + lane] + sB.o[dt] * scB;
          u32x2 wa; wa.x = cvtpk(a[0], a[1]); wa.y = cvtpk(a[2], a[3]); *(u32x2*)(orowA + 16 * dt + 4 * g4) = wa;
          u32x2 wb; wb.x = cvtpk(bq2[0], bq2[1]); wb.y = cvtpk(bq2[2], bq2[3]); *(u32x2*)(orowB + 16 * dt + 4 * g4) = wb; } }
#undef NSA_ACC1
#undef GATE_
#undef OROW_
#undef NMAXA_
#undef NMAXB_
    if (flags & 0x10) { __syncthreads(); return; }
    asm volatile("s_waitcnt vmcnt(0)" ::: "memory");
    __syncthreads();
    if (tid == 0) { __builtin_amdgcn_fence(__ATOMIC_RELEASE, "agent"); asm volatile("s_waitcnt vmcnt(0)" ::: "memory");
        const unsigned tk = __hip_atomic_fetch_add(F.ctl + CW_TILECNT + b * 256 + c, 1u, __ATOMIC_RELAXED, __HIP_MEMORY_SCOPE_AGENT);
        if (tk & 1u) { __builtin_amdgcn_fence(__ATOMIC_ACQUIRE, "agent"); asm volatile("s_waitcnt vmcnt(0)" ::: "memory"); }
        misc[0] = tk & 1u; }
    __syncthreads();
    if (misc[0] == 1u) { const float* gnorm = F.in[I_NSAG];
#pragma nounroll
        for (int tk = 0; tk < 8; ++tk) { const size_t mm = (size_t)b * SEQ + 64 * c + 8 * w + tk; const u32x4 rw = *((const u32x4*)(SO + mm * 512) + lane);
            const f32x4 v0 = (f32x4){bflo(rw.x), bfhi(rw.x), bflo(rw.y), bfhi(rw.y)}, v1 = (f32x4){bflo(rw.z), bfhi(rw.z), bflo(rw.w), bfhi(rw.w)};
            float ss = (v0[0] * v0[0] + v0[1] * v0[1]) + (v0[2] * v0[2] + v0[3] * v0[3]) + (v1[0] * v1[0] + v1[1] * v1[1]) + (v1[2] * v1[2] + v1[3] * v1[3]);
            ss = wave_sum(ss); const float rs = __builtin_amdgcn_rsqf(ss * (1.f / 512.f) + 1e-6f);
            const f32x4 g0 = ((const f32x4*)gnorm)[2 * lane], g1 = ((const f32x4*)gnorm)[2 * lane + 1];
            bf16_t* MX = (bf16_t*)(ws + WS_RB) + mm * 1024;
            ((u32x4*)MX)[lane] = pack8(v0 * rs * g0, v1 * rs * g1); } }
    __syncthreads();
}

__device__ __forceinline__ void cmp2_unit(Frame& F, int kv, int pm) {
    const int lane = F.lane, w = F.wave, r32 = lane & 31, hi = lane >> 5;
    const bf16_t* W2 = (const bf16_t*)(F.ws + (kv ? WS_W2V : WS_W2K)); const bf16_t* HID = (const bf16_t*)(F.ws + WS_HID) + ((size_t)kv * 4096 + pm * 256 + w * 32 + r32) * 256;
    f32x16 a0 = {}, a1 = {};
#pragma unroll
    for (int ks = 0; ks < 16; ++ks) { const bf16x8 hb = *(const bf16x8*)(HID + 16 * ks + 8 * hi);
        const bf16x8 w0 = *(const bf16x8*)(W2 + (size_t)r32 * 256 + 16 * ks + 8 * hi), w1 = *(const bf16x8*)(W2 + (size_t)(32 + r32) * 256 + 16 * ks + 8 * hi);
        a0 = MFMA32(w0, hb, a0); a1 = MFMA32(w1, hb, a1); }
    const int bg = pm >> 2, i = (pm & 3) * 256 + w * 32 + r32, blk = i >> 6, key = i & 63;
    unsigned char* img = F.ws + (kv ? WS_VC : WS_KC) + (size_t)(bg * 16 + blk) * 8192;
    if (i == 1023) { a0 = (f32x16){}; a1 = (f32x16){}; }
#pragma unroll
    for (int k = 0; k < 4; ++k) { u32x2 o0, o1; o0.x = cvtpk(a0[4 * k], a0[4 * k + 1]); o0.y = cvtpk(a0[4 * k + 2], a0[4 * k + 3]); o1.x = cvtpk(a1[4 * k], a1[4 * k + 1]); o1.y = cvtpk(a1[4 * k + 2], a1[4 * k + 3]);
        const int d0 = 8 * k + 4 * hi, d1 = 32 + d0;
        if (kv == 0) { *(u32x2*)(img + kf_off(key, d0)) = o0; *(u32x2*)(img + kf_off(key, d1)) = o1; }
        else { *(bf16_t*)(img + vf_off(key, d0)) = (bf16_t)(o0.x & 0xffffu); *(bf16_t*)(img + vf_off(key, d0 + 1)) = (bf16_t)(o0.x >> 16); *(bf16_t*)(img + vf_off(key, d0 + 2)) = (bf16_t)(o0.y & 0xffffu); *(bf16_t*)(img + vf_off(key, d0 + 3)) = (bf16_t)(o0.y >> 16);
               *(bf16_t*)(img + vf_off(key, d1)) = (bf16_t)(o1.x & 0xffffu); *(bf16_t*)(img + vf_off(key, d1 + 1)) = (bf16_t)(o1.x >> 16); *(bf16_t*)(img + vf_off(key, d1 + 2)) = (bf16_t)(o1.y & 0xffffu); *(bf16_t*)(img + vf_off(key, d1 + 3)) = (bf16_t)(o1.y >> 16); } }
}

__device__ __forceinline__ void xattn_phase(Frame& F, int ul0, int ul1, int ul2, int ul3, int nun) {
    const int w = F.wave, tg = w >> 1, dh = w & 1;
    LAS unsigned char* lds = F.lds;
    const int nsteps = 4 * nun;
    if (nsteps <= 0) return;
#define XA_UNIT(G_) ((G_) == 0 ? ul0 : (G_) == 1 ? ul1 : (G_) == 2 ? ul2 : ul3)
#define XA_SRC(S, I) ({ const int u_ = XA_UNIT((S) >> 2), bh_ = u_ >> 7, kb_ = (S) & 3; \
        (const u32x4*)(F.ws + ((I) < 4 ? WS_MEMK : WS_MEMV) + ((size_t)bh_ * 4 + kb_) * 32768) + F.tid + 512 * ((I) & 3); })
    { u32x4 r[8];
#pragma unroll
      for (int i = 0; i < 8; ++i) r[i] = *XA_SRC(0, i);
#pragma unroll
      for (int i = 0; i < 8; ++i) *(LAS u32x4*)(lds + (i >> 2) * 32768 + (F.tid + 512 * (i & 3)) * 16) = r[i]; }
    __syncthreads();
    bf16x8 qr[16]; f32x16 o[4]; float mrun = -INFINITY, lrun = 0.f; bf16_t* QO = nullptr;
    for (int s = 0; s < nsteps; ++s) {
        int tid = F.tid; asm volatile("" : "+v"(tid));
        const int lane = tid & 63, r32 = lane & 31, hi = lane >> 5;
        const int u = XA_UNIT(s >> 2), tile = u & 127, bh = u >> 7, kb = s & 3;
        if (kb == 0) { const size_t m = (size_t)(bh >> 2) * SEQ + 128 * tile + 32 * tg + r32; QO = (bf16_t*)(F.ws + WS_RB) + m * 1024 + (bh & 3) * 256;
#pragma unroll
            for (int d0 = 0; d0 < 16; ++d0) qr[d0] = *(const bf16x8*)(QO + 16 * d0 + 8 * hi);
            o[0] = (f32x16){}; o[1] = (f32x16){}; o[2] = (f32x16){}; o[3] = (f32x16){}; mrun = -INFINITY; lrun = 0.f; }
        u32x4 r[8]; const bool more = (s + 1 < nsteps);
        if (more) {
#pragma unroll
            for (int i = 0; i < 8; ++i) r[i] = *XA_SRC(s + 1, i); }
        const LAS unsigned char* buf = lds + (s & 1) * 65536;
        f32x16 p0 = {}, p1 = {};
        const LAS unsigned char* kp = buf + hi * 1024 + r32 * 16;
#pragma unroll
        for (int d0 = 0; d0 < 16; ++d0) { const bf16x8 b0 = *(const LAS bf16x8*)(kp + d0 * 2048), b1 = *(const LAS bf16x8*)(kp + d0 * 2048 + 512);
            p0 = MFMA32(b0, qr[d0], p0); p1 = MFMA32(b1, qr[d0], p1); }
        const float mx = rowmax32(p0, p1), mnew = fmaxf(mrun, mx), alpha = fast_exp2(mrun - mnew); mrun = mnew;
        float sum = 0.f;
#pragma unroll
        for (int r2 = 0; r2 < 16; ++r2) { p0[r2] = fast_exp2(p0[r2] - mnew); p1[r2] = fast_exp2(p1[r2] - mnew); sum += p0[r2] + p1[r2]; }
        sum += xhalf(sum); lrun = lrun * alpha + sum;
#pragma unroll
        for (int i = 0; i < 4; ++i) o[i] = o[i] * alpha;
        u32x4 pw[4];
        pw[0] = (u32x4){cvtpk(p0[0], p0[1]), cvtpk(p0[2], p0[3]), cvtpk(p0[4], p0[5]), cvtpk(p0[6], p0[7])};
        pw[1] = (u32x4){cvtpk(p0[8], p0[9]), cvtpk(p0[10], p0[11]), cvtpk(p0[12], p0[13]), cvtpk(p0[14], p0[15])};
        pw[2] = (u32x4){cvtpk(p1[0], p1[1]), cvtpk(p1[2], p1[3]), cvtpk(p1[4], p1[5]), cvtpk(p1[6], p1[7])};
        pw[3] = (u32x4){cvtpk(p1[8], p1[9]), cvtpk(p1[10], p1[11]), cvtpk(p1[12], p1[13]), cvtpk(p1[14], p1[15])};
        const LAS unsigned char* vp = buf + 32768 + dh * 16384 + ((lane >> 4) & 1) * 32 + (lane & 3) * 8 + (4 * hi + ((lane & 15) >> 2)) * 64;
#pragma unroll
        for (int ks = 0; ks < 4; ++ks) { const bf16x8 pa = __builtin_bit_cast(bf16x8, pw[ks]);
#pragma unroll
            for (int i = 0; i < 4; ++i) { const s16x4 lo = vtr(vp + i * 4096 + ks * 1024), hh2 = vtr(vp + i * 4096 + ks * 1024 + 512);
                const bf16x8 vf = (bf16x8){lo[0], lo[1], lo[2], lo[3], hh2[0], hh2[1], hh2[2], hh2[3]}; o[i] = MFMA32(vf, pa, o[i]); } }
        if (more) { LAS unsigned char* nb = lds + ((s + 1) & 1) * 65536;
#pragma unroll
            for (int i = 0; i < 8; ++i) *(LAS u32x4*)(nb + (i >> 2) * 32768 + (tid + 512 * (i & 3)) * 16) = r[i]; }
        __syncthreads();
        if (kb == 3) { const float inv = 1.0f / lrun;
#pragma unroll
            for (int i = 0; i < 4; ++i)
#pragma unroll
                for (int k = 0; k < 4; ++k) { u32x2 ov; ov.x = cvtpk(o[i][4 * k] * inv, o[i][4 * k + 1] * inv); ov.y = cvtpk(o[i][4 * k + 2] * inv, o[i][4 * k + 3] * inv);
                    *(u32x2*)(QO + 128 * dh + 32 * i + 8 * k + 4 * hi) = ov; } }
    }
#undef XA_SRC
#undef XA_UNIT
}
__device__ __forceinline__ void router_phase(Frame& F, LAS unsigned* rl, LAS unsigned* lcnt, bool skip) {
    const int lane = F.lane, w = F.wave, r16 = lane & 15, q4 = lane >> 4;
    LAS float* gb = (LAS float*)F.lds; LAS float* lg = (LAS float*)(F.lds + 8192 + w * 3072);
    for (int i = F.tid; i < 1024; i += NTHR) { gb[i] = F.in[I_LN2G][i]; gb[1024 + i] = F.in[I_LN2B][i]; }
    __syncthreads();
    const bf16_t* WH = (const bf16_t*)(F.ws + WS_WRH); const bf16_t* WL = (const bf16_t*)(F.ws + WS_WRL);
    const int gwv = F.bid * NWAVES + w, NGWv = F.G * NWAVES;
    int kslot = 0;
    for (int tg = gwv; tg < (skip ? 0 : NTOK / 16); tg += NGWv, ++kslot) {
        const int m = tg * 16 + r16;
        const f32x2 st = *(const f32x2*)((const float*)(F.ws + WS_STAT2) + (size_t)m * 2);
        const float mean = st[0] * (1.f / 1024.f), rstd = 1.0f / sqrtf(fmaxf(st[1] * (1.f / 1024.f) - mean * mean, 0.f) + 1e-5f);
        const bf16_t* xrow = (const bf16_t*)(F.ws + WS_RA) + (size_t)m * 1024 + 8 * q4;
        f32x4 acc[3]; acc[0] = (f32x4){0.f, 0.f, 0.f, 0.f}; acc[1] = acc[0]; acc[2] = acc[0];
#pragma unroll 2
        for (int s = 0; s < 32; ++s) {
            const u32x4 xw = *(const u32x4*)(xrow + 32 * s);
            const LAS f32x4* gp = (const LAS f32x4*)(gb + 32 * s + 8 * q4); const LAS f32x4* bp = (const LAS f32x4*)(gb + 1024 + 32 * s + 8 * q4);
            const f32x4 g0 = gp[0], g1 = gp[1], b0 = bp[0], b1 = bp[1];
            const f32x4 x0 = ((f32x4){bflo(xw.x), bfhi(xw.x), bflo(xw.y), bfhi(xw.y)} - mean) * rstd * g0 + b0, x1 = ((f32x4){bflo(xw.z), bfhi(xw.z), bflo(xw.w), bfhi(xw.w)} - mean) * rstd * g1 + b1;
            const u32x4 hw = pack8(x0, x1);
            const f32x4 h0 = (f32x4){bflo(hw.x), bfhi(hw.x), bflo(hw.y), bfhi(hw.y)}, h1 = (f32x4){bflo(hw.z), bfhi(hw.z), bflo(hw.w), bfhi(hw.w)};
            const u32x4 lw = pack8(x0 - h0, x1 - h1);
            const bf16x8 ah = __builtin_bit_cast(bf16x8, hw), al = __builtin_bit_cast(bf16x8, lw);
#pragma unroll
            for (int ct = 0; ct < 3; ++ct) { const size_t wo = (size_t)(16 * ct + r16) * 1024 + 32 * s + 8 * q4;
                const bf16x8 bh = *(const bf16x8*)(WH + wo), bl = *(const bf16x8*)(WL + wo);
                acc[ct] = MFMA16(ah, bh, acc[ct]); acc[ct] = MFMA16(ah, bl, acc[ct]); acc[ct] = MFMA16(al, bh, acc[ct]); }
        }
#pragma unroll
        for (int ct = 0; ct < 3; ++ct)
#pragma unroll
            for (int i = 0; i < 4; ++i) lg[(4 * q4 + i) * 48 + 16 * ct + r16] = acc[ct][i];
        WAVE_LDS_FENCE();
        if (lane < 16) { const LAS float* L = lg + lane * 48; const int t = tg * 16 + lane;
            float gl[4];
#pragma unroll
            for (int i = 0; i < 4; ++i) gl[i] = L[i] + F.in[I_MBG][i];
            int gi = 0; float gm = gl[0];
#pragma unroll
            for (int i = 1; i < 4; ++i) if (gl[i] > gm) { gm = gl[i]; gi = i; }
            float gden = 0.f;
#pragma unroll
            for (int i = 0; i < 4; ++i) gden += __expf(gl[i] - gm);
            const float gw = 1.0f / gden;
            float el[8];
#pragma unroll
            for (int e = 0; e < 8; ++e) el[e] = L[4 + gi * 8 + e] + F.in[I_MBE][gi * 8 + e];
            int i0 = 0; float m0 = el[0];
#pragma unroll
            for (int i = 1; i < 8; ++i) if (el[i] > m0) { m0 = el[i]; i0 = i; }
            int i1 = -1; float m1 = -INFINITY;
#pragma unroll
            for (int i = 0; i < 8; ++i) if (i != i0 && el[i] > m1) { m1 = el[i]; i1 = i; }
            const float e1 = __expf(m1 - m0), w0 = 1.0f / (1.0f + e1), w1 = e1 * w0;
            const unsigned ea = (unsigned)(gi * 8 + i0), eb = (unsigned)(gi * 8 + i1);
            LAS unsigned* r = rl + 4 * (w * 24 + kslot * 16 + lane);
            r[0] = ea; r[1] = eb;
            r[2] = __hip_atomic_fetch_add(lcnt + ea, 1u, __ATOMIC_RELAXED, __HIP_MEMORY_SCOPE_WORKGROUP);
            r[3] = __hip_atomic_fetch_add(lcnt + eb, 1u, __ATOMIC_RELAXED, __HIP_MEMORY_SCOPE_WORKGROUP);
            *(f32x2*)(F.ws + WS_ROUTEW + (size_t)t * 8) = (f32x2){gw * w0, gw * w1}; }
        WAVE_LDS_FENCE();
    }
}

constexpr int MOE_LDS = LDS_MISC + 1024;
__device__ __forceinline__ void moe_offsets(Frame& F) {
    LAS unsigned* off = (LAS unsigned*)(F.lds + MOE_LDS); LAS unsigned* tmp = off + 64;
    if (F.tid < 32) tmp[F.tid] = (__hip_atomic_load(F.ctl + CW_ECNT + 32 * F.tid, __ATOMIC_RELAXED, __HIP_MEMORY_SCOPE_AGENT) + 255u) & ~255u;
    __syncthreads();
    if (F.tid == 0) { unsigned s = 0;
#pragma unroll
        for (int e = 0; e < 32; ++e) { off[e] = s; s += tmp[e]; }
        off[32] = s; }
    __syncthreads();
    if (F.tid < 288) { const unsigned slot0 = (unsigned)F.tid << 8; int e = 0;
#pragma unroll
        for (int k = 1; k < 32; ++k) e = (off[k] <= slot0) ? k : e;
        off[128 + F.tid] = (unsigned)e; }
    __syncthreads();
}
struct MoeOrder {
    const char* A; const char* W; size_t atile, wexp, wtile; const LAS unsigned* off; int G, c;
    __device__ __forceinline__ bool next(int i, pg8::Unit& u) const {
        const unsigned L = (unsigned)(i * G + c), ntile = off[32] >> 8; if (L >= ntile * 4u) return false;
        const unsigned mt = L >> 2, pn = L & 3u; const int e = (int)off[128 + mt];
        u.pm = (int)mt; u.pn = (int)pn; u.aux = e; u.a = A + (size_t)mt * atile; u.b = W + (size_t)e * wexp + (size_t)pn * wtile; return true;
    }
};
#define XB_TMO      128
#define XB_XCNT(j)  (256  + 64 * (j))
#define XB_XSUB(j)  (1280 + 64 * (j))
#define XB_XGEN(j)  (2304 + 64 * (j))
#define XB_TOP      3328
#define XB_TOPGEN   3392
#define XCD_BAR_WORDS 4096
#define XB_SPIN_CAP (1u << 22)
__device__ __forceinline__ unsigned xb_ld(unsigned* p)              { return __hip_atomic_load(p, __ATOMIC_RELAXED, __HIP_MEMORY_SCOPE_AGENT); }
__device__ __forceinline__ unsigned xb_add(unsigned* p, unsigned v) { return __hip_atomic_fetch_add(p, v, __ATOMIC_RELAXED, __HIP_MEMORY_SCOPE_AGENT); }
__device__ __forceinline__ unsigned xb_xcc_id() { return (unsigned)__builtin_amdgcn_s_getreg((3 << 11) | 20) & 0xFu; }
#define XB_SPIN(cond, bar) do { unsigned _sp = 0; while (cond) { __builtin_amdgcn_s_sleep(1); \
    if ((++_sp & 255u) == 0u) { if (xb_ld(&(bar)[XB_TMO])) break; if (_sp > XB_SPIN_CAP) { atomicAdd(&(bar)[XB_TMO], 1u); break; } } } } while (0)
struct XcdBarrier { unsigned* bar; unsigned x; volatile LAS unsigned* st; };
__device__ __forceinline__ XcdBarrier xcd_barrier_post(unsigned* bar, volatile LAS unsigned* st) {
    XcdBarrier b; b.bar = bar; b.x = xb_xcc_id(); b.st = st;
    if (threadIdx.x == 0) (void)xb_add(&bar[XB_XCNT(b.x)], 1u);
    return b;
}
__device__ __forceinline__ void xcd_barrier_complete(unsigned* bar, unsigned x, unsigned& nloc, unsigned& nx) {
    const unsigned G = gridDim.x * gridDim.y * gridDim.z;
    unsigned sum, cnt, mine, sp = 0u;
    for (;;) {
        sum = 0u; cnt = 0u; mine = 0u;
#pragma unroll
        for (unsigned j = 0; j < 16; ++j) { const unsigned c = xb_ld(&bar[XB_XCNT(j)]); sum += c; cnt += (c > 0u) ? 1u : 0u; mine = (j == x) ? c : mine; }
        if (sum == G) break;
        __builtin_amdgcn_s_sleep(1);
        if ((++sp & 255u) == 0u) { if (xb_ld(&bar[XB_TMO])) break; if (sp > XB_SPIN_CAP) { atomicAdd(&bar[XB_TMO], 1u); break; } }
    }
    nloc = mine > 0u ? mine : 1u; nx = cnt > 0u ? cnt : 1u;
}
__device__ __forceinline__ void xcd_barrier(const XcdBarrier& b) {
    asm volatile("s_waitcnt vmcnt(0)" ::: "memory");
    __syncthreads();
    if (threadIdx.x == 0) {
        unsigned* bar = b.bar;
        __builtin_amdgcn_s_waitcnt(0);
        unsigned nloc = b.st[0], nx = b.st[1];
        if (nloc == 0u) { xcd_barrier_complete(bar, b.x, nloc, nx); b.st[0] = nloc; b.st[1] = nx; }
        const unsigned old = xb_add(&bar[XB_XSUB(b.x)], 1u);
        const unsigned gen = old / nloc;
        if (old + 1u == (gen + 1u) * nloc) {
            __builtin_amdgcn_fence(__ATOMIC_RELEASE, "agent");
            asm volatile("s_waitcnt vmcnt(0)" ::: "memory");
            const unsigned og = xb_add(&bar[XB_TOP], 1u);
            const unsigned tg = og / nx;
            if (og + 1u == (tg + 1u) * nx) xb_add(&bar[XB_TOPGEN], 1u);
            else XB_SPIN(xb_ld(&bar[XB_TOPGEN]) == tg, bar);
            __builtin_amdgcn_fence(__ATOMIC_ACQUIRE, "agent");
            xb_add(&bar[XB_XGEN(b.x)], 1u);
            asm volatile("s_waitcnt vmcnt(0)" ::: "memory");
        } else {
            XB_SPIN(xb_ld(&bar[XB_XGEN(b.x)]) == gen, bar);
            __builtin_amdgcn_fence(__ATOMIC_ACQUIRE, "agent");
            asm volatile("s_waitcnt vmcnt(0)" ::: "memory");
        }
    }
    __syncthreads();
}

#ifndef REP_P4
#define REP_P4 1
#endif
#ifndef NSA_CALL
#define NSA_CALL nsa_unit(F, bg >> 1, bg & 1, c, args.rep);
#endif
#ifndef HGC_CALL
#define HGC_CALL ;
#endif
struct OneUnit { pg8::Unit u; __device__ __forceinline__ bool next(int i, pg8::Unit& o) const { if (i > 0) return false; o = u; return true; } };

__device__ __forceinline__ int queue_next(Frame& F, int cw) {
    LAS unsigned* mw = (LAS unsigned*)(F.lds + LDS_MISC);
    __syncthreads();
    if (F.tid == 0) mw[0] = __hip_atomic_fetch_add(F.ctl + cw, 1u, __ATOMIC_RELAXED, __HIP_MEMORY_SCOPE_AGENT);
    __syncthreads();
    return (int)mw[0];
}
__device__ __forceinline__ void ln_vals(f32x4 (&v)[4], const float* g, const float* b, int lane) {
    float s = 0.f;
#pragma unroll
    for (int j = 0; j < 4; ++j) s += (v[j][0] + v[j][1]) + (v[j][2] + v[j][3]);
    const float mean = wave_sum(s) * (1.f / 1024.f); float s2 = 0.f;
#pragma unroll
    for (int j = 0; j < 4; ++j) { v[j] = v[j] - mean; s2 += (v[j][0] * v[j][0] + v[j][1] * v[j][1]) + (v[j][2] * v[j][2] + v[j][3] * v[j][3]); }
    const float rstd = 1.0f / sqrtf(wave_sum(s2) * (1.f / 1024.f) + 1e-5f);
#pragma unroll
    for (int j = 0; j < 4; ++j) { const f32x4 gg = ((const f32x4*)g)[lane + 64 * j], bb = ((const f32x4*)b)[lane + 64 * j]; v[j] = v[j] * rstd * gg + bb; }
}

constexpr int N_PHASES_ = 15;
__device__ __forceinline__ void ln2_row(Frame& F, int m, f32x4 (&y)[4]) {
    float mean, rstd; row_stats((const float*)(F.ws + WS_STAT2), (size_t)m, mean, rstd);
    const u32x2* xr = (const u32x2*)((const bf16_t*)(F.ws + WS_RA) + (size_t)m * 1024) + F.lane; const f32x4* g = (const f32x4*)F.in[I_LN2G] + F.lane; const f32x4* b = (const f32x4*)F.in[I_LN2B] + F.lane;
#pragma unroll
    for (int j = 0; j < 4; ++j) { const u32x2 w = xr[64 * j]; y[j] = ((f32x4){bflo(w.x), bfhi(w.x), bflo(w.y), bfhi(w.y)} - mean) * rstd * g[64 * j] + b[64 * j]; }
}
__global__ void __launch_bounds__(NTHR, 2) mk_fwd(Args args) {
    extern __shared__ __attribute__((aligned(16))) unsigned char lds_raw[];
    cg::grid_group grid = cg::this_grid();
    Frame F;
    F.lds = (LAS unsigned char*)lds_raw; F.ws = args.ws; F.ctl = (unsigned*)(args.ws + WS_CTL); F.in = args.in; F.out = args.out;
    F.tid = threadIdx.x; F.lane = F.tid & 63; F.wave = __builtin_amdgcn_readfirstlane(F.tid >> 6); F.G = gridDim.x; F.bid = blockIdx.x;
    unsigned char* ws = args.ws;
    const int lo = args.ph_lo, hi = args.ph_hi;
    if (lo == -12345) grid.sync();
    if (F.tid < 4) ((LAS unsigned*)(F.lds + LDS_MISC))[16 + F.tid] = 0u;
    __syncthreads();
    const XcdBarrier xbar = xcd_barrier_post(F.ctl + CW_BAR + args.li * XCD_BAR_WORDS, (volatile LAS unsigned*)(F.lds + LDS_MISC) + 16);
    const int gw = F.bid * NWAVES + F.wave, NGW = F.G * NWAVES;
#ifndef PH_MASK
#define PH_MASK 0x7fff
#endif
#define IN(k) (((PH_MASK >> (k)) & 1) && lo <= (k) && (k) < hi)
#define SEAM(k) do { if (IN(k) && (IN((k) + 1) || ((k) == 5 && IN(7)) || ((k) == 7 && IN(9)))) xcd_barrier(xbar); } while (0)

    if (IN(0)) { p0_prep(F); } SEAM(0);
    if (IN(1)) {
        pg8::GridOrder S{(const char*)(ws + WS_RA), (const char*)(ws + WS_WIN), (size_t)256 * 1024 * 2, (size_t)256 * 1024 * 2, 128, 14, 128 * 14, F.G, F.bid};
        EpiInproj E{ws, (const float*)(ws + WS_LB), (args.rep & 0x200) ? 1 : 0};
        pg8::gemm_phase(F.lds, 1024, 1024, 1024, S, E);
    } SEAM(1);
    if (IN(2)) {
        for (int u = F.bid; u < ((args.rep & 0x4000) ? 0 : 48); u += F.G) {
            if (u < 32) { const int kv = u >> 4, pm = u & 15; OneUnit S; S.u.a = (const char*)(ws + (kv ? WS_VCIN : WS_KCIN)) + (size_t)pm * 256 * 1024 * 2; S.u.b = (const char*)(ws + (kv ? WS_W1V : WS_W1K)); S.u.pm = pm; S.u.pn = 0; S.u.aux = kv;
                EpiCmp1 E{ws}; pg8::gemm_phase(F.lds, 2048, 1024, 2048, S, E); }
            else { const int idx = u - 32, pm = idx >> 3, pn = idx & 7; OneUnit S; S.u.a = (const char*)(ws + WS_MEMB) + (size_t)pm * 256 * 1024 * 2; S.u.b = (const char*)(ws + WS_WK) + (size_t)pn * 256 * 1024 * 2; S.u.pm = pm; S.u.pn = pn; S.u.aux = 0;
                EpiMemKV E{ws}; pg8::gemm_phase(F.lds, 1024, 1024, 1024, S, E); }
        }
        { const int cw = CW_Q2 + 2 * (args.rep & 3); hgrn_a_loop(F, [&]() { const int u = queue_next(F, cw); return u < 2048 ? u : -1; }); }
    } SEAM(2);
    if (IN(3)) {
        for (int u = F.bid; u < 32; u += F.G) cmp2_unit(F, u >> 4, u & 15);
        hgrn_b(F);
    } SEAM(3);
    if (IN(4)) {
        if ((args.rep & 3) != 3) { const int bg0 = (int)(xb_xcc_id() & 3u);
            for (int kq = 0; kq < 4; ++kq) { const int bg = (bg0 + kq) & 3;
                for (;;) { const int tk = queue_next(F, CW_Q4 + 16 * (args.rep & 3) + bg); if (tk >= 256) break; const int c = 255 - tk; NSA_CALL } } }
        if (!(args.rep & 0x10) && (args.rep & 3) != 2) { const int cw = CW_Q4B + 16 * (args.rep & 3); hgrn_c_loop(F, [&]() { const int u = queue_next(F, cw); return u < 2048 ? u : -1; }); }
    } SEAM(4);
    if (IN(5)) {
        pg8::GridOrder S{(const char*)(ws + WS_RB), (const char*)(ws + WS_WOUT), (size_t)256 * 1024 * 2, (size_t)256 * 1024 * 2, 128, 4, 512, F.G, F.bid};
        EpiRes<0> E{F.in[I_X], nullptr, (bf16_t*)(ws + WS_RA), (float*)(ws + WS_STAT1), nullptr, nullptr, nullptr};
        pg8::gemm_phase(F.lds, 1024, 1024, 1024, S, E);
    } SEAM(5);
    if (IN(7)) {
        pg8::GridOrder S{(const char*)(ws + WS_RA), (const char*)(ws + WS_WQ), (size_t)256 * 1024 * 2, (size_t)256 * 1024 * 2, 128, 4, 512, F.G, F.bid};
        EpiQLn E{(bf16_t*)(ws + WS_RB), (const float*)(ws + WS_STAT1), (const float*)(ws + WS_QCS), (const float*)(ws + WS_QBQ), (args.rep & 0x200) ? 1 : 0};
        pg8::gemm_phase(F.lds, 1024, 1024, 1024, S, E);
        asm volatile("s_waitcnt vmcnt(0)" ::: "memory"); __syncthreads();
        { int a0 = 0, a1 = 0, a2 = 0, a3 = 0, nun = 0; pg8::Unit u0, u1;
          if (S.next(0, u0)) { const int b = u0.pm >> 6, t0 = (u0.pm & 63) * 2; a0 = (b * 4 + u0.pn) * 128 + t0; a1 = a0 + 1; nun = 2;
              if (S.next(1, u1)) { const int b1 = u1.pm >> 6, t1 = (u1.pm & 63) * 2; a2 = (b1 * 4 + u1.pn) * 128 + t1; a3 = a2 + 1; nun = 4; } }
          xattn_phase(F, a0, a1, a2, a3, nun); }
    } SEAM(8);
    if (IN(9)) {
        pg8::GridOrder S{(const char*)(ws + WS_RB), (const char*)(ws + WS_WO), (size_t)256 * 1024 * 2, (size_t)256 * 1024 * 2, 128, 4, 512, F.G, F.bid};
        EpiRes<1> E{nullptr, (const bf16_t*)(ws + WS_RA), (bf16_t*)(ws + WS_RA), (float*)(ws + WS_STAT2), (const float*)(ws + WS_STAT1), F.in[I_LN1G], F.in[I_LN1B]};
        pg8::gemm_phase(F.lds, 1024, 1024, 1024, S, E);
    } SEAM(9);
    if (IN(10)) {
        LAS unsigned* rl = (LAS unsigned*)(F.lds + LDS_MISC + 1024);
        LAS unsigned* lcnt = rl + 4 * 192; LAS unsigned* lbase = lcnt + 32;
        if (F.tid < 32) lcnt[F.tid] = 0u;
        __syncthreads();
        const bool skip = (args.rep & 0x800) != 0;
        router_phase(F, rl, lcnt, skip);
        __syncthreads();
        if (F.tid < 32) lbase[F.tid] = __hip_atomic_fetch_add(F.ctl + CW_ECNT + 32 * (32 * (args.rep & 1) + F.tid), lcnt[F.tid], __ATOMIC_RELAXED, __HIP_MEMORY_SCOPE_AGENT);
        __syncthreads();
        { int kslot = 0;
          for (int tg = gw; tg < (skip ? 0 : NTOK / 16); tg += NGW, ++kslot) if (F.lane < 16) { const LAS unsigned* r = rl + 4 * (F.wave * 24 + kslot * 16 + F.lane);
              *(u32x4*)(ws + WS_ROUTE + (size_t)(tg * 16 + F.lane) * 16) = (u32x4){r[0], r[1], lbase[r[0]] + r[2], lbase[r[1]] + r[3]}; } }
        __syncthreads();
    } SEAM(10);
    if (IN(11)) {
        moe_offsets(F);
        const LAS unsigned* off = (const LAS unsigned*)(F.lds + MOE_LDS);
        const f32x4* g2 = (const f32x4*)F.in[I_LN2G] + F.lane; const f32x4* b2p = (const f32x4*)F.in[I_LN2B] + F.lane;
        f32x4 gq[4], bq4[4];
#pragma unroll
        for (int j = 0; j < 4; ++j) { gq[j] = g2[64 * j]; bq4[j] = b2p[64 * j]; }
        for (int m0 = gw; m0 < NTOK; m0 += 4 * NGW) {
            u32x4 r[4]; f32x2 wv[4], st[4]; u32x2 xw[4][4];
#pragma unroll
            for (int q = 0; q < 4; ++q) { const int m = m0 + q * NGW; if (m < NTOK) { r[q] = *(const u32x4*)(ws + WS_ROUTE + (size_t)m * 16); wv[q] = *(const f32x2*)(ws + WS_ROUTEW + (size_t)m * 8);
                st[q] = *(const f32x2*)((const float*)(ws + WS_STAT2) + (size_t)m * 2); const u32x2* xr = (const u32x2*)((const bf16_t*)(ws + WS_RA) + (size_t)m * 1024) + F.lane;
#pragma unroll
                for (int j = 0; j < 4; ++j) xw[q][j] = xr[64 * j]; } }
#pragma unroll
            for (int q = 0; q < 4; ++q) { const int m = m0 + q * NGW; if (m < NTOK) {
                const unsigned s0 = off[r[q].x] + r[q].z, s1 = off[r[q].y] + r[q].w;
                const float mean = st[q][0] * (1.f / 1024.f), rstd = 1.0f / sqrtf(fmaxf(st[q][1] * (1.f / 1024.f) - mean * mean, 0.f) + 1e-5f);
                u32x2* d0 = (u32x2*)((bf16_t*)(ws + WS_XG) + (size_t)s0 * 1024); u32x2* d1 = (u32x2*)((bf16_t*)(ws + WS_XG) + (size_t)s1 * 1024);
#pragma unroll
                for (int j = 0; j < 4; ++j) { const u32x2 w = xw[q][j]; const f32x4 y = ((f32x4){bflo(w.x), bfhi(w.x), bflo(w.y), bfhi(w.y)} - mean) * rstd * gq[j] + bq4[j];
                    u32x2 o; o.x = cvtpk(y[0], y[1]); o.y = cvtpk(y[2], y[3]); d0[F.lane + 64 * j] = o; d1[F.lane + 64 * j] = o; }
                if (F.lane == 0) { *(u32x2*)(ws + WS_TOKSLOT + (size_t)m * 8) = (u32x2){s0, s1}; ((float*)(ws + WS_SLOTW))[s0] = wv[q][0]; ((float*)(ws + WS_SLOTW))[s1] = wv[q][1]; } } }
        }
    } SEAM(11);
    if (IN(12)) {
        moe_offsets(F);
        MoeOrder S{(const char*)(ws + WS_XG), (const char*)(ws + WS_WGU), (size_t)256 * 1024 * 2, (size_t)1024 * 1024 * 2, (size_t)256 * 1024 * 2, (const LAS unsigned*)(F.lds + MOE_LDS), F.G, F.bid};
        EpiGateUp E{(bf16_t*)(ws + WS_HIDM)};
        pg8::gemm_phase(F.lds, 1024, 1024, 1024, S, E);
    } SEAM(12);
    if (IN(13)) {
        moe_offsets(F);
        MoeOrder S{(const char*)(ws + WS_HIDM), (const char*)(ws + WS_WD), (size_t)256 * 512 * 2, (size_t)1024 * 512 * 2, (size_t)256 * 512 * 2, (const LAS unsigned*)(F.lds + MOE_LDS), F.G, F.bid};
        EpiDown E{(bf16_t*)(ws + WS_XG), (const float*)(ws + WS_SLOTW)};
        pg8::gemm_phase(F.lds, 512, 512, 512, S, E);
    } SEAM(13);
    if (IN(14)) {
        const f32x4* g2 = (const f32x4*)F.in[I_LN2G] + F.lane; const f32x4* b2p = (const f32x4*)F.in[I_LN2B] + F.lane;
        const f32x4* g3 = (const f32x4*)F.in[I_LN3G] + F.lane; const f32x4* b3p = (const f32x4*)F.in[I_LN3B] + F.lane;
        for (int m0 = gw; m0 < NTOK; m0 += 2 * NGW) {
            u32x2 xw[2][4], ya[2][4], yb[2][4]; f32x2 st[2];
#pragma unroll
            for (int q = 0; q < 2; ++q) { const int m = m0 + q * NGW; if (m < NTOK) { const u32x2 sl = *(const u32x2*)(ws + WS_TOKSLOT + (size_t)m * 8);
                st[q] = *(const f32x2*)((const float*)(ws + WS_STAT2) + (size_t)m * 2); const u32x2* xr = (const u32x2*)((const bf16_t*)(ws + WS_RA) + (size_t)m * 1024) + F.lane;
                const u32x2* y0 = (const u32x2*)((const bf16_t*)(ws + WS_XG) + (size_t)sl.x * 1024) + F.lane; const u32x2* y1 = (const u32x2*)((const bf16_t*)(ws + WS_XG) + (size_t)sl.y * 1024) + F.lane;
#pragma unroll
                for (int j = 0; j < 4; ++j) { xw[q][j] = xr[64 * j]; ya[q][j] = y0[64 * j]; yb[q][j] = y1[64 * j]; } } }
            f32x4 v[2][4];
#pragma unroll
            for (int q = 0; q < 2; ++q) { const float mean = st[q][0] * (1.f / 1024.f), rstd = 1.0f / sqrtf(fmaxf(st[q][1] * (1.f / 1024.f) - mean * mean, 0.f) + 1e-5f);
#pragma unroll
                for (int j = 0; j < 4; ++j) { const u32x2 w = xw[q][j], a = ya[q][j], b2 = yb[q][j]; const f32x4 x = ((f32x4){bflo(w.x), bfhi(w.x), bflo(w.y), bfhi(w.y)} - mean) * rstd * g2[64 * j] + b2p[64 * j];
                    v[q][j] = x * ALPHA + (f32x4){bflo(a.x) + bflo(b2.x), bfhi(a.x) + bfhi(b2.x), bflo(a.y) + bflo(b2.y), bfhi(a.y) + bfhi(b2.y)}; } }
            float s[2], s2[2], mean3[2], rstd3[2];
#pragma unroll
            for (int q = 0; q < 2; ++q) { s[q] = 0.f;
#pragma unroll
                for (int j = 0; j < 4; ++j) s[q] += (v[q][j][0] + v[q][j][1]) + (v[q][j][2] + v[q][j][3]); }
#pragma unroll
            for (int o = 1; o < 64; o <<= 1) { s[0] += __shfl_xor(s[0], o); s[1] += __shfl_xor(s[1], o); }
#pragma unroll
            for (int q = 0; q < 2; ++q) { mean3[q] = s[q] * (1.f / 1024.f); s2[q] = 0.f;
#pragma unroll
                for (int j = 0; j < 4; ++j) { v[q][j] = v[q][j] - mean3[q]; s2[q] += (v[q][j][0] * v[q][j][0] + v[q][j][1] * v[q][j][1]) + (v[q][j][2] * v[q][j][2] + v[q][j][3] * v[q][j][3]); } }
#pragma unroll
            for (int o = 1; o < 64; o <<= 1) { s2[0] += __shfl_xor(s2[0], o); s2[1] += __shfl_xor(s2[1], o); }
#pragma unroll
            for (int q = 0; q < 2; ++q) { const int m = m0 + q * NGW; rstd3[q] = 1.0f / sqrtf(s2[q] * (1.f / 1024.f) + 1e-5f);
                if (m < NTOK) {
#pragma unroll
                    for (int j = 0; j < 4; ++j) ((f32x4*)(F.out + (size_t)m * 1024))[F.lane + 64 * j] = v[q][j] * rstd3[q] * g3[64 * j] + b3p[64 * j]; } }
        }
    }
#ifdef PROBE_SYNCS
    if (hi == N_PHASES_) { for (int i = 0; i < PROBE_SYNCS; ++i) xcd_barrier(xbar); }
#endif
#undef IN
#undef SEAM
}

#ifndef MK_N_LAUNCHES
#define MK_N_LAUNCHES 1
#endif
constexpr int N_PHASES = 15;
extern "C" void kernel_launch(void* const* d_in, const int* in_sizes, int n_in, void* d_out, int out_size, void* d_ws, size_t ws_size, hipStream_t stream) {
    static int grid = 0;
    if (grid == 0) {
        if (n_in != 30 || ws_size < WS_TOTAL) { fprintf(stderr, "kernel_launch: unexpected n_in %d / ws %zu\n", n_in, ws_size); grid = -1; return; }
        int dev = 0, cus = 0, per_cu = 0;
        (void)hipGetDevice(&dev); (void)hipDeviceGetAttribute(&cus, hipDeviceAttributeMultiprocessorCount, dev);
        (void)hipFuncSetAttribute((const void*)mk_fwd, hipFuncAttributeMaxDynamicSharedMemorySize, LDS_BYTES);
        (void)hipOccupancyMaxActiveBlocksPerMultiprocessor(&per_cu, (const void*)mk_fwd, NTHR, LDS_BYTES);
        if (per_cu < 1) { fprintf(stderr, "kernel_launch: occupancy query says %d blocks per CU\n", per_cu); per_cu = 1; }
        grid = cus * per_cu;
    }
    if (grid < 0) return;
    (void)hipMemsetAsync((char*)d_ws + WS_CTL, 0, 128 * 1024, stream);
    Args a{};
    for (int i = 0; i < 30; ++i) a.in[i] = (const float*)d_in[i];
    a.out = (float*)d_out; a.ws = (unsigned char*)d_ws;
#ifdef PROBE_PHASE
#ifndef PROBE_LO
#define PROBE_LO PROBE_PHASE
#endif
#ifndef PROBE_REP
#define PROBE_REP 1
#endif
    const int seq[3][3] = {{0, PROBE_PHASE + 1, 0}, {PROBE_LO, PROBE_PHASE + 1, PROBE_REP}, {PROBE_PHASE + 1, N_PHASES, 0}};
    const int nl = (PROBE_PHASE + 1 < N_PHASES) ? 3 : 2;
#else
    const int seq[1][3] = {{0, N_PHASES, 0}};
    const int nl = 1;
#endif
    for (int li = 0; li < nl; ++li) {
        a.ph_lo = seq[li][0]; a.ph_hi = seq[li][1]; a.rep = seq[li][2]; a.li = li;
        void* kargs[] = {&a};
        hipError_t e = hipLaunchCooperativeKernel((const void*)mk_fwd, dim3(grid), dim3(NTHR), kargs, LDS_BYTES, stream);
        if (e != hipSuccess) { fprintf(stderr, "kernel_launch: cooperative launch failed: %s (grid %d)\n", hipGetErrorString(e), grid); break; }
    }
}
```

```cpp
#include <hip/hip_runtime.h>
#include <hip/hip_cooperative_groups.h>
#include <cstdio>
#include <cstdint>
namespace cg = cooperative_groups;

#define LAS __attribute__((address_space(3)))
typedef unsigned short bf16_t;
typedef short bf16x8 __attribute__((ext_vector_type(8)));
typedef short s16x4 __attribute__((ext_vector_type(4)));
typedef float f32x2 __attribute__((ext_vector_type(2)));
typedef float f32x4 __attribute__((ext_vector_type(4)));
typedef float f32x16 __attribute__((ext_vector_type(16)));
typedef unsigned u32x2 __attribute__((ext_vector_type(2)));
typedef unsigned u32x4 __attribute__((ext_vector_type(4)));
typedef __bf16 bf16x2_t __attribute__((ext_vector_type(2)));

constexpr int NB = 2, SEQ = 16384, NTOK = NB * SEQ, DM = 1024;
constexpr int NIN = 3584;
constexpr int NSELB = SEQ / 64;
constexpr int MOE_E = 32, MOE_FF = 512, MOE_CAP = 73728;
constexpr float ALPHA = 1.189207115002721f;
constexpr float QSCALE = 0.125f * 1.4426950408889634f;
constexpr float XSCALE = 0.0625f * 1.4426950408889634f;

constexpr size_t MiB = 1u << 20;
constexpr size_t WS_CTL = 0;
constexpr size_t WS_WIN = 1 * MiB;
constexpr size_t WS_WOUT = 8 * MiB, WS_WQ = 10 * MiB, WS_WK = 12 * MiB, WS_WV = 14 * MiB, WS_WO = 16 * MiB;
constexpr size_t WS_W1K = 18 * MiB, WS_W1V = 19 * MiB;
constexpr size_t WS_SMALL = 20 * MiB;
constexpr size_t WS_W2K = WS_SMALL, WS_W2V = WS_SMALL + 32768;
constexpr size_t WS_BIASK = WS_SMALL + 65536, WS_BIASV = WS_BIASK + 1024;
constexpr size_t WS_LB = WS_BIASV + 1024;
constexpr size_t WS_WRH = WS_SMALL + 512 * 1024, WS_WRL = WS_WRH + 128 * 1024;
constexpr size_t WS_QCS = WS_SMALL + 256 * 1024, WS_QBQ = WS_QCS + 4096;
constexpr size_t WS_MEMB = 21 * MiB;
constexpr size_t WS_MEMK = 22 * MiB, WS_MEMV = 23 * MiB;
constexpr size_t WS_RA = 24 * MiB;
constexpr size_t WS_RB = 88 * MiB;
constexpr size_t WS_RC = 152 * MiB;
constexpr size_t WS_RD = 296 * MiB;
constexpr size_t WS_RE = 400 * MiB;
constexpr size_t WS_QN = WS_RC;
constexpr size_t WS_KS = WS_RC + 32 * MiB, WS_VS = WS_KS + 8 * MiB, WS_KW = WS_VS + 8 * MiB, WS_VW = WS_KW + 8 * MiB;
constexpr size_t WS_HQ = WS_RC + 64 * MiB;
constexpr size_t WS_HI = WS_RC + 96 * MiB;
constexpr size_t WS_KCIN = WS_RC + 128 * MiB, WS_VCIN = WS_RC + 136 * MiB;
constexpr size_t WS_PRE = WS_RC;
constexpr size_t WS_XG = WS_RC;
constexpr size_t WS_LOGF = WS_RD;
constexpr size_t WS_HGS = WS_RD + 64 * MiB;
constexpr size_t WS_GATE = WS_RD + 96 * MiB;
constexpr size_t WS_HID = WS_RD + 99 * MiB;
constexpr size_t WS_KC = WS_RD + 103 * MiB, WS_VC = WS_KC + 512 * 1024;
constexpr size_t WS_HIDM = WS_RD;
constexpr size_t WS_WGU = WS_RE;
constexpr size_t WS_WD = WS_RE + 64 * MiB;
constexpr int CW_Q2 = 64, CW_Q4 = 128, CW_Q4B = 192;
constexpr int CW_ECNT = 2048;
constexpr int CW_BAR = 8192;
constexpr int CW_TILECNT = 1024;
constexpr size_t WS_HD = 496 * MiB;
constexpr size_t WS_ROUTE = 497 * MiB;
constexpr size_t WS_ROUTEW = WS_ROUTE + 512 * 1024;
constexpr size_t WS_TOKSLOT = WS_ROUTEW + 256 * 1024;
constexpr size_t WS_SLOTW = 498 * MiB;
constexpr size_t WS_STAT1 = 499 * MiB, WS_STAT2 = WS_STAT1 + 256 * 1024;
constexpr size_t WS_TOTAL = 507 * MiB;

__device__ __forceinline__ unsigned cvtpk(float lo, float hi) { f32x2 v = {lo, hi}; bf16x2_t b = __builtin_convertvector(v, bf16x2_t); return __builtin_bit_cast(unsigned, b); }
__device__ __forceinline__ float bf2f(unsigned short h) { return __uint_as_float((unsigned)h << 16); }
__device__ __forceinline__ float bflo(unsigned w) { return __uint_as_float(w << 16); }
__device__ __forceinline__ float bfhi(unsigned w) { return __uint_as_float(w & 0xffff0000u); }
__device__ __forceinline__ unsigned short f2bf(float f) { return (unsigned short)(cvtpk(f, 0.f) & 0xffffu); }
#define DPPADDW_(v, ctrl, rm) v += __int_as_float(__builtin_amdgcn_update_dpp(0, __float_as_int(v), ctrl, rm, 0xF, true))
__device__ __forceinline__ float wave_sum(float v) {
    DPPADDW_(v, 0x111, 0xF); DPPADDW_(v, 0x112, 0xF); DPPADDW_(v, 0x114, 0xF); DPPADDW_(v, 0x118, 0xF); DPPADDW_(v, 0x142, 0xA); DPPADDW_(v, 0x143, 0xC);
    return __int_as_float(__builtin_amdgcn_readlane(__float_as_int(v), 63));
}
__device__ __forceinline__ float fast_exp2(float x) { return __builtin_amdgcn_exp2f(x); }
__device__ __forceinline__ float sigmoidf_(float z) { return __builtin_amdgcn_rcpf(1.0f + __expf(-z)); }
namespace pg8 {
constexpr int BM = 256, BK = 64, HALF = 128, HTB = HALF * BK * 2, STAGE_BYTES = 8 * HTB;
__device__ __forceinline__ int lds_byte(int r, int c) { const int st = (r >> 4) * 2 + (c >> 5), rr = r & 15, cc = c & 31, ob = rr * 64 + cc * 2; return st * 1024 + (ob ^ (((ob >> 9) & 1) << 5)); }
__device__ __forceinline__ void stage_rc(int b, int& R, int& C) { const int st = b / 1024, sb = b % 1024, swz = sb ^ (((sb >> 9) & 1) << 5); R = (st >> 1) * 16 + swz / 64; C = (st & 1) * 32 + (swz % 64) / 2; }
__device__ __forceinline__ int perm32(int rho) { const int n = rho >> 4, i = rho & 15; return 8 * (i >> 2) + 4 * n + (i & 3); }

struct Unit { const char* a; const char* b; int pm, pn, aux; };

template <class Epi, class Sched>
__device__ __forceinline__ void gemm_phase(LAS unsigned char* lds, const int K, const int lda, const int ldb, const Sched& S, const Epi& E) {
    const int tid = threadIdx.x, wid = __builtin_amdgcn_readfirstlane(tid >> 6), lane = tid & 63, wr = wid >> 2, wc = wid & 3, fr = lane & 15, fq = lane >> 4;
    const int nt = K / BK;
    unsigned voffA[2], voffB[2];
#pragma unroll
    for (int i = 0; i < 2; ++i) { int R, C; stage_rc(tid * 16 + i * 8192, R, C); const int Rb = Epi::PERM ? ((R & ~31) + perm32(R & 31)) : R;
        voffA[i] = (unsigned)(R * lda + C) * 2u; voffB[i] = (unsigned)(Rb * ldb + C) * 2u; }
    const size_t kstep = (size_t)(BK * 2);
    const size_t hstepA = (size_t)HALF * lda * 2, hstepB = (size_t)HALF * ldb * 2;
    const unsigned ldsw = (unsigned)wid * 1024u;
    const int aoff = lds_byte(wr * 64 + fr, fq * 8), boff = lds_byte(wc * 32 + fr, fq * 8);
#define PG8_SA(b, h) (((b) * 2 + (h)) * HTB)
#define PG8_SB(b, h) ((4 + (b) * 2 + (h)) * HTB)
#define PG8_STAGE(bufoff, gbase, voff) do { _Pragma("unroll") for (int _i = 0; _i < 2; ++_i) \
        __builtin_amdgcn_global_load_lds((const unsigned*)((const char*)(gbase) + (voff)[_i]), (LAS unsigned*)(lds + (bufoff) + ldsw + _i * 8192), 16, 0, 0); } while (0)
#define PG8_LDA(dst, b, h) do { _Pragma("unroll") for (int m = 0; m < 4; ++m) _Pragma("unroll") for (int k = 0; k < 2; ++k) dst[m][k] = *(const LAS bf16x8*)(lds + PG8_SA(b, h) + aoff + m * 2048 + k * 1024); } while (0)
#define PG8_LDB(dst, b, h) do { _Pragma("unroll") for (int n = 0; n < 2; ++n) _Pragma("unroll") for (int k = 0; k < 2; ++k) dst[n][k] = *(const LAS bf16x8*)(lds + PG8_SB(b, h) + boff + n * 2048 + k * 1024); } while (0)
#define PG8_MMA(ai, bj, At, Bt) do { __builtin_amdgcn_s_setprio(1); _Pragma("unroll") for (int m = 0; m < 4; ++m) _Pragma("unroll") for (int n = 0; n < 2; ++n) _Pragma("unroll") for (int k = 0; k < 2; ++k) \
        acc[ai][bj][m][n] = __builtin_amdgcn_mfma_f32_16x16x32_bf16(Bt[n][k], At[m][k], acc[ai][bj][m][n], 0, 0, 0); __builtin_amdgcn_s_setprio(0); } while (0)
#define PG8_WAIT_V(n) asm volatile("s_waitcnt vmcnt(" #n ")" ::: "memory")
#define PG8_WAIT_L(n) asm volatile("s_waitcnt lgkmcnt(" #n ")" ::: "memory")
#define PG8_BAR __builtin_amdgcn_s_barrier()
#define PG8_SCHED __builtin_amdgcn_sched_barrier(0)
    Unit cur, nxt; int ui = 0;
    if (!S.next(0, cur)) return;
    f32x4 acc[2][2][4][2];
#pragma unroll
    for (int a = 0; a < 2; ++a)
#pragma unroll
        for (int b = 0; b < 2; ++b)
#pragma unroll
            for (int m = 0; m < 4; ++m)
#pragma unroll
                for (int n = 0; n < 2; ++n) acc[a][b][m][n] = (f32x4){0.f, 0.f, 0.f, 0.f};
    bf16x8 At[4][2], B0[2][2], B1[2][2];
    const char* cA = cur.a; const char* cB = cur.b;
    PG8_STAGE(PG8_SB(0, 0), cB, voffB); PG8_STAGE(PG8_SB(0, 1), cB + hstepB, voffB); PG8_STAGE(PG8_SA(0, 0), cA, voffA); PG8_STAGE(PG8_SA(0, 1), cA + hstepA, voffA);
    if (wr == 1) PG8_BAR;
    PG8_WAIT_V(2); PG8_BAR;
    PG8_STAGE(PG8_SB(1, 0), cB + kstep, voffB); PG8_STAGE(PG8_SA(1, 0), cA + kstep, voffA); PG8_STAGE(PG8_SB(1, 1), cB + hstepB + kstep, voffB);
    PG8_WAIT_V(6); PG8_BAR;
    for (;;) {
        const bool has_next = S.next(ui + 1, nxt);
        const char* nA = has_next ? nxt.a : cA; const char* nB = has_next ? nxt.b : cB;
        for (int t = 0; t < nt; t += 2) {
            const bool last = (t == nt - 2);
            const char* a1 = cA + (size_t)(t + 1) * kstep;
            const char* a2 = last ? nA : cA + (size_t)(t + 2) * kstep; const char* b2 = last ? nB : cB + (size_t)(t + 2) * kstep;
            const char* a3 = a2 + kstep; const char* b3 = b2 + kstep;
            PG8_LDB(B0, 0, 0); PG8_LDB(B1, 0, 1); PG8_SCHED; PG8_LDA(At, 0, 0); PG8_STAGE(PG8_SA(1, 1), a1 + hstepA, voffA);
            PG8_WAIT_V(8); PG8_WAIT_L(0); PG8_BAR; PG8_MMA(0, 0, At, B0); PG8_MMA(0, 1, At, B1); PG8_BAR; PG8_SCHED;
            PG8_LDA(At, 0, 1); PG8_STAGE(PG8_SB(0, 0), b2, voffB); PG8_STAGE(PG8_SB(0, 1), b2 + hstepB, voffB); PG8_STAGE(PG8_SA(0, 0), a2, voffA);
            PG8_WAIT_V(8); PG8_WAIT_L(0); PG8_BAR; PG8_MMA(1, 0, At, B0); PG8_MMA(1, 1, At, B1); PG8_BAR; PG8_SCHED;
            PG8_LDB(B0, 1, 0); PG8_LDB(B1, 1, 1); PG8_SCHED; PG8_LDA(At, 1, 0); PG8_STAGE(PG8_SA(0, 1), a2 + hstepA, voffA);
            PG8_WAIT_V(8); PG8_WAIT_L(0); PG8_BAR; PG8_MMA(0, 0, At, B0); PG8_MMA(0, 1, At, B1); PG8_BAR; PG8_SCHED;
            PG8_LDA(At, 1, 1); PG8_STAGE(PG8_SB(1, 0), b3, voffB); PG8_STAGE(PG8_SB(1, 1), b3 + hstepB, voffB); PG8_STAGE(PG8_SA(1, 0), a3, voffA);
            PG8_WAIT_V(8); PG8_WAIT_L(0); PG8_BAR; PG8_MMA(1, 0, At, B0); PG8_MMA(1, 1, At, B1); PG8_BAR; PG8_SCHED;
        }
        if (wr == 0) PG8_BAR;
        E(acc, cur, wr, wc, fr, fq);
        if (!has_next) break;
#pragma unroll
        for (int a = 0; a < 2; ++a)
#pragma unroll
            for (int b = 0; b < 2; ++b)
#pragma unroll
                for (int m = 0; m < 4; ++m)
#pragma unroll
                    for (int n = 0; n < 2; ++n) acc[a][b][m][n] = (f32x4){0.f, 0.f, 0.f, 0.f};
        cur = nxt; cA = nA; cB = nB; ++ui;
        if (wr == 1) PG8_BAR;
    }
    PG8_WAIT_V(0);
    PG8_BAR;
#undef PG8_SA
#undef PG8_SB
#undef PG8_STAGE
#undef PG8_LDA
#undef PG8_LDB
#undef PG8_MMA
#undef PG8_WAIT_V
#undef PG8_WAIT_L
#undef PG8_BAR
#undef PG8_SCHED
}

struct GridOrder {
    const char* A; const char* Bt; size_t atile, btile; int nM, nN, nwg, G, c;
    __device__ __forceinline__ bool next(int i, Unit& u) const {
        const long L = (long)i * G + c; if (L >= nwg) return false;
        int wgid = (int)L; { const int q = nwg / 8, r = nwg % 8, xcd = wgid % 8, off = wgid / 8; wgid = (xcd < r ? xcd * (q + 1) : r * (q + 1) + (xcd - r) * q) + off; }
        const int nig = 8 * nN, gid = wgid / nig, fm = gid * 8, gsz = (nM - fm) < 8 ? (nM - fm) : 8;
        u.pm = fm + ((wgid % nig) % gsz); u.pn = (wgid % nig) / gsz; u.aux = 0;
        u.a = A + (size_t)u.pm * atile; u.b = Bt + (size_t)u.pn * btile; return true;
    }
};
}
__device__ __forceinline__ float gelu_tanh(float x) {
    const float u = 0.7978845608028654f * (x + 0.044715f * x * x * x);
    const float e = __expf(2.0f * u);
    const float th = 1.0f - 2.0f * __builtin_amdgcn_rcpf(1.0f + e);
    return 0.5f * x * (1.0f + th);
}
__device__ __forceinline__ float silu_(float z) { return z * __builtin_amdgcn_rcpf(1.0f + __expf(-z)); }
__device__ __forceinline__ u32x4 pack8(const f32x4 a, const f32x4 b) { u32x4 w; w.x = cvtpk(a[0], a[1]); w.y = cvtpk(a[2], a[3]); w.z = cvtpk(b[0], b[1]); w.w = cvtpk(b[2], b[3]); return w; }

__device__ __forceinline__ int kimg_off(int key, int dim) { return (dim >> 3) * 1024 + key * 16; }
__device__ __forceinline__ int vimg_off(int key, int dim) { return (dim >> 5) * 4096 + ((key >> 4) & 3) * 1024 + ((key >> 3) & 1) * 512 + (key & 7) * 64 + (dim & 31) * 2; }

__device__ __forceinline__ int kf_off(int key, int dim) { return ((((key >> 4) * 2 + (dim >> 5)) * 64 + (key & 15) + 16 * ((dim >> 3) & 3)) * 16) + (dim & 7) * 2; }
__device__ __forceinline__ int vf_off(int key, int dim) { return ((((dim >> 4) * 2 + (key >> 5)) * 64 + (dim & 15) + 16 * ((key >> 2) & 3)) * 16) + (((key >> 4) & 1) * 4 + (key & 3)) * 2; }
__device__ __forceinline__ void vf_store8(unsigned char* img, int key, int dim, const u32x4 w) {
    unsigned char* p = img + vf_off(key, dim);
    *(bf16_t*)(p) = (bf16_t)(w.x & 0xffffu); *(bf16_t*)(p + 16) = (bf16_t)(w.x >> 16); *(bf16_t*)(p + 32) = (bf16_t)(w.y & 0xffffu); *(bf16_t*)(p + 48) = (bf16_t)(w.y >> 16);
    *(bf16_t*)(p + 64) = (bf16_t)(w.z & 0xffffu); *(bf16_t*)(p + 80) = (bf16_t)(w.z >> 16); *(bf16_t*)(p + 96) = (bf16_t)(w.w & 0xffffu); *(bf16_t*)(p + 112) = (bf16_t)(w.w >> 16);
}
struct EpiInproj {
    static constexpr bool PERM = true;
    unsigned char* ws; const float* lb; int skip;
    __device__ __forceinline__ void operator()(const f32x4 (&acc)[2][2][4][2], const pg8::Unit& u, int wr, int wc, int fr, int fq) const {
        if (skip) { if (acc[0][0][0][0][0] == 12345.678f) ws[0] = 1; return; }
        const int pn = u.pn;
        const int rbase = u.pm * 256 + wr * 64 + fr;
        const int cwl = wc * 32 + fq * 8;
        if (pn == 2) {
            const int g = wc >> 1, dim = (wc & 1) * 32 + fq * 8;
#pragma unroll
            for (int ai = 0; ai < 2; ++ai)
#pragma unroll
                for (int m = 0; m < 4; ++m) { const int row = rbase + ai * 128 + m * 16, b = row >> 14, t = row & 16383;
                    const size_t e = ((size_t)((b * 2 + g) * 16384 + t)) * 64 + dim;
                    *(u32x4*)((bf16_t*)(ws + WS_KCIN) + e) = pack8(acc[ai][0][m][0], acc[ai][0][m][1]);
                    *(u32x4*)((bf16_t*)(ws + WS_VCIN) + e) = pack8(acc[ai][1][m][0], acc[ai][1][m][1]); }
        } else if (pn == 3 || pn == 4) {
            unsigned char* Kimg = ws + (pn == 3 ? WS_KS : WS_KW); unsigned char* Vimg = ws + (pn == 3 ? WS_VS : WS_VW);
            const int g = wc >> 1, dim = (wc & 1) * 32 + fq * 8;
#pragma unroll
            for (int ai = 0; ai < 2; ++ai)
#pragma unroll
                for (int m = 0; m < 4; ++m) { const int row = rbase + ai * 128 + m * 16, b = row >> 14, t = row & 16383, blk = t >> 6, key = t & 63;
                    const size_t ib = (size_t)((b * 2 + g) * 256 + blk) * 8192;
                    *(u32x4*)(Kimg + ib + kf_off(key, dim)) = pack8(acc[ai][0][m][0], acc[ai][0][m][1]);
                    vf_store8(Vimg + ib, key, dim, pack8(acc[ai][1][m][0], acc[ai][1][m][1])); }
        } else if (pn == 7 || pn == 8) {
            float* LOGF = (float*)(ws + WS_LOGF);
#pragma unroll
            for (int bj = 0; bj < 2; ++bj) { const int col = (pn - 7) * 256 + bj * 128 + cwl;
                const f32x4 l0 = *(const f32x4*)(lb + col), l1 = *(const f32x4*)(lb + col + 4);
#pragma unroll
                for (int ai = 0; ai < 2; ++ai)
#pragma unroll
                    for (int m = 0; m < 4; ++m) { const int row = rbase + ai * 128 + m * 16; f32x4 o0, o1;
#pragma unroll
                        for (int j = 0; j < 4; ++j) { o0[j] = __logf(l0[j] + (1.0f - l0[j]) * sigmoidf_(acc[ai][bj][m][0][j])); o1[j] = __logf(l1[j] + (1.0f - l1[j]) * sigmoidf_(acc[ai][bj][m][1][j])); }
                        *(f32x4*)(LOGF + (size_t)row * 512 + col) = o0; *(f32x4*)(LOGF + (size_t)row * 512 + col + 4) = o1; } }
        } else if (pn == 13) {
            if (cwl < 24) { float* GATE = (float*)(ws + WS_GATE);
#pragma unroll
                for (int ai = 0; ai < 2; ++ai)
#pragma unroll
                    for (int m = 0; m < 4; ++m) { const int row = rbase + ai * 128 + m * 16; f32x4 o0, o1;
#pragma unroll
                        for (int j = 0; j < 4; ++j) { o0[j] = sigmoidf_(acc[ai][0][m][0][j]); o1[j] = sigmoidf_(acc[ai][0][m][1][j]); }
                        *(f32x4*)(GATE + (size_t)row * 24 + cwl) = o0; *(f32x4*)(GATE + (size_t)row * 24 + cwl + 4) = o1; } }
        } else {
            bf16_t* base; int coff; int mode;
            if (pn <= 1) { base = (bf16_t*)(ws + WS_QN); coff = pn * 256; mode = 0; }
            else if (pn <= 6) { base = (bf16_t*)(ws + WS_HQ); coff = (pn - 5) * 256; mode = 1; }
            else if (pn <= 10) { base = (bf16_t*)(ws + WS_HI); coff = (pn - 9) * 256; mode = 1; }
            else { base = (bf16_t*)(ws + WS_HGS); coff = (pn - 11) * 256; mode = 2; }
#pragma unroll
            for (int ai = 0; ai < 2; ++ai)
#pragma unroll
                for (int m = 0; m < 4; ++m) { const int row = rbase + ai * 128 + m * 16;
#pragma unroll
                    for (int bj = 0; bj < 2; ++bj) { f32x4 v0 = acc[ai][bj][m][0], v1 = acc[ai][bj][m][1];
                        if (mode == 0) { v0 = v0 * QSCALE; v1 = v1 * QSCALE; }
                        else if (mode == 2) {
#pragma unroll
                            for (int j = 0; j < 4; ++j) { v0[j] = silu_(v0[j]); v1[j] = silu_(v1[j]); } }
                        *(u32x4*)(base + (size_t)row * 512 + coff + bj * 128 + cwl) = pack8(v0, v1); } }
        }
    }
};

struct EpiMemKV {
    static constexpr bool PERM = true;
    unsigned char* ws;
    __device__ __forceinline__ void operator()(const f32x4 (&acc)[2][2][4][2], const pg8::Unit& u, int wr, int wc, int fr, int fq) const {
        const int isv = u.pn >> 2, head = u.pn & 3, b = u.pm;
        unsigned char* img = ws + (isv ? WS_MEMV : WS_MEMK) + (size_t)(b * 4 + head) * 4 * 32768;
#pragma unroll
        for (int ai = 0; ai < 2; ++ai)
#pragma unroll
            for (int m = 0; m < 4; ++m) { const int key = ai * 128 + wr * 64 + m * 16 + fr, kb = key >> 6, kl = key & 63;
#pragma unroll
                for (int bj = 0; bj < 2; ++bj) { const int dim = bj * 128 + wc * 32 + fq * 8;
                    const int off = isv ? vimg_off(kl, dim) : kimg_off(kl, dim);
                    *(u32x4*)(img + (size_t)kb * 32768 + off) = pack8(acc[ai][bj][m][0], acc[ai][bj][m][1]); } }
    }
};

struct EpiCmp1 {
    static constexpr bool PERM = true;
    unsigned char* ws;
    __device__ __forceinline__ void operator()(const f32x4 (&acc)[2][2][4][2], const pg8::Unit& u, int wr, int wc, int fr, int fq) const {
        const int kv = u.aux; const float* bias = (const float*)(ws + (kv ? WS_BIASV : WS_BIASK));
        bf16_t* HID = (bf16_t*)(ws + WS_HID) + (size_t)kv * 4096 * 256;
#pragma unroll
        for (int bj = 0; bj < 2; ++bj) { const int col = bj * 128 + wc * 32 + fq * 8;
            const f32x4 b0 = *(const f32x4*)(bias + col), b1 = *(const f32x4*)(bias + col + 4);
#pragma unroll
            for (int ai = 0; ai < 2; ++ai)
#pragma unroll
                for (int m = 0; m < 4; ++m) { const int row = u.pm * 256 + ai * 128 + wr * 64 + m * 16 + fr; f32x4 v0, v1;
#pragma unroll
                    for (int j = 0; j < 4; ++j) { v0[j] = gelu_tanh(acc[ai][bj][m][0][j] + b0[j]); v1[j] = gelu_tanh(acc[ai][bj][m][1][j] + b1[j]); }
                    *(u32x4*)(HID + (size_t)row * 256 + col) = pack8(v0, v1); } }
    }
};

__device__ __forceinline__ void row_stats(const float* stat, size_t row, float& mean, float& rstd) {
    const f32x2 v = *(const f32x2*)(stat + row * 2);
    mean = v[0] * (1.f / 1024.f); rstd = 1.0f / sqrtf(fmaxf(v[1] * (1.f / 1024.f) - mean * mean, 0.f) + 1e-5f);
}
template <int MODE>
struct EpiRes {
    static constexpr bool PERM = false;
    const float* base; const bf16_t* baseb; bf16_t* outb; float* stat; const float* pstat; const float* lg; const float* lb;
    __device__ __forceinline__ void operator()(const f32x4 (&acc)[2][2][4][2], const pg8::Unit& u, int wr, int wc, int fr, int fq) const {
        const int col0 = u.pn * 256 + wc * 32 + 4 * fq;
        f32x4 gv[2][2], bv[2][2];
        if (MODE == 1) {
#pragma unroll
            for (int bj = 0; bj < 2; ++bj)
#pragma unroll
                for (int n = 0; n < 2; ++n) { gv[bj][n] = *(const f32x4*)(lg + col0 + bj * 128 + n * 16); bv[bj][n] = *(const f32x4*)(lb + col0 + bj * 128 + n * 16); } }
#pragma unroll
        for (int ai = 0; ai < 2; ++ai) {
            f32x2 st[4]; f32x4 bsf[4][2][2]; u32x2 bsw[4][2][2];
#pragma unroll
            for (int m = 0; m < 4; ++m) { const size_t row = (size_t)(u.pm * 256 + ai * 128 + wr * 64 + m * 16 + fr); const size_t off = row * 1024 + col0;
                if (MODE == 1) st[m] = *(const f32x2*)(pstat + row * 2);
#pragma unroll
                for (int bj = 0; bj < 2; ++bj)
#pragma unroll
                    for (int n = 0; n < 2; ++n) { if (MODE == 0) bsf[m][bj][n] = *(const f32x4*)(base + off + bj * 128 + n * 16); else bsw[m][bj][n] = *(const u32x2*)(baseb + off + bj * 128 + n * 16); } }
#pragma unroll
            for (int m = 0; m < 4; ++m) { const size_t row = (size_t)(u.pm * 256 + ai * 128 + wr * 64 + m * 16 + fr); const size_t off = row * 1024 + col0;
                float mean = 0.f, rstd = 1.f;
                if (MODE == 1) { mean = st[m][0] * (1.f / 1024.f); rstd = 1.0f / sqrtf(fmaxf(st[m][1] * (1.f / 1024.f) - mean * mean, 0.f) + 1e-5f); }
                float s1 = 0.f, s2 = 0.f;
#pragma unroll
                for (int bj = 0; bj < 2; ++bj)
#pragma unroll
                    for (int n = 0; n < 2; ++n) { f32x4 bs;
                        if (MODE == 0) bs = bsf[m][bj][n];
                        else { const u32x2 bw = bsw[m][bj][n]; bs = ((f32x4){bflo(bw.x), bfhi(bw.x), bflo(bw.y), bfhi(bw.y)} - mean) * rstd * gv[bj][n] + bv[bj][n]; }
                        const f32x4 o = bs * ALPHA + acc[ai][bj][m][n];
                        u32x2 w; w.x = cvtpk(o[0], o[1]); w.y = cvtpk(o[2], o[3]); *(u32x2*)(outb + off + bj * 128 + n * 16) = w;
                        s1 += (o[0] + o[1]) + (o[2] + o[3]); s2 += (o[0] * o[0] + o[1] * o[1]) + (o[2] * o[2] + o[3] * o[3]); }
                s1 += __shfl_xor(s1, 16); s1 += __shfl_xor(s1, 32); s2 += __shfl_xor(s2, 16); s2 += __shfl_xor(s2, 32);
                if (fq == 0) { atomicAdd(stat + row * 2, s1); atomicAdd(stat + row * 2 + 1, s2); } } }
    }
};

struct EpiQLn {
    static constexpr bool PERM = true;
    bf16_t* O; const float* stat; const float* cs; const float* bq; int skip;
    __device__ __forceinline__ void operator()(const f32x4 (&acc)[2][2][4][2], const pg8::Unit& u, int wr, int wc, int fr, int fq) const {
        if (skip) { if (acc[0][0][0][0][0] == 12345.678f) O[0] = 1; return; }
        const int col0 = u.pn * 256 + wc * 32 + 8 * fq;
        f32x4 c0[2], c1[2], b0[2], b1[2]; f32x2 st[2][4];
#pragma unroll
        for (int bj = 0; bj < 2; ++bj) { c0[bj] = *(const f32x4*)(cs + col0 + bj * 128); c1[bj] = *(const f32x4*)(cs + col0 + bj * 128 + 4); b0[bj] = *(const f32x4*)(bq + col0 + bj * 128); b1[bj] = *(const f32x4*)(bq + col0 + bj * 128 + 4); }
#pragma unroll
        for (int ai = 0; ai < 2; ++ai)
#pragma unroll
            for (int m = 0; m < 4; ++m) st[ai][m] = *(const f32x2*)(stat + (size_t)(u.pm * 256 + ai * 128 + wr * 64 + m * 16 + fr) * 2);
#pragma unroll
        for (int ai = 0; ai < 2; ++ai)
#pragma unroll
            for (int m = 0; m < 4; ++m) { const size_t row = (size_t)(u.pm * 256 + ai * 128 + wr * 64 + m * 16 + fr);
                const float mean = st[ai][m][0] * (1.f / 1024.f), rstd = 1.0f / sqrtf(fmaxf(st[ai][m][1] * (1.f / 1024.f) - mean * mean, 0.f) + 1e-5f);
                bf16_t* rowp = O + row * 1024 + col0;
#pragma unroll
                for (int bj = 0; bj < 2; ++bj) {
                    const f32x4 v0 = ((acc[ai][bj][m][0] - c0[bj] * mean) * rstd + b0[bj]) * XSCALE, v1 = ((acc[ai][bj][m][1] - c1[bj] * mean) * rstd + b1[bj]) * XSCALE;
                    *(u32x4*)(rowp + bj * 128) = pack8(v0, v1); } }
    }
};

struct EpiScaleBf16 {
    static constexpr bool PERM = true;
    bf16_t* O; int ldc; float scale;
    __device__ __forceinline__ void operator()(const f32x4 (&acc)[2][2][4][2], const pg8::Unit& u, int wr, int wc, int fr, int fq) const {
#pragma unroll
        for (int ai = 0; ai < 2; ++ai)
#pragma unroll
            for (int m = 0; m < 4; ++m) { bf16_t* rowp = O + (size_t)(u.pm * 256 + ai * 128 + wr * 64 + m * 16 + fr) * ldc + u.pn * 256 + wc * 32 + 8 * fq;
#pragma unroll
                for (int bj = 0; bj < 2; ++bj) *(u32x4*)(rowp + bj * 128) = pack8(acc[ai][bj][m][0] * scale, acc[ai][bj][m][1] * scale); }
    }
};

struct EpiGateUp {
    static constexpr bool PERM = true;
    bf16_t* H;
    __device__ __forceinline__ void operator()(const f32x4 (&acc)[2][2][4][2], const pg8::Unit& u, int wr, int wc, int fr, int fq) const {
#pragma unroll
        for (int ai = 0; ai < 2; ++ai)
#pragma unroll
            for (int m = 0; m < 4; ++m) { f32x4 v0, v1;
#pragma unroll
                for (int j = 0; j < 4; ++j) { v0[j] = silu_(acc[ai][0][m][0][j]) * acc[ai][1][m][0][j]; v1[j] = silu_(acc[ai][0][m][1][j]) * acc[ai][1][m][1][j]; }
                *(u32x4*)(H + (size_t)(u.pm * 256 + ai * 128 + wr * 64 + m * 16 + fr) * 512 + u.pn * 128 + wc * 32 + 8 * fq) = pack8(v0, v1); }
    }
};

struct EpiDown {
    static constexpr bool PERM = true;
    bf16_t* Y; const float* sw;
    __device__ __forceinline__ void operator()(const f32x4 (&acc)[2][2][4][2], const pg8::Unit& u, int wr, int wc, int fr, int fq) const {
#pragma unroll
        for (int ai = 0; ai < 2; ++ai)
#pragma unroll
            for (int m = 0; m < 4; ++m) { const int row = u.pm * 256 + ai * 128 + wr * 64 + m * 16 + fr; const float w = sw[row];
                bf16_t* rowp = Y + (size_t)row * 1024 + u.pn * 256 + wc * 32 + 8 * fq;
#pragma unroll
                for (int bj = 0; bj < 2; ++bj) *(u32x4*)(rowp + bj * 128) = pack8(acc[ai][bj][m][0] * w, acc[ai][bj][m][1] * w); }
    }
};
struct Args { const float* in[30]; float* out; unsigned char* ws; int ph_lo, ph_hi, rep, li; };
enum { I_X = 0, I_MEM, I_WIN, I_PEK, I_PEV, I_W1K, I_W2K, I_W1V, I_W2V, I_NSAG, I_LBL, I_HGG, I_WOUT, I_LN1G, I_LN1B, I_XWQ, I_XWK, I_XWV, I_XWO, I_LN2G, I_LN2B,
       I_MWG, I_MBG, I_MWE, I_MBE, I_MGATE, I_MUP, I_MDOWN, I_LN3G, I_LN3B };
constexpr int NWAVES = 8, NTHR = 512;
constexpr int LDS_BYTES = 147456;

struct Frame {
    LAS unsigned char* lds; unsigned char* ws; unsigned* ctl; const float* const* in; float* out;
    int tid, lane, wave, G, bid;
};

template <class Src>
__device__ __forceinline__ void transpose_item(const Src& src, int K, bf16_t* dst, int nblk, LAS float* scr, int item, int lane) {
    const int kb = item / nblk, nb = item % nblk, k0 = 64 * kb, n0 = 32 * nb;
    f32x4 v[8];
#pragma unroll
    for (int i = 0; i < 8; ++i) v[i] = src.ld4(k0 + 8 * i + (lane >> 3), n0 + 4 * (lane & 7));
#pragma unroll
    for (int i = 0; i < 8; ++i) { LAS float* d = scr + (8 * i + (lane >> 3)) * 33 + 4 * (lane & 7); d[0] = v[i][0]; d[1] = v[i][1]; d[2] = v[i][2]; d[3] = v[i][3]; }
    asm volatile("s_waitcnt lgkmcnt(0)" ::: "memory");
    const int c = lane & 7;
#pragma unroll
    for (int j = 0; j < 4; ++j) { const int n = (lane >> 3) + 8 * j; const LAS float* s = scr + (8 * c) * 33 + n;
        u32x4 o; o.x = cvtpk(s[0 * 33], s[1 * 33]); o.y = cvtpk(s[2 * 33], s[3 * 33]); o.z = cvtpk(s[4 * 33], s[5 * 33]); o.w = cvtpk(s[6 * 33], s[7 * 33]);
        *(u32x4*)(dst + (size_t)(n0 + n) * K + k0 + 8 * c) = o; }
    asm volatile("s_waitcnt lgkmcnt(0)" ::: "memory");
}
struct SrcPlain { const float* w; int ldn; __device__ __forceinline__ f32x4 ld4(int k, int n) const { return *(const f32x4*)(w + (size_t)k * ldn + n); } };
struct SrcScaled { const float* w; const float* g; int ldn; __device__ __forceinline__ f32x4 ld4(int k, int n) const { return *(const f32x4*)(w + (size_t)k * ldn + n) * g[k]; } };
struct SrcWin { const float* w; __device__ __forceinline__ f32x4 ld4(int k, int n) const {
    int sc; if (n < 1280) sc = n; else if (n < 3328) sc = n + 24; else { const int j = n - 3328; sc = j < 24 ? 1280 + j : -1; }
    return sc >= 0 ? *(const f32x4*)(w + (size_t)k * 3352 + sc) : (f32x4){0.f, 0.f, 0.f, 0.f}; } };
struct SrcGU { const float* wg; const float* wu; __device__ __forceinline__ f32x4 ld4(int k, int n) const {
    const int tile = n >> 8, i = n & 255; const long long d = (long long)(wu - wg) * (long long)((i >> 7) & 1); return *(const f32x4*)(wg + d + (size_t)k * 512 + tile * 128 + (i & 127)); } };

constexpr int MOE_CONV_ITEMS = 32 * (16 * 32 + 8 * 32);
__device__ __forceinline__ void moe_conv_item(Frame& F, int it) {
    constexpr int I_GU = 16 * 32, I_D = 8 * 32;
    LAS float* scr = (LAS float*)(F.lds + F.wave * 16384);
    const int e = it / (I_GU + I_D), r = it % (I_GU + I_D);
    if (r < I_GU) transpose_item(SrcGU{F.in[I_MGATE] + (size_t)e * 1024 * 512, F.in[I_MUP] + (size_t)e * 1024 * 512}, 1024, (bf16_t*)(F.ws + WS_WGU) + (size_t)e * 1024 * 1024, 32, scr, r, F.lane);
    else transpose_item(SrcPlain{F.in[I_MDOWN] + (size_t)e * 512 * 1024, 1024}, 512, (bf16_t*)(F.ws + WS_WD) + (size_t)e * 1024 * 512, 32, scr, r - I_GU, F.lane);
}
__device__ __forceinline__ void p0_prep(Frame& F) {
    LAS float* scr = (LAS float*)(F.lds + F.wave * 16384);
    const int gw = F.bid * NWAVES + F.wave, NGW = F.G * NWAVES;
    unsigned char* ws = F.ws;
    if (F.bid == 0) { const float* l = F.in[I_LBL]; ((float*)(ws + WS_LB))[F.tid] = 1.0f / (1.0f + __expf(l[512 + F.tid] - l[F.tid])); }
    { const int job = F.bid - 1;
      if (job >= 0 && job < 48) { LAS float* red = (LAS float*)(F.lds + 100 * 1024); const int cl = F.tid & 31, sl = F.tid >> 5; float a0 = 0.f, a1 = 0.f;
        if (job < 16) { const int kv = job >> 3, n = (job & 7) * 32 + cl; const float* pe = F.in[kv ? I_PEV : I_PEK]; const float* w1 = F.in[kv ? I_W1V : I_W1K];
#pragma unroll 8
            for (int k = sl * 128; k < sl * 128 + 128; ++k) a0 += pe[k] * w1[(size_t)k * 256 + n]; }
        else { const int n = (job - 16) * 32 + cl; const float* wq = F.in[I_XWQ]; const float* g1 = F.in[I_LN1G]; const float* b1 = F.in[I_LN1B];
#pragma unroll 8
            for (int k = sl * 64; k < sl * 64 + 64; ++k) { const float wv = wq[(size_t)k * 1024 + n]; a0 += bf2f(f2bf(wv * g1[k])); a1 += b1[k] * wv; } }
        red[F.tid] = a0; red[512 + F.tid] = a1;
        __syncthreads();
        if (F.tid < 32) { float s0 = 0.f, s1 = 0.f;
#pragma unroll
            for (int i = 0; i < 16; ++i) { s0 += red[i * 32 + F.tid]; s1 += red[512 + i * 32 + F.tid]; }
            if (job < 16) ((float*)(ws + ((job >> 3) ? WS_BIASV : WS_BIASK)))[(job & 7) * 32 + F.tid] = s0;
            else { ((float*)(ws + WS_QCS))[(job - 16) * 32 + F.tid] = s0; ((float*)(ws + WS_QBQ))[(job - 16) * 32 + F.tid] = s1; } }
        __syncthreads(); } }
    constexpr int I_WINN = 16 * 112, I_SQ = 16 * 32, I_W1 = 32 * 8, I_W2 = 4 * 2;
    constexpr int NITEMS_A = I_WINN + 5 * I_SQ + 2 * I_W1 + 2 * I_W2;
    for (int it = gw; it < NITEMS_A; it += NGW) {
        int r = it;
        if (r < I_WINN) { transpose_item(SrcWin{F.in[I_WIN]}, 1024, (bf16_t*)(ws + WS_WIN), 112, scr, r, F.lane); continue; } r -= I_WINN;
        if (r < 5 * I_SQ) { const int w = r / I_SQ; const float* src = F.in[w == 0 ? I_WOUT : w == 1 ? I_XWQ : w == 2 ? I_XWK : w == 3 ? I_XWV : I_XWO];
            if (w == 1) transpose_item(SrcScaled{src, F.in[I_LN1G], 1024}, 1024, (bf16_t*)(ws + WS_WQ), 32, scr, r % I_SQ, F.lane);
            else transpose_item(SrcPlain{src, 1024}, 1024, (bf16_t*)(ws + WS_WOUT + (size_t)w * 2 * MiB), 32, scr, r % I_SQ, F.lane);
            continue; } r -= 5 * I_SQ;
        if (r < 2 * I_W1) { const int kv = r / I_W1; transpose_item(SrcPlain{F.in[kv ? I_W1V : I_W1K], 256}, 2048, (bf16_t*)(ws + (kv ? WS_W1V : WS_W1K)), 8, scr, r % I_W1, F.lane); continue; } r -= 2 * I_W1;
        { const int kv = r / I_W2; transpose_item(SrcPlain{F.in[kv ? I_W2V : I_W2K], 64}, 256, (bf16_t*)(ws + (kv ? WS_W2V : WS_W2K)), 2, scr, r % I_W2, F.lane); }
    }
    for (int it = gw; it < MOE_CONV_ITEMS; it += NGW) moe_conv_item(F, it);
    { f32x4* z = (f32x4*)(ws + WS_STAT1); for (size_t i = (size_t)F.bid * NTHR + F.tid; i < (size_t)2 * NTOK * 2 / 4; i += (size_t)F.G * NTHR) z[i] = (f32x4){0.f, 0.f, 0.f, 0.f}; }
    { bf16_t* WH = (bf16_t*)(ws + WS_WRH); bf16_t* WL = (bf16_t*)(ws + WS_WRL); const float* wg = F.in[I_MWG]; const float* we = F.in[I_MWE];
      for (size_t i = (size_t)F.bid * NTHR + F.tid; i < (size_t)48 * 1024; i += (size_t)F.G * NTHR) { const int c = (int)(i >> 10), k = (int)(i & 1023);
          const float v = c < 4 ? wg[k * 4 + c] : c < 36 ? we[k * 32 + (c - 4)] : 0.f; const bf16_t h = f2bf(v); WH[i] = h; WL[i] = f2bf(v - bf2f(h)); } }
    const size_t gt = (size_t)F.bid * NTHR + F.tid, NT = (size_t)F.G * NTHR;
    { const f32x4* x4 = (const f32x4*)F.in[I_X]; u32x4* o = (u32x4*)(ws + WS_RA);
      for (size_t i = gt; i < (size_t)NTOK * DM / 8; i += NT) o[i] = pack8(x4[2 * i], x4[2 * i + 1]); }
    { const f32x4* x4 = (const f32x4*)F.in[I_MEM]; u32x4* o = (u32x4*)(ws + WS_MEMB);
      for (size_t i = gt; i < (size_t)512 * DM / 8; i += NT) o[i] = pack8(x4[2 * i], x4[2 * i + 1]); }
}

__device__ __forceinline__ void ln_row(const float* src, const float* g, const float* b, int lane, f32x4 (&y)[4]) {
    const f32x4* xr = (const f32x4*)src + lane; f32x4 v[4]; float s = 0.f;
#pragma unroll
    for (int j = 0; j < 4; ++j) { v[j] = xr[64 * j]; s += (v[j][0] + v[j][1]) + (v[j][2] + v[j][3]); }
    const float mean = wave_sum(s) * (1.f / 1024.f); float s2 = 0.f;
#pragma unroll
    for (int j = 0; j < 4; ++j) { v[j] = v[j] - mean; s2 += (v[j][0] * v[j][0] + v[j][1] * v[j][1]) + (v[j][2] * v[j][2] + v[j][3] * v[j][3]); }
    const float rstd = 1.0f / sqrtf(wave_sum(s2) * (1.f / 1024.f) + 1e-5f);
#pragma unroll
    for (int j = 0; j < 4; ++j) { const f32x4 gg = ((const f32x4*)g)[lane + 64 * j], bb = ((const f32x4*)b)[lane + 64 * j]; y[j] = v[j] * rstd * gg + bb; }
}
__device__ __forceinline__ void store_row_f32_bf16(const f32x4 (&y)[4], float* of, bf16_t* ob, int lane) {
#pragma unroll
    for (int j = 0; j < 4; ++j) { ((f32x4*)of)[lane + 64 * j] = y[j]; u32x2 w; w.x = cvtpk(y[j][0], y[j][1]); w.y = cvtpk(y[j][2], y[j][3]); ((u32x2*)ob)[lane + 64 * j] = w; }
}
__device__ __forceinline__ int crow(int r, int hi) { return (r & 3) + 8 * (r >> 2) + 4 * hi; }
#define MFMA32(a, b, c) __builtin_amdgcn_mfma_f32_32x32x16_bf16((a), (b), (c), 0, 0, 0)

__device__ __forceinline__ void chunk_cumsum(LAS float* lf, LAS float* seg_tot, int tid) {
    const int ch = tid & 127, seg = tid >> 7; float v[16];
#pragma unroll
    for (int i = 0; i < 16; ++i) v[i] = lf[(seg * 16 + i) * 128 + ch];
#pragma unroll
    for (int i = 1; i < 16; ++i) v[i] += v[i - 1];
#pragma unroll
    for (int i = 0; i < 16; ++i) lf[(seg * 16 + i) * 128 + ch] = v[i];
    seg_tot[seg * 128 + ch] = v[15];
}
#define DPPADD_(v, ctrl, rm) v += __int_as_float(__builtin_amdgcn_update_dpp(0, __float_as_int(v), ctrl, rm, 0xF, true))
__device__ __forceinline__ float half_sum_dpp(float v) { DPPADD_(v, 0x111, 0xF); DPPADD_(v, 0x112, 0xF); DPPADD_(v, 0x114, 0xF); DPPADD_(v, 0x118, 0xF); DPPADD_(v, 0x142, 0xA); return v; }

struct HAIn { f32x4 lfr[4]; u32x2 vr[4]; };
__device__ __forceinline__ void hgrn_a_load(Frame& F, int unit, int tid, HAIn& in) {
    const int bh = unit >> 8, c = unit & 255, b = bh >> 2, h = bh & 3; const size_t m0 = (size_t)b * SEQ + 64 * c; const int tr = tid >> 5, c4 = (tid & 31) * 4;
    const float* LOGF = (const float*)(F.ws + WS_LOGF) + m0 * 512 + h * 128; const bf16_t* HI = (const bf16_t*)(F.ws + WS_HI) + m0 * 512 + h * 128;
#pragma unroll
    for (int i = 0; i < 4; ++i) { const int t = tr + 16 * i; in.lfr[i] = *(const f32x4*)(LOGF + (size_t)t * 512 + c4); in.vr[i] = *(const u32x2*)(HI + (size_t)t * 512 + c4); }
}
template <class NextFn>
__device__ __forceinline__ void hgrn_a_loop(Frame& F, const NextFn& next_unit) {
    const int w = F.wave;
    LAS float* lf = (LAS float*)F.lds; LAS bf16_t* KeT = (LAS bf16_t*)(F.lds + 32768); LAS bf16_t* Vt = (LAS bf16_t*)(F.lds + 51200); LAS float* segt = (LAS float*)(F.lds + 69632);
    int unit = next_unit(); if (unit < 0) return;
    HAIn in; hgrn_a_load(F, unit, F.tid, in);
    for (;;) {
        const int un = next_unit();
        int tid = F.tid; asm volatile("" : "+v"(tid));
        const int lane = tid & 63, r32 = lane & 31, hi = lane >> 5, tr = tid >> 5, c4 = (tid & 31) * 4;
#pragma unroll
        for (int i = 0; i < 4; ++i) *(LAS f32x4*)(lf + (tr + 16 * i) * 128 + c4) = in.lfr[i];
        __syncthreads();
        chunk_cumsum(lf, segt, tid);
        __syncthreads();
        { const f32x4 T0 = *(const LAS f32x4*)(segt + c4), T1 = *(const LAS f32x4*)(segt + 128 + c4), T2 = *(const LAS f32x4*)(segt + 256 + c4);
          const f32x4 bl = *(const LAS f32x4*)(lf + 63 * 128 + c4) + T0 + T1 + T2;
          if (tr == 0) *(f32x4*)((float*)(F.ws + WS_HD) + (size_t)unit * 128 + c4) = (f32x4){__expf(bl[0]), __expf(bl[1]), __expf(bl[2]), __expf(bl[3])};
          f32x4 off = (f32x4){0.f, 0.f, 0.f, 0.f};
#pragma unroll
          for (int i = 0; i < 4; ++i) { const int t = tr + 16 * i; const f32x4 bt = *(const LAS f32x4*)(lf + t * 128 + c4) + off;
#pragma unroll
            for (int j = 0; j < 4; ++j) { const float kk = 1.0f - __expf(in.lfr[i][j]); const float ke = kk * __expf(bl[j] - bt[j]);
                KeT[(c4 + j) * 72 + t] = f2bf(ke); }
            Vt[(c4 + 0) * 72 + t] = (bf16_t)(in.vr[i].x & 0xffffu); Vt[(c4 + 1) * 72 + t] = (bf16_t)(in.vr[i].x >> 16);
            Vt[(c4 + 2) * 72 + t] = (bf16_t)(in.vr[i].y & 0xffffu); Vt[(c4 + 3) * 72 + t] = (bf16_t)(in.vr[i].y >> 16);
            off = off + (i == 0 ? T0 : i == 1 ? T1 : T2); } }
        if (un >= 0) hgrn_a_load(F, un, tid, in);
        __syncthreads();
        { const int vt = w >> 1, kt0 = 2 * (w & 1); f32x16 a0 = {}, a1 = {};
#pragma unroll
          for (int ks = 0; ks < 4; ++ks) { const bf16x8 av = *(const LAS bf16x8*)(Vt + (vt * 32 + r32) * 72 + 16 * ks + 8 * hi);
            const bf16x8 b0 = *(const LAS bf16x8*)(KeT + (kt0 * 32 + r32) * 72 + 16 * ks + 8 * hi), b1 = *(const LAS bf16x8*)(KeT + ((kt0 + 1) * 32 + r32) * 72 + 16 * ks + 8 * hi);
            a0 = MFMA32(av, b0, a0); a1 = MFMA32(av, b1, a1); }
          bf16_t* HST = (bf16_t*)F.out + (size_t)unit * 16384;
#pragma unroll
          for (int r = 0; r < 16; ++r) { const int v = vt * 32 + crow(r, hi); HST[v * 128 + kt0 * 32 + r32] = f2bf(a0[r]); HST[v * 128 + (kt0 + 1) * 32 + r32] = f2bf(a1[r]); } }
        if (un < 0) break;
        unit = un;
    }
    __syncthreads();
}

__device__ __forceinline__ void hgrn_b(Frame& F) {
    unsigned* HST = (unsigned*)F.out; const float* HD = (const float*)(F.ws + WS_HD);
    for (int e = F.bid * NTHR + F.tid; e < 8 * 8192; e += F.G * NTHR) {
        const int bh = e >> 13, rem = e & 8191, k2 = (rem & 63) * 2; float S0 = 0.f, S1 = 0.f;
        for (int c0 = 0; c0 < 256; c0 += 16) { unsigned L[16]; f32x2 d[16];
#pragma unroll
            for (int i = 0; i < 16; ++i) { L[i] = HST[(size_t)(bh * 256 + c0 + i) * 8192 + rem]; d[i] = *(const f32x2*)(HD + (size_t)(bh * 256 + c0 + i) * 128 + k2); }
#pragma unroll
            for (int i = 0; i < 16; ++i) { HST[(size_t)(bh * 256 + c0 + i) * 8192 + rem] = cvtpk(S0, S1); S0 = d[i][0] * S0 + bflo(L[i]); S1 = d[i][1] * S1 + bfhi(L[i]); } }
    }
}

struct HCIn { f32x4 lfr[4]; u32x2 vr[4], qv[4]; u32x4 stf[8]; };
template <int PART>
__device__ __forceinline__ void hgrn_c_load(Frame& F, int unit, HCIn& in) {
    const int bh = unit >> 8, c = unit & 255, b = bh >> 2, h = bh & 3, tid = F.tid, lane = F.lane, w = F.wave, r32 = lane & 31, hi = lane >> 5;
    const size_t m0 = (size_t)b * SEQ + 64 * c; const int tr = tid >> 5, c4 = (tid & 31) * 4, vt = w & 3;
    if (PART & 1) {
    const float* LOGF = (const float*)(F.ws + WS_LOGF) + m0 * 512 + h * 128; const bf16_t* HI = (const bf16_t*)(F.ws + WS_HI) + m0 * 512 + h * 128;
    const bf16_t* HQ = (const bf16_t*)(F.ws + WS_HQ) + m0 * 512 + h * 128;
#pragma unroll
    for (int i = 0; i < 4; ++i) { const int t = tr + 16 * i; in.lfr[i] = *(const f32x4*)(LOGF + (size_t)t * 512 + c4); in.vr[i] = *(const u32x2*)(HI + (size_t)t * 512 + c4);
        in.qv[i] = *(const u32x2*)(HQ + (size_t)t * 512 + c4); } }
    if (PART & 2) { const bf16_t* ST = (const bf16_t*)F.out + (size_t)unit * 16384 + (size_t)(vt * 32 + r32) * 128 + 8 * hi;
#pragma unroll
    for (int ks = 0; ks < 8; ++ks) in.stf[ks] = *(const u32x4*)(ST + 16 * ks); }
}
template <class NextFn>
__device__ __forceinline__ void hgrn_c_loop(Frame& F, const NextFn& next_unit) {
    const int w = F.wave;
    LAS float* lf = (LAS float*)F.lds; LAS bf16_t* Qe = (LAS bf16_t*)(F.lds + 32768); LAS bf16_t* Qi = (LAS bf16_t*)(F.lds + 50176); LAS bf16_t* Ki = (LAS bf16_t*)(F.lds + 67584);
    LAS bf16_t* Vt = (LAS bf16_t*)(F.lds + 84992); LAS bf16_t* att = (LAS bf16_t*)(F.lds + 103424); LAS float* ssb = (LAS float*)(F.lds + 112640); LAS float* segt = (LAS float*)(F.lds + 113664);
    const int tt = w >> 2, vt = w & 3;
    const float gg = F.in[I_HGG][vt * 32 + (F.lane & 31)];
    int unit = next_unit(); if (unit < 0) return;
    HCIn in; hgrn_c_load<3>(F, unit, in);
    for (;;) {
        const int un = next_unit();
        int tid = F.tid; asm volatile("" : "+v"(tid));
        const int lane = tid & 63, r32 = lane & 31, hi = lane >> 5, tr = tid >> 5, c4 = (tid & 31) * 4;
        const int bh = unit >> 8, c = unit & 255, b = bh >> 2, h = bh & 3; const size_t m0 = (size_t)b * SEQ + 64 * c;
        const bf16_t* HGS = (const bf16_t*)(F.ws + WS_HGS) + m0 * 512 + h * 128 + vt * 32 + r32;
#pragma unroll
        for (int i = 0; i < 4; ++i) *(LAS f32x4*)(lf + (tr + 16 * i) * 128 + c4) = in.lfr[i];
        __syncthreads();
        chunk_cumsum(lf, segt, tid);
        __syncthreads();
        { const f32x4 T0 = *(const LAS f32x4*)(segt + c4), T1 = *(const LAS f32x4*)(segt + 128 + c4), T2 = *(const LAS f32x4*)(segt + 256 + c4);
          const f32x4 bm = *(const LAS f32x4*)(lf + 31 * 128 + c4) + T0;
          f32x4 off = (f32x4){0.f, 0.f, 0.f, 0.f};
#pragma unroll
          for (int i = 0; i < 4; ++i) { const int t = tr + 16 * i; const f32x4 bt = *(const LAS f32x4*)(lf + t * 128 + c4) + off;
            float q[4] = {bflo(in.qv[i].x), bfhi(in.qv[i].x), bflo(in.qv[i].y), bfhi(in.qv[i].y)}; float qe[4], qi[4], ki[4];
#pragma unroll
            for (int j = 0; j < 4; ++j) { const float kk = 1.0f - __expf(in.lfr[i][j]); qe[j] = q[j] * __expf(bt[j]); const float ed = __expf(fminf(fmaxf(bt[j] - bm[j], -80.f), 80.f)); qi[j] = q[j] * ed; ki[j] = kk * __builtin_amdgcn_rcpf(ed); }
            u32x2 o; o.x = cvtpk(qe[0], qe[1]); o.y = cvtpk(qe[2], qe[3]); *(LAS u32x2*)(Qe + t * 136 + c4) = o;
            o.x = cvtpk(qi[0], qi[1]); o.y = cvtpk(qi[2], qi[3]); *(LAS u32x2*)(Qi + t * 136 + c4) = o;
            o.x = cvtpk(ki[0], ki[1]); o.y = cvtpk(ki[2], ki[3]); *(LAS u32x2*)(Ki + t * 136 + c4) = o;
            Vt[(c4 + 0) * 72 + t] = (bf16_t)(in.vr[i].x & 0xffffu); Vt[(c4 + 1) * 72 + t] = (bf16_t)(in.vr[i].x >> 16);
            Vt[(c4 + 2) * 72 + t] = (bf16_t)(in.vr[i].y & 0xffffu); Vt[(c4 + 3) * 72 + t] = (bf16_t)(in.vr[i].y >> 16);
            off = off + (i == 0 ? T0 : i == 1 ? T1 : T2); } }
        __syncthreads();
        f32x16 acc = {};
#pragma unroll
        for (int ks = 0; ks < 8; ++ks) { const bf16x8 af = *(const LAS bf16x8*)(Qe + (tt * 32 + r32) * 136 + 16 * ks + 8 * hi);
            acc = MFMA32(af, __builtin_bit_cast(bf16x8, in.stf[ks]), acc); }
        unsigned short gs[16];
#pragma unroll
        for (int r = 0; r < 16; ++r) gs[r] = HGS[(size_t)(tt * 32 + crow(r, hi)) * 512];
        if (un >= 0) hgrn_c_load<1>(F, un, in);
        if (w < 4 && w != 1) { const int ti = w >> 1, si = w & 1; f32x16 a = {};
#pragma unroll
            for (int ks = 0; ks < 8; ++ks) { const bf16x8 af = *(const LAS bf16x8*)(Qi + (ti * 32 + r32) * 136 + 16 * ks + 8 * hi), bf = *(const LAS bf16x8*)(Ki + (si * 32 + r32) * 136 + 16 * ks + 8 * hi);
                a = MFMA32(af, bf, a); }
            const int sidx = si * 32 + r32;
#pragma unroll
            for (int r = 0; r < 16; ++r) { const int t = ti * 32 + crow(r, hi); att[t * 72 + sidx] = f2bf(sidx <= t ? a[r] : 0.f); } }
        __syncthreads();
#pragma unroll
        for (int ks = 0; ks < 4; ++ks) if (ks < 2 || tt == 1) { const bf16x8 af = *(const LAS bf16x8*)(att + (tt * 32 + r32) * 72 + 16 * ks + 8 * hi), bf = *(const LAS bf16x8*)(Vt + (vt * 32 + r32) * 72 + 16 * ks + 8 * hi);
            acc = MFMA32(af, bf, acc); }
#pragma unroll
        for (int r = 0; r < 16; ++r) { const float q = half_sum_dpp(acc[r] * acc[r]);
            if (r32 == 31) ssb[(tt * 32 + crow(r, hi)) * 4 + vt] = q; }
        if (un >= 0) hgrn_c_load<2>(F, un, in);
        __syncthreads();
        { bf16_t* MX = (bf16_t*)(F.ws + WS_RB) + m0 * 1024 + 512 + h * 128 + vt * 32 + r32;
#pragma unroll
          for (int r = 0; r < 16; ++r) { const int t = tt * 32 + crow(r, hi); const f32x4 s4 = *(const LAS f32x4*)(ssb + t * 4);
            const float rs = __builtin_amdgcn_rsqf(((s4[0] + s4[1]) + (s4[2] + s4[3])) * (1.f / 128.f) + 1e-6f);
            MX[(size_t)t * 1024] = f2bf(acc[r] * rs * gg * bf2f(gs[r])); } }
        if (un < 0) break;
        unit = un;
    }
    __syncthreads();
}
typedef short v4i16_t __attribute__((ext_vector_type(4)));
__device__ __forceinline__ s16x4 vtr(const LAS unsigned char* p) { return __builtin_bit_cast(s16x4, __builtin_amdgcn_ds_read_tr16_b64_v4i16((LAS v4i16_t*)p)); }
__device__ __forceinline__ float xhalf(float v) { return __shfl_xor(v, 32); }
__device__ __forceinline__ float dpp_x1(float v) { return __int_as_float(__builtin_amdgcn_update_dpp(0, __float_as_int(v), 0xB1, 0xF, 0xF, true)); }
__device__ __forceinline__ float dpp_x2(float v) { return __int_as_float(__builtin_amdgcn_update_dpp(0, __float_as_int(v), 0x4E, 0xF, 0xF, true)); }

#define DPPMAX_(v, ctrl, rm) v = fmaxf(v, __int_as_float(__builtin_amdgcn_update_dpp(__float_as_int(v), __float_as_int(v), ctrl, rm, 0xF, false)))
__device__ __forceinline__ float wave_max_bcast(float v) {
    DPPMAX_(v, 0x111, 0xF); DPPMAX_(v, 0x112, 0xF); DPPMAX_(v, 0x114, 0xF); DPPMAX_(v, 0x118, 0xF); DPPMAX_(v, 0x142, 0xA); DPPMAX_(v, 0x143, 0xC);
    return __int_as_float(__builtin_amdgcn_readlane(__float_as_int(v), 63));
}
#define LADD(p, v) (void)__hip_atomic_fetch_add((p), (v), __ATOMIC_RELAXED, __HIP_MEMORY_SCOPE_WORKGROUP)
struct FlashSt { f32x16 o0, o1; float m, l; };
__device__ __forceinline__ void flash_init(FlashSt& s) { s.o0 = (f32x16){}; s.o1 = (f32x16){}; s.m = -INFINITY; s.l = 0.f; }

__device__ __forceinline__ void qk_block64(const LAS unsigned char* Kimg, const bf16x8 (&qr)[4], f32x16& p0, f32x16& p1, int klo, int khi, bool nomask, int r32, int hi) {
    const LAS unsigned char* kb = Kimg + hi * 1024 + r32 * 16;
    p0 = (f32x16){}; p1 = (f32x16){};
#pragma unroll
    for (int d0 = 0; d0 < 4; ++d0) { const bf16x8 b0 = *(const LAS bf16x8*)(kb + d0 * 2048), b1 = *(const LAS bf16x8*)(kb + d0 * 2048 + 512);
        p0 = MFMA32(b0, qr[d0], p0); p1 = MFMA32(b1, qr[d0], p1); }
    if (!nomask) {
#pragma unroll
        for (int r = 0; r < 16; ++r) { const int k0 = crow(r, hi); if (k0 < klo || k0 > khi) p0[r] = -INFINITY; if (k0 + 32 < klo || k0 + 32 > khi) p1[r] = -INFINITY; } }
}
__device__ __forceinline__ float rowmax32(const f32x16& p0, const f32x16& p1) {
    float a = fmaxf(p0[0], p1[0]);
#pragma unroll
    for (int r = 1; r < 16; ++r) a = fmaxf(a, fmaxf(p0[r], p1[r]));
    return fmaxf(a, xhalf(a));
}
__device__ __forceinline__ void flash_block64(const LAS unsigned char* Kimg, const LAS unsigned char* Vimg, const bf16x8 (&qr)[4], FlashSt& st, int klo, int khi, bool nomask, int lane) {
    const int r32 = lane & 31, hi = lane >> 5;
    f32x16 p0, p1; qk_block64(Kimg, qr, p0, p1, klo, khi, nomask, r32, hi);
    const float mx = rowmax32(p0, p1), mnew = fmaxf(st.m, mx), msafe = (mnew == -INFINITY) ? 0.f : mnew;
    const float alpha = fast_exp2(st.m - msafe); st.m = mnew;
    float sum = 0.f;
#pragma unroll
    for (int r = 0; r < 16; ++r) { p0[r] = fast_exp2(p0[r] - msafe); p1[r] = fast_exp2(p1[r] - msafe); sum += p0[r] + p1[r]; }
    sum += xhalf(sum); st.l = st.l * alpha + sum;
    st.o0 = st.o0 * alpha; st.o1 = st.o1 * alpha;
    u32x4 pw[4];
    pw[0] = (u32x4){cvtpk(p0[0], p0[1]), cvtpk(p0[2], p0[3]), cvtpk(p0[4], p0[5]), cvtpk(p0[6], p0[7])};
    pw[1] = (u32x4){cvtpk(p0[8], p0[9]), cvtpk(p0[10], p0[11]), cvtpk(p0[12], p0[13]), cvtpk(p0[14], p0[15])};
    pw[2] = (u32x4){cvtpk(p1[0], p1[1]), cvtpk(p1[2], p1[3]), cvtpk(p1[4], p1[5]), cvtpk(p1[6], p1[7])};
    pw[3] = (u32x4){cvtpk(p1[8], p1[9]), cvtpk(p1[10], p1[11]), cvtpk(p1[12], p1[13]), cvtpk(p1[14], p1[15])};
    const LAS unsigned char* vp = Vimg + ((lane >> 4) & 1) * 32 + (lane & 3) * 8 + (4 * hi + ((lane & 15) >> 2)) * 64;
#pragma unroll
    for (int ks = 0; ks < 4; ++ks) { const bf16x8 pa = __builtin_bit_cast(bf16x8, pw[ks]);
        { const s16x4 lo = vtr(vp + ks * 1024), hh = vtr(vp + ks * 1024 + 512); const bf16x8 vf = (bf16x8){lo[0], lo[1], lo[2], lo[3], hh[0], hh[1], hh[2], hh[3]}; st.o0 = MFMA32(vf, pa, st.o0); }
        { const s16x4 lo = vtr(vp + 4096 + ks * 1024), hh = vtr(vp + 4096 + ks * 1024 + 512); const bf16x8 vf = (bf16x8){lo[0], lo[1], lo[2], lo[3], hh[0], hh[1], hh[2], hh[3]}; st.o1 = MFMA32(vf, pa, st.o1); } }
}

#define MFMA16(a, b, c) __builtin_amdgcn_mfma_f32_16x16x32_bf16((a), (b), (c), 0, 0, 0)
constexpr int LDS_MISC = 139264;
constexpr int NSA_IMPLD = 257, NSA_WREG = 8 * 4 * NSA_IMPLD * 2, NSA_SELM = 8 * NSA_WREG, NSA_QNEED = NSA_SELM + 64 * 8 * 4, NSA_ILT = NSA_QNEED + 16 * 8 * 4, NSA_MISC = NSA_ILT + 8 * 32 * 4;
static_assert(NSA_MISC + (8 + 256) * 4 <= LDS_MISC && NSA_WREG >= 8 * NSA_IMPLD * 4 && NSA_WREG >= 8192 && NSA_WREG % 16 == 0, "NSA LDS map");
struct QS { f32x4 o[4]; f32x4 lacc; float m, l; };
__device__ __forceinline__ void qs_init(QS& s) { s.o[0] = (f32x4){0.f, 0.f, 0.f, 0.f}; s.o[1] = s.o[0]; s.o[2] = s.o[0]; s.o[3] = s.o[0]; s.lacc = s.o[0]; s.m = -INFINITY; s.l = 0.f; }
__device__ __forceinline__ float x16(float v) { return __shfl_xor(v, 16); }
__device__ __forceinline__ void quad_scores(const LAS unsigned char* KF, const bf16x8 (&qf)[2], f32x4 (&sc)[4], int klo, int khi, bool nomask, int lane, float negm = 0.f) {
#pragma unroll
    for (int kt = 0; kt < 4; ++kt) { sc[kt] = (f32x4){negm, negm, negm, negm};
#pragma unroll
        for (int ks = 0; ks < 2; ++ks) { const bf16x8 kf = *(const LAS bf16x8*)(KF + ((kt * 2 + ks) * 64 + lane) * 16); sc[kt] = MFMA16(kf, qf[ks], sc[kt]); } }
    if (!nomask) { const int g4 = lane >> 4;
#pragma unroll
        for (int kt = 0; kt < 4; ++kt)
#pragma unroll
            for (int i = 0; i < 4; ++i) { const int key = 16 * kt + 4 * g4 + i; if (key < klo || key > khi) sc[kt][i] = -INFINITY; } }
}
constexpr float QTHR = 6.0f;
#ifndef NSA_QTHR_IMP
#define NSA_QTHR_IMP 6.0f
#endif
constexpr float QTHR_IMP = NSA_QTHR_IMP;
template <bool IMP, class VLoad>
__device__ __forceinline__ float quad_core(f32x4 (&sc)[4], QS& st, const VLoad& vload, float (&pa)[4], float (&pe)[4]) {
    float moved = 1.f;
    float mxl = fmaxf(fmaxf(sc[0][0], sc[0][1]), fmaxf(sc[0][2], sc[0][3]));
#pragma unroll
    for (int kt = 1; kt < 4; ++kt) mxl = fmaxf(mxl, fmaxf(fmaxf(sc[kt][0], sc[kt][1]), fmaxf(sc[kt][2], sc[kt][3])));
    if (__any(st.m == -INFINITY ? (mxl > -INFINITY) : (mxl > (IMP ? QTHR_IMP : QTHR)))) {
        float mx = fmaxf(mxl, x16(mxl)); mx = fmaxf(mx, xhalf(mx));
        const float mold = (st.m == -INFINITY) ? 0.f : st.m;
        const float dl = (mx == -INFINITY) ? 0.f : fmaxf(mx, (st.m == -INFINITY) ? mx : 0.f);
        const float alpha = (st.m == -INFINITY) ? 0.f : fast_exp2(-dl);
        if (IMP) moved = (st.m == -INFINITY) ? 1.f : alpha;
        if (mx != -INFINITY) st.m = mold + dl;
        st.lacc = st.lacc * alpha;
#pragma unroll
        for (int dt = 0; dt < 4; ++dt) st.o[dt] = st.o[dt] * alpha;
#pragma unroll
        for (int kt = 0; kt < 4; ++kt) sc[kt] = sc[kt] - dl;
    }
#pragma unroll
    for (int kt = 0; kt < 4; ++kt)
#pragma unroll
        for (int i = 0; i < 4; ++i) sc[kt][i] = fast_exp2(sc[kt][i]);
    if (IMP) {
#pragma unroll
        for (int kt = 0; kt < 4; ++kt) { pa[kt] = (sc[kt][0] + sc[kt][1]) + (sc[kt][2] + sc[kt][3]); pe[kt] = sc[kt][3]; } }
    bf16x8 pb[2];
    pb[0] = __builtin_bit_cast(bf16x8, pack8(sc[0], sc[1])); pb[1] = __builtin_bit_cast(bf16x8, pack8(sc[2], sc[3]));
    const bf16x8 ones = (bf16x8){0x3f80, 0x3f80, 0x3f80, 0x3f80, 0x3f80, 0x3f80, 0x3f80, 0x3f80};
    st.lacc = MFMA16(ones, pb[0], st.lacc); st.lacc = MFMA16(ones, pb[1], st.lacc);
#pragma unroll
    for (int dt = 0; dt < 4; ++dt)
#pragma unroll
        for (int s2 = 0; s2 < 2; ++s2) st.o[dt] = MFMA16(vload(dt * 2 + s2), pb[s2], st.o[dt]);
    return moved;
}
__device__ __forceinline__ void qs_finish(QS& st) { st.l = st.lacc[0]; }
__device__ __forceinline__ void quad_block(const LAS unsigned char* KF, const LAS unsigned char* VF, const bf16x8 (&qf)[2], QS& st, int klo, int khi, bool nomask, int lane) {
    f32x4 sc[4]; quad_scores(KF, qf, sc, klo, khi, nomask, lane, (st.m == -INFINITY) ? 0.f : -st.m);
    float pa_[4], pe_[4]; (void)quad_core<false>(sc, st, [&](int f) { return *(const LAS bf16x8*)(VF + (f * 64 + lane) * 16); }, pa_, pe_);
    __builtin_amdgcn_sched_barrier(0);
}
template <bool IMP>
__device__ __forceinline__ float quad_block_ri(const bf16x8 (&kfr)[8], const bf16x8 (&vfr)[8], const bf16x8 (&qf)[2], QS& st, int klo, int khi, int lane, float (&pa)[4], float (&pe)[4]) {
    f32x4 sc[4]; const float negm = (st.m == -INFINITY) ? 0.f : -st.m;
#pragma unroll
    for (int kt = 0; kt < 4; ++kt) { sc[kt] = (f32x4){negm, negm, negm, negm};
#pragma unroll
        for (int ks = 0; ks < 2; ++ks) sc[kt] = MFMA16(kfr[kt * 2 + ks], qf[ks], sc[kt]); }
    if (!__all(khi >= 63 && klo <= 0)) { const int g4 = lane >> 4;
#pragma unroll
        for (int kt = 0; kt < 4; ++kt)
#pragma unroll
            for (int i = 0; i < 4; ++i) { const int key = 16 * kt + 4 * g4 + i; if (key > khi || key < klo) sc[kt][i] = -INFINITY; } }
    const float mv = quad_core<IMP>(sc, st, [&](int f) { return vfr[f]; }, pa, pe);
    __builtin_amdgcn_sched_barrier(0);
    return mv;
}
__device__ __forceinline__ void quad_block_r(const bf16x8 (&kfr)[8], const bf16x8 (&vfr)[8], const bf16x8 (&qf)[2], QS& st, int klo, int khi, int lane) {
    float pa_[4], pe_[4]; (void)quad_block_ri<false>(kfr, vfr, qf, st, klo, khi, lane, pa_, pe_);
}

#define WAVE_LDS_FENCE() do { __builtin_amdgcn_wave_barrier(); asm volatile("s_waitcnt lgkmcnt(0)" ::: "memory"); } while (0)
__device__ __forceinline__ void load_frags(const unsigned char* img, int lane, bf16x8 (&fr)[8]) {
    const u32x4* p = (const u32x4*)img + lane;
#pragma unroll
    for (int f = 0; f < 8; ++f) fr[f] = __builtin_bit_cast(bf16x8, p[f * 64]);
}
__device__ __forceinline__ int nsa_lane(const Frame& F) { int l = F.lane; asm volatile("" : "+v"(l)); return l; }
__device__ __forceinline__ void nsa_unit(Frame& F, int b, int g, int c, int flags) {
    const int tid = F.tid, lane = F.lane, w = F.wave, q16 = lane & 15, g4 = lane >> 4;
    const int tq = q16 >> 2, hh = q16 & 3;
    const int tokA = 8 * w + tq, tokB = tokA + 4;
    const int tA = 64 * c + tokA, tB = tA + 4; const size_t mA = (size_t)b * SEQ + tA;
    const int bg = b * 2 + g;
    LAS unsigned char* lds = F.lds;
    LAS unsigned char* wreg = lds + w * NSA_WREG;
    LAS unsigned short* imph = (LAS unsigned short*)wreg; LAS float* ilt = (LAS float*)(lds + NSA_ILT) + w * 32;
    LAS unsigned* selm = (LAS unsigned*)(lds + NSA_SELM); LAS unsigned* qneed = (LAS unsigned*)(lds + NSA_QNEED);
    LAS unsigned* misc = (LAS unsigned*)(lds + NSA_MISC);
    unsigned char* ws = F.ws;
    bf16x8 qfA[2], qfB[2];
    { const bf16_t* Q = (const bf16_t*)(ws + WS_QN) + mA * 512 + (g * 4 + hh) * 64 + 8 * g4;
      qfA[0] = *(const bf16x8*)Q; qfA[1] = *(const bf16x8*)(Q + 32); qfB[0] = *(const bf16x8*)(Q + 4 * 512); qfB[1] = *(const bf16x8*)(Q + 4 * 512 + 32); }
    bf16_t* SO = (flags & 0x10) ? (bf16_t*)F.out : (bf16_t*)(ws + WS_RA);
#define GATE_(QD, BR) (((const float*)(ws + WS_GATE))[((size_t)b * SEQ + 64 * c + tokA + 4 * (QD)) * 24 + (g * 4 + hh) * 3 + (BR)])
#define OROW_(QD) (SO + ((size_t)b * SEQ + 64 * c + tokA + 4 * (QD)) * 512 + (g * 4 + hh) * 64)
    QS sA, sB;
    LAS f32x4* stash = (LAS f32x4*)wreg;
#define NSA_ACC1(ST, QD, GV, FIRST) do { const float sc_ = (ST).l > 0.f ? (GV) / (ST).l : 0.f; \
        _Pragma("unroll") for (int dt = 0; dt < 4; ++dt) { f32x4 a_ = (ST).o[dt] * sc_; LAS f32x4* p_ = stash + ((QD) * 4 + dt) * 64 + lane; \
            if (!(FIRST)) a_ = a_ + *p_; *p_ = a_; } } while (0)

#define NMAXA_ ((64 * c + tokA >= 31) ? ((64 * c + tokA - 31) >> 4) : -1)
#define NMAXB_ ((64 * c + tokB >= 31) ? ((64 * c + tokB - 31) >> 4) : -1)
    const int ncb = (((64 * c + 8 * w + 7 - 31) >> 4) >> 6) + 1;
    const unsigned char* KCb = ws + WS_KC + (size_t)bg * 16 * 8192; const unsigned char* VCb = ws + WS_VC + (size_t)bg * 16 * 8192;
    qs_init(sA); qs_init(sB);
    const bool want_imp = (c >= 16) && !(flags & 0x40);
    if (!(flags & 0x80)) { const int lane = nsa_lane(F), q16 = lane & 15, g4 = lane >> 4, tq = q16 >> 2, hh = q16 & 3, tokA = 8 * w + tq, tokB = tokA + 4; (void)q16; (void)g4; (void)tq; (void)hh; (void)tokA; (void)tokB; const int nmaxA = NMAXA_, nmaxB = NMAXB_;
        float carA = 0.f, carB = 0.f;
#pragma nounroll
        for (int kb = 0; kb < ncb; ++kb) { bf16x8 kfr[8], vfr[8]; load_frags(KCb + (size_t)kb * 8192, lane, kfr); load_frags(VCb + (size_t)kb * 8192, lane, vfr);
            if (want_imp) {
#pragma unroll
                for (int qd = 0; qd < 2; ++qd) { float pa[4], pe[4];
                    const float al = quad_block_ri<true>(kfr, vfr, qd ? qfB : qfA, qd ? sB : sA, 0, (qd ? nmaxB : nmaxA) - 64 * kb, lane, pa, pe);
                    float car = (qd ? carB : carA) * al; LAS unsigned short* hrow = imph + ((tq + 4 * qd) * 4 + hh) * NSA_IMPLD + g4;
                    if (__any(al != 1.f)) {
#pragma nounroll
                        for (int e = 0; e < 4 * kb; ++e) { LAS unsigned short* hp = hrow + 4 * e; *hp = __builtin_bit_cast(unsigned short, (_Float16)((float)__builtin_bit_cast(_Float16, *hp) * al)); } }
                    hrow += 16 * kb;
#pragma unroll
                    for (int kt = 0; kt < 4; ++kt) { const float offer = (g4 == 3) ? (kt == 0 ? car : pe[kt - 1]) : pe[kt];
                        const float got = __shfl(offer, (lane - 16) & 63);
                        hrow[4 * kt] = __builtin_bit_cast(unsigned short, (_Float16)(pa[kt] + got)); }
                    if (qd) carB = pe[3]; else carA = pe[3]; }
            } else { quad_block_r(kfr, vfr, qfA, sA, 0, nmaxA - 64 * kb, lane); quad_block_r(kfr, vfr, qfB, sB, 0, nmaxB - 64 * kb, lane); } } }
    qs_finish(sA); qs_finish(sB);
    if (want_imp) { const int lane = nsa_lane(F), q16 = lane & 15, g4 = lane >> 4, tq = q16 >> 2, hh = q16 & 3, tokA = 8 * w + tq, tokB = tokA + 4; (void)q16; (void)g4; (void)tq; (void)hh; (void)tokA; (void)tokB;
      if (g4 == 0) { ilt[tq * 4 + hh] = sA.l > 0.f ? 1.0f / sA.l : 0.f; ilt[(tq + 4) * 4 + hh] = sB.l > 0.f ? 1.0f / sB.l : 0.f; }
        WAVE_LDS_FENCE();
        { const int tk = lane >> 3, s8 = lane & 7; float v[32];
          { const LAS unsigned short* h0 = imph + (tk * 4) * NSA_IMPLD; const f32x4 il4 = *(const LAS f32x4*)(ilt + tk * 4);
#pragma unroll
            for (int i = 0; i < 32; ++i) { const int j = s8 + 8 * i; float a = -1.f;
                if (j >= 1 && j <= c - 2) a = ((float)__builtin_bit_cast(_Float16, h0[j]) * il4[0] + (float)__builtin_bit_cast(_Float16, h0[NSA_IMPLD + j]) * il4[1])
                                            + ((float)__builtin_bit_cast(_Float16, h0[2 * NSA_IMPLD + j]) * il4[2] + (float)__builtin_bit_cast(_Float16, h0[3 * NSA_IMPLD + j]) * il4[3]);
                v[i] = a; } }
          selm[(8 * w) * 8 + lane] = 0u;
          WAVE_LDS_FENCE();
#pragma nounroll
          for (int it = 0; it < ((flags & 0x400) ? 1 : 13); ++it) {
              float bv = v[0]; int bi = 0;
#pragma unroll
              for (int i = 1; i < 32; ++i) { const bool gt = v[i] > bv; bv = gt ? v[i] : bv; bi = gt ? i : bi; }
              const int j = s8 + 8 * bi;
              long long key = ((long long)__float_as_int(bv) << 32) | (long long)(unsigned)(255 - j);
#define KEYMAX_(ctrl) do { const int lo_ = __builtin_amdgcn_update_dpp(0, (int)(unsigned)key, ctrl, 0xF, 0xF, true), hi_ = __builtin_amdgcn_update_dpp(0, (int)(key >> 32), ctrl, 0xF, 0xF, true); \
                  const long long o_ = ((long long)hi_ << 32) | (long long)(unsigned)lo_; key = o_ > key ? o_ : key; } while (0)
              const long long mine = key;
              KEYMAX_(0xB1); KEYMAX_(0x4E); KEYMAX_(0x141);
#undef KEYMAX_
              const bool win = (mine == key);
              if (win) (void)__hip_atomic_fetch_or(selm + (8 * w + tk) * 8 + (j >> 5), 1u << (j & 31), __ATOMIC_RELAXED, __HIP_MEMORY_SCOPE_WORKGROUP);
#pragma unroll
              for (int i = 0; i < 32; ++i) v[i] = (win && i == bi) ? -1.f : v[i];
          }
          WAVE_LDS_FENCE();
          if (lane < 8) { LAS unsigned* sm = selm + (8 * w + lane) * 8; sm[0] |= 1u; sm[(c - 1) >> 5] |= 1u << ((c - 1) & 31); sm[c >> 5] |= 1u << (c & 31); } }
    } else { const int lane = nsa_lane(F), q16 = lane & 15, g4 = lane >> 4, tq = q16 >> 2, hh = q16 & 3, tokA = 8 * w + tq, tokB = tokA + 4; (void)q16; (void)g4; (void)tq; (void)hh; (void)tokA; (void)tokB;
        if (lane < 8) {
#pragma unroll
            for (int i = 0; i < 8; ++i) selm[(8 * w + lane) * 8 + i] = (i == 0) ? ((2u << (c < 16 ? c : 15)) - 1u) : 0u; }
    }
    { const int lane = nsa_lane(F), q16 = lane & 15, g4 = lane >> 4, tq = q16 >> 2, hh = q16 & 3, tokA = 8 * w + tq, tokB = tokA + 4; (void)q16; (void)g4; (void)tq; (void)hh; (void)tokA; (void)tokB;
    WAVE_LDS_FENCE();
    NSA_ACC1(sA, 0, GATE_(0, 0), true); NSA_ACC1(sB, 1, GATE_(1, 0), true);
    if (lane < 16) { const int qd = 2 * w + (lane >> 3), wi = lane & 7;
        qneed[qd * 8 + wi] = selm[(4 * qd + 0) * 8 + wi] | selm[(4 * qd + 1) * 8 + wi] | selm[(4 * qd + 2) * 8 + wi] | selm[(4 * qd + 3) * 8 + wi]; }
    WAVE_LDS_FENCE();
    }
    const unsigned char* KSb = ws + WS_KS + (size_t)bg * 256 * 8192; const unsigned char* VSb = ws + WS_VS + (size_t)bg * 256 * 8192;
    qs_init(sA); qs_init(sB);
    if (!(flags & 0x20)) { const int lane = nsa_lane(F), q16 = lane & 15, g4 = lane >> 4, tq = q16 >> 2, hh = q16 & 3, tokA = 8 * w + tq, tokB = tokA + 4; (void)q16; (void)g4; (void)tq; (void)hh; (void)tokA; (void)tokB;
#pragma nounroll
        for (int wi = 0; wi < 8; ++wi) {
            const unsigned nA = (unsigned)__builtin_amdgcn_readfirstlane((int)qneed[(2 * w) * 8 + wi]), nB = (unsigned)__builtin_amdgcn_readfirstlane((int)qneed[(2 * w + 1) * 8 + wi]);
            const unsigned swA = selm[tokA * 8 + wi], swB = selm[tokB * 8 + wi];
            unsigned mm = nA | nB;
#pragma nounroll
            while (mm) { const int bit = __builtin_ctz(mm); mm &= mm - 1u; const int j = 32 * wi + bit;
                bf16x8 kfr[8], vfr[8]; load_frags(KSb + (size_t)j * 8192, lane, kfr); load_frags(VSb + (size_t)j * 8192, lane, vfr);
                if ((nA >> bit) & 1u) { const int kh = ((swA >> bit) & 1u) ? ((j == c) ? tokA : 63) : -1; quad_block_r(kfr, vfr, qfA, sA, 0, kh, lane); }
                if ((nB >> bit) & 1u) { const int kh = ((swB >> bit) & 1u) ? ((j == c) ? tokB : 63) : -1; quad_block_r(kfr, vfr, qfB, sB, 0, kh, lane); }
            } } }
    qs_finish(sA); qs_finish(sB);
    { const int lane = nsa_lane(F), q16 = lane & 15, g4 = lane >> 4, tq = q16 >> 2, hh = q16 & 3, tokA = 8 * w + tq, tokB = tokA + 4; (void)q16; (void)g4; (void)tq; (void)hh; (void)tokA; (void)tokB;
    NSA_ACC1(sA, 0, GATE_(0, 1), false); NSA_ACC1(sB, 1, GATE_(1, 1), false); }
    const int jw0 = c >= 8 ? c - 8 : 0;
    const unsigned char* KWb = ws + WS_KW + (size_t)bg * 256 * 8192; const unsigned char* VWb = ws + WS_VW + (size_t)bg * 256 * 8192;
    qs_init(sA); qs_init(sB);
    if (!(flags & 0x100)) { const int lane = nsa_lane(F), q16 = lane & 15, g4 = lane >> 4, tq = q16 >> 2, hh = q16 & 3, tokA = 8 * w + tq, tokB = tokA + 4; (void)q16; (void)g4; (void)tq; (void)hh; (void)tokA; (void)tokB;
#pragma nounroll
        for (int j = jw0; j <= c; ++j) { bf16x8 kfr[8], vfr[8]; load_frags(KWb + (size_t)j * 8192, lane, kfr); load_frags(VWb + (size_t)j * 8192, lane, vfr);
            int klA = 0, khA = 63, klB = 0, khB = 63;
            if (j == c) { khA = tokA; khB = tokB; } else if (j == c - 8) { klA = tokA + 1; klB = tokB + 1; }
            quad_block_r(kfr, vfr, qfA, sA, klA, khA, lane); quad_block_r(kfr, vfr, qfB, sB, klB, khB, lane); } }
    qs_finish(sA); qs_finish(sB);
    { const int lane = nsa_lane(F), q16 = lane & 15, g4 = lane >> 4, tq = q16 >> 2, hh = q16 & 3, tokA = 8 * w + tq, tokB = tokA + 4; (void)q16; (void)g4; (void)tq; (void)hh; (void)tokA; (void)tokB; bf16_t* orowA = OROW_(0); bf16_t* orowB = OROW_(1);
      const float scA = sA.l > 0.f ? GATE_(0, 2) / sA.l : 0.f, scB = sB.l > 0.f ? GATE_(1, 2) / sB.l : 0.f;
#pragma unroll
      for (int dt = 0; dt < 4; ++dt) { const f32x4 a = stash[(0 * 4 + dt) * 64 + lane] + sA.o[dt] * scA, bq2 = stash[(1 * 4 + dt) * 64 + lane] + sB.o[dt] * scB;
          u32x2 wa; wa.x = cvtpk(a[0], a[1]); wa.y = cvtpk(a[2], a[3]); *(u32x2*)(orowA + 16 * dt + 4 * g4) = wa;
          u32x2 wb; wb.x = cvtpk(bq2[0], bq2[1]); wb.y = cvtpk(bq2[2], bq2[3]); *(u32x2*)(orowB + 16 * dt + 4 * g4) = wb; } }
#undef NSA_ACC1
#undef GATE_
#undef OROW_
#undef NMAXA_
#undef NMAXB_
    if (flags & 0x10) { __syncthreads(); return; }
    asm volatile("s_waitcnt vmcnt(0)" ::: "memory");
    __syncthreads();
    if (tid == 0) { __builtin_amdgcn_fence(__ATOMIC_RELEASE, "agent"); asm volatile("s_waitcnt vmcnt(0)" ::: "memory");
        const unsigned tk = __hip_atomic_fetch_add(F.ctl + CW_TILECNT + b * 256 + c, 1u, __ATOMIC_RELAXED, __HIP_MEMORY_SCOPE_AGENT);
        if (tk & 1u) { __builtin_amdgcn_fence(__ATOMIC_ACQUIRE, "agent"); asm volatile("s_waitcnt vmcnt(0)" ::: "memory"); }
        misc[0] = tk & 1u; }
    __syncthreads();
    if (misc[0] == 1u) { const float* gnorm = F.in[I_NSAG];
#pragma nounroll
        for (int tk = 0; tk < 8; ++tk) { const size_t mm = (size_t)b * SEQ + 64 * c + 8 * w + tk; const u32x4 rw = *((const u32x4*)(SO + mm * 512) + lane);
            const f32x4 v0 = (f32x4){bflo(rw.x), bfhi(rw.x), bflo(rw.y), bfhi(rw.y)}, v1 = (f32x4){bflo(rw.z), bfhi(rw.z), bflo(rw.w), bfhi(rw.w)};
            float ss = (v0[0] * v0[0] + v0[1] * v0[1]) + (v0[2] * v0[2] + v0[3] * v0[3]) + (v1[0] * v1[0] + v1[1] * v1[1]) + (v1[2] * v1[2] + v1[3] * v1[3]);
            ss = wave_sum(ss); const float rs = __builtin_amdgcn_rsqf(ss * (1.f / 512.f) + 1e-6f);
            const f32x4 g0 = ((const f32x4*)gnorm)[2 * lane], g1 = ((const f32x4*)gnorm)[2 * lane + 1];
            bf16_t* MX = (bf16_t*)(ws + WS_RB) + mm * 1024;
            ((u32x4*)MX)[lane] = pack8(v0 * rs * g0, v1 * rs * g1); } }
    __syncthreads();
}

__device__ __forceinline__ void cmp2_unit(Frame& F, int kv, int pm) {
    const int lane = F.lane, w = F.wave, r32 = lane & 31, hi = lane >> 5;
    const bf16_t* W2 = (const bf16_t*)(F.ws + (kv ? WS_W2V : WS_W2K)); const bf16_t* HID = (const bf16_t*)(F.ws + WS_HID) + ((size_t)kv * 4096 + pm * 256 + w * 32 + r32) * 256;
    f32x16 a0 = {}, a1 = {};
#pragma unroll
    for (int ks = 0; ks < 16; ++ks) { const bf16x8 hb = *(const bf16x8*)(HID + 16 * ks + 8 * hi);
        const bf16x8 w0 = *(const bf16x8*)(W2 + (size_t)r32 * 256 + 16 * ks + 8 * hi), w1 = *(const bf16x8*)(W2 + (size_t)(32 + r32) * 256 + 16 * ks + 8 * hi);
        a0 = MFMA32(w0, hb, a0); a1 = MFMA32(w1, hb, a1); }
    const int bg = pm >> 2, i = (pm & 3) * 256 + w * 32 + r32, blk = i >> 6, key = i & 63;
    unsigned char* img = F.ws + (kv ? WS_VC : WS_KC) + (size_t)(bg * 16 + blk) * 8192;
    if (i == 1023) { a0 = (f32x16){}; a1 = (f32x16){}; }
#pragma unroll
    for (int k = 0; k < 4; ++k) { u32x2 o0, o1; o0.x = cvtpk(a0[4 * k], a0[4 * k + 1]); o0.y = cvtpk(a0[4 * k + 2], a0[4 * k + 3]); o1.x = cvtpk(a1[4 * k], a1[4 * k + 1]); o1.y = cvtpk(a1[4 * k + 2], a1[4 * k + 3]);
        const int d0 = 8 * k + 4 * hi, d1 = 32 + d0;
        if (kv == 0) { *(u32x2*)(img + kf_off(key, d0)) = o0; *(u32x2*)(img + kf_off(key, d1)) = o1; }
        else { *(bf16_t*)(img + vf_off(key, d0)) = (bf16_t)(o0.x & 0xffffu); *(bf16_t*)(img + vf_off(key, d0 + 1)) = (bf16_t)(o0.x >> 16); *(bf16_t*)(img + vf_off(key, d0 + 2)) = (bf16_t)(o0.y & 0xffffu); *(bf16_t*)(img + vf_off(key, d0 + 3)) = (bf16_t)(o0.y >> 16);
               *(bf16_t*)(img + vf_off(key, d1)) = (bf16_t)(o1.x & 0xffffu); *(bf16_t*)(img + vf_off(key, d1 + 1)) = (bf16_t)(o1.x >> 16); *(bf16_t*)(img + vf_off(key, d1 + 2)) = (bf16_t)(o1.y & 0xffffu); *(bf16_t*)(img + vf_off(key, d1 + 3)) = (bf16_t)(o1.y >> 16); } }
}

__device__ __forceinline__ void xattn_phase(Frame& F, int ul0, int ul1, int ul2, int ul3, int nun) {
    const int w = F.wave, tg = w >> 1, dh = w & 1;
    LAS unsigned char* lds = F.lds;
    const int nsteps = 4 * nun;
    if (nsteps <= 0) return;
#define XA_UNIT(G_) ((G_) == 0 ? ul0 : (G_) == 1 ? ul1 : (G_) == 2 ? ul2 : ul3)
#define XA_SRC(S, I) ({ const int u_ = XA_UNIT((S) >> 2), bh_ = u_ >> 7, kb_ = (S) & 3; \
        (const u32x4*)(F.ws + ((I) < 4 ? WS_MEMK : WS_MEMV) + ((size_t)bh_ * 4 + kb_) * 32768) + F.tid + 512 * ((I) & 3); })
    { u32x4 r[8];
#pragma unroll
      for (int i = 0; i < 8; ++i) r[i] = *XA_SRC(0, i);
#pragma unroll
      for (int i = 0; i < 8; ++i) *(LAS u32x4*)(lds + (i >> 2) * 32768 + (F.tid + 512 * (i & 3)) * 16) = r[i]; }
    __syncthreads();
    bf16x8 qr[16]; f32x16 o[4]; float mrun = -INFINITY, lrun = 0.f; bf16_t* QO = nullptr;
    for (int s = 0; s < nsteps; ++s) {
        int tid = F.tid; asm volatile("" : "+v"(tid));
        const int lane = tid & 63, r32 = lane & 31, hi = lane >> 5;
        const int u = XA_UNIT(s >> 2), tile = u & 127, bh = u >> 7, kb = s & 3;
        if (kb == 0) { const size_t m = (size_t)(bh >> 2) * SEQ + 128 * tile + 32 * tg + r32; QO = (bf16_t*)(F.ws + WS_RB) + m * 1024 + (bh & 3) * 256;
#pragma unroll
            for (int d0 = 0; d0 < 16; ++d0) qr[d0] = *(const bf16x8*)(QO + 16 * d0 + 8 * hi);
            o[0] = (f32x16){}; o[1] = (f32x16){}; o[2] = (f32x16){}; o[3] = (f32x16){}; mrun = -INFINITY; lrun = 0.f; }
        u32x4 r[8]; const bool more = (s + 1 < nsteps);
        if (more) {
#pragma unroll
            for (int i = 0; i < 8; ++i) r[i] = *XA_SRC(s + 1, i); }
        const LAS unsigned char* buf = lds + (s & 1) * 65536;
        f32x16 p0 = {}, p1 = {};
        const LAS unsigned char* kp = buf + hi * 1024 + r32 * 16;
#pragma unroll
        for (int d0 = 0; d0 < 16; ++d0) { const bf16x8 b0 = *(const LAS bf16x8*)(kp + d0 * 2048), b1 = *(const LAS bf16x8*)(kp + d0 * 2048 + 512);
            p0 = MFMA32(b0, qr[d0], p0); p1 = MFMA32(b1, qr[d0], p1); }
        const float mx = rowmax32(p0, p1), mnew = fmaxf(mrun, mx), alpha = fast_exp2(mrun - mnew); mrun = mnew;
        float sum = 0.f;
#pragma unroll
        for (int r2 = 0; r2 < 16; ++r2) { p0[r2] = fast_exp2(p0[r2] - mnew); p1[r2] = fast_exp2(p1[r2] - mnew); sum += p0[r2] + p1[r2]; }
        sum += xhalf(sum); lrun = lrun * alpha + sum;
#pragma unroll
        for (int i = 0; i < 4; ++i) o[i] = o[i] * alpha;
        u32x4 pw[4];
        pw[0] = (u32x4){cvtpk(p0[0], p0[1]), cvtpk(p0[2], p0[3]), cvtpk(p0[4], p0[5]), cvtpk(p0[6], p0[7])};
        pw[1] = (u32x4){cvtpk(p0[8], p0[9]), cvtpk(p0[10], p0[11]), cvtpk(p0[12], p0[13]), cvtpk(p0[14], p0[15])};
        pw[2] = (u32x4){cvtpk(p1[0], p1[1]), cvtpk(p1[2], p1[3]), cvtpk(p1[4], p1[5]), cvtpk(p1[6], p1[7])};
        pw[3] = (u32x4){cvtpk(p1[8], p1[9]), cvtpk(p1[10], p1[11]), cvtpk(p1[12], p1[13]), cvtpk(p1[14], p1[15])};
        const LAS unsigned char* vp = buf + 32768 + dh * 16384 + ((lane >> 4) & 1) * 32 + (lane & 3) * 8 + (4 * hi + ((lane & 15) >> 2)) * 64;
#pragma unroll
        for (int ks = 0; ks < 4; ++ks) { const bf16x8 pa = __builtin_bit_cast(bf16x8, pw[ks]);
#pragma unroll
            for (int i = 0; i < 4; ++i) { const s16x4 lo = vtr(vp + i * 4096 + ks * 1024), hh2 = vtr(vp + i * 4096 + ks * 1024 + 512);
                const bf16x8 vf = (bf16x8){lo[0], lo[1], lo[2], lo[3], hh2[0], hh2[1], hh2[2], hh2[3]}; o[i] = MFMA32(vf, pa, o[i]); } }
        if (more) { LAS unsigned char* nb = lds + ((s + 1) & 1) * 65536;
#pragma unroll
            for (int i = 0; i < 8; ++i) *(LAS u32x4*)(nb + (i >> 2) * 32768 + (tid + 512 * (i & 3)) * 16) = r[i]; }
        __syncthreads();
        if (kb == 3) { const float inv = 1.0f / lrun;
#pragma unroll
            for (int i = 0; i < 4; ++i)
#pragma unroll
                for (int k = 0; k < 4; ++k) { u32x2 ov; ov.x = cvtpk(o[i][4 * k] * inv, o[i][4 * k + 1] * inv); ov.y = cvtpk(o[i][4 * k + 2] * inv, o[i][4 * k + 3] * inv);
                    *(u32x2*)(QO + 128 * dh + 32 * i + 8 * k + 4 * hi) = ov; } }
    }
#undef XA_SRC
#undef XA_UNIT
}
__device__ __forceinline__ void router_phase(Frame& F, LAS unsigned* rl, LAS unsigned* lcnt, bool skip) {
    const int lane = F.lane, w = F.wave, r16 = lane & 15, q4 = lane >> 4;
    LAS float* gb = (LAS float*)F.lds; LAS float* lg = (LAS float*)(F.lds + 8192 + w * 3072);
    LAS unsigned char* wimg = F.lds + 32768;
    constexpr int WQB = 96 * 512;
    const int wu = __builtin_amdgcn_readfirstlane(w);
    for (int i = F.tid; i < 1024; i += NTHR) { gb[i] = F.in[I_LN2G][i]; gb[1024 + i] = F.in[I_LN2B][i]; }
    const int gwv = F.bid * NWAVES + w, NGWv = F.G * NWAVES, ngr = skip ? 0 : NTOK / 16;
    unsigned wsrc[6];
#pragma unroll
    for (int i = 0; i < 6; ++i) { const int row = 2 * (w + 8 * i) + (lane >> 5), pch = lane & 31, part = row >= 48 ? 1 : 0;
        wsrc[i] = (unsigned)(part * (int)(WS_WRL - WS_WRH) + ((row - 48 * part) * 1024 + 8 * (pch ^ (row & 15))) * 2); }
#define RT_STAGE(Q, B) do { _Pragma("unroll") for (int i_ = 0; i_ < 6; ++i_) \
        __builtin_amdgcn_global_load_lds((const unsigned*)(F.ws + WS_WRH + wsrc[i_] + 512 * (Q)), (LAS unsigned*)(wimg + (B) * WQB + (wu + 8 * i_) * 1024), 16, 0, 0); } while (0)
    int kslot = 0;
    for (int tg0 = 0; tg0 < ngr; tg0 += NGWv, ++kslot) {
        const int tg = tg0 + gwv; const bool act = tg < ngr;
        const int m = (act ? tg : 0) * 16 + r16;
        const f32x2 st = *(const f32x2*)((const float*)(F.ws + WS_STAT2) + (size_t)m * 2);
        const u32x4* xp = (const u32x4*)((const bf16_t*)(F.ws + WS_RA) + (size_t)m * 1024 + 8 * q4);
        u32x4 xr[32];
#pragma unroll
        for (int i = 0; i < 32; ++i) xr[i] = xp[4 * i];
        __syncthreads();
        RT_STAGE(0, 0);
        const float mean = st[0] * (1.f / 1024.f), rstd = 1.0f / sqrtf(fmaxf(st[1] * (1.f / 1024.f) - mean * mean, 0.f) + 1e-5f);
        f32x4 acc[3]; acc[0] = (f32x4){0.f, 0.f, 0.f, 0.f}; acc[1] = acc[0]; acc[2] = acc[0];
#pragma unroll
        for (int h = 0; h < 4; ++h) {
            asm volatile("s_waitcnt vmcnt(0)" ::: "memory");
            __syncthreads();
            if (h < 3) RT_STAGE(h + 1, (h + 1) & 1);
            const LAS unsigned char* wf = wimg + (h & 1) * WQB + r16 * 512;
#pragma unroll
            for (int u = 0; u < 8; ++u) { const int s = 8 * h + u; const u32x4 xw = xr[s];
                const LAS f32x4* gp = (const LAS f32x4*)(gb + 32 * s + 8 * q4); const LAS f32x4* bp = (const LAS f32x4*)(gb + 1024 + 32 * s + 8 * q4);
                const f32x4 g0 = gp[0], g1 = gp[1], b0 = bp[0], b1 = bp[1];
                const f32x4 x0 = ((f32x4){bflo(xw.x), bfhi(xw.x), bflo(xw.y), bfhi(xw.y)} - mean) * rstd * g0 + b0, x1 = ((f32x4){bflo(xw.z), bfhi(xw.z), bflo(xw.w), bfhi(xw.w)} - mean) * rstd * g1 + b1;
                const u32x4 hw = pack8(x0, x1);
                const f32x4 h0 = (f32x4){bflo(hw.x), bfhi(hw.x), bflo(hw.y), bfhi(hw.y)}, h1 = (f32x4){bflo(hw.z), bfhi(hw.z), bflo(hw.w), bfhi(hw.w)};
                const u32x4 lw = pack8(x0 - h0, x1 - h1);
                const bf16x8 ah = __builtin_bit_cast(bf16x8, hw), al = __builtin_bit_cast(bf16x8, lw);
                const int co = 16 * ((4 * u + q4) ^ r16);
#pragma unroll
                for (int ct = 0; ct < 3; ++ct) { const bf16x8 bh = *(const LAS bf16x8*)(wf + (16 * ct) * 512 + co), bl = *(const LAS bf16x8*)(wf + (48 + 16 * ct) * 512 + co);
                    acc[ct] = MFMA16(ah, bh, acc[ct]); acc[ct] = MFMA16(ah, bl, acc[ct]); acc[ct] = MFMA16(al, bh, acc[ct]); }
            }
        }
#pragma unroll
        for (int ct = 0; ct < 3; ++ct)
#pragma unroll
            for (int i = 0; i < 4; ++i) lg[(4 * q4 + i) * 48 + 16 * ct + r16] = acc[ct][i];
        WAVE_LDS_FENCE();
        if (act && lane < 16) { const LAS float* L = lg + lane * 48; const int t = tg * 16 + lane;
            float gl[4];
#pragma unroll
            for (int i = 0; i < 4; ++i) gl[i] = L[i] + F.in[I_MBG][i];
            int gi = 0; float gm = gl[0];
#pragma unroll
            for (int i = 1; i < 4; ++i) if (gl[i] > gm) { gm = gl[i]; gi = i; }
            float gden = 0.f;
#pragma unroll
            for (int i = 0; i < 4; ++i) gden += __expf(gl[i] - gm);
            const float gw = 1.0f / gden;
            float el[8];
#pragma unroll
            for (int e = 0; e < 8; ++e) el[e] = L[4 + gi * 8 + e] + F.in[I_MBE][gi * 8 + e];
            int i0 = 0; float m0 = el[0];
#pragma unroll
            for (int i = 1; i < 8; ++i) if (el[i] > m0) { m0 = el[i]; i0 = i; }
            int i1 = -1; float m1 = -INFINITY;
#pragma unroll
            for (int i = 0; i < 8; ++i) if (i != i0 && el[i] > m1) { m1 = el[i]; i1 = i; }
            const float e1 = __expf(m1 - m0), w0 = 1.0f / (1.0f + e1), w1 = e1 * w0;
            const unsigned ea = (unsigned)(gi * 8 + i0), eb = (unsigned)(gi * 8 + i1);
            LAS unsigned* r = rl + 4 * (w * 24 + kslot * 16 + lane);
            r[0] = ea; r[1] = eb;
            r[2] = __hip_atomic_fetch_add(lcnt + ea, 1u, __ATOMIC_RELAXED, __HIP_MEMORY_SCOPE_WORKGROUP);
            r[3] = __hip_atomic_fetch_add(lcnt + eb, 1u, __ATOMIC_RELAXED, __HIP_MEMORY_SCOPE_WORKGROUP);
            *(f32x2*)(F.ws + WS_ROUTEW + (size_t)t * 8) = (f32x2){gw * w0, gw * w1}; }
        WAVE_LDS_FENCE();
    }
}

#undef RT_STAGE
constexpr int MOE_LDS = LDS_MISC + 1024;
__device__ __forceinline__ void moe_offsets(Frame& F) {
    LAS unsigned* off = (LAS unsigned*)(F.lds + MOE_LDS); LAS unsigned* tmp = off + 64;
    if (F.tid < 32) tmp[F.tid] = (__hip_atomic_load(F.ctl + CW_ECNT + 32 * F.tid, __ATOMIC_RELAXED, __HIP_MEMORY_SCOPE_AGENT) + 255u) & ~255u;
    __syncthreads();
    if (F.tid == 0) { unsigned s = 0;
#pragma unroll
        for (int e = 0; e < 32; ++e) { off[e] = s; s += tmp[e]; }
        off[32] = s; }
    __syncthreads();
    if (F.tid < 288) { const unsigned slot0 = (unsigned)F.tid << 8; int e = 0;
#pragma unroll
        for (int k = 1; k < 32; ++k) e = (off[k] <= slot0) ? k : e;
        off[128 + F.tid] = (unsigned)e; }
    __syncthreads();
}
struct MoeOrder {
    const char* A; const char* W; size_t atile, wexp, wtile; const LAS unsigned* off; int G, c;
    __device__ __forceinline__ bool next(int i, pg8::Unit& u) const {
        const unsigned L = (unsigned)(i * G + c), ntile = off[32] >> 8; if (L >= ntile * 4u) return false;
        const unsigned mt = L >> 2, pn = L & 3u; const int e = (int)off[128 + mt];
        u.pm = (int)mt; u.pn = (int)pn; u.aux = e; u.a = A + (size_t)mt * atile; u.b = W + (size_t)e * wexp + (size_t)pn * wtile; return true;
    }
};
#define XB_TMO      128
#define XB_XCNT(j)  (256  + 64 * (j))
#define XB_XSUB(j)  (1280 + 64 * (j))
#define XB_XGEN(j)  (2304 + 64 * (j))
#define XB_TOP      3328
#define XB_TOPGEN   3392
#define XCD_BAR_WORDS 4096
#define XB_SPIN_CAP (1u << 22)
__device__ __forceinline__ unsigned xb_ld(unsigned* p)              { return __hip_atomic_load(p, __ATOMIC_RELAXED, __HIP_MEMORY_SCOPE_AGENT); }
__device__ __forceinline__ unsigned xb_add(unsigned* p, unsigned v) { return __hip_atomic_fetch_add(p, v, __ATOMIC_RELAXED, __HIP_MEMORY_SCOPE_AGENT); }
__device__ __forceinline__ unsigned xb_xcc_id() { return (unsigned)__builtin_amdgcn_s_getreg((3 << 11) | 20) & 0xFu; }
#define XB_SPIN(cond, bar) do { unsigned _sp = 0; while (cond) { __builtin_amdgcn_s_sleep(1); \
    if ((++_sp & 255u) == 0u) { if (xb_ld(&(bar)[XB_TMO])) break; if (_sp > XB_SPIN_CAP) { atomicAdd(&(bar)[XB_TMO], 1u); break; } } } } while (0)
struct XcdBarrier { unsigned* bar; unsigned x; volatile LAS unsigned* st; };
__device__ __forceinline__ XcdBarrier xcd_barrier_post(unsigned* bar, volatile LAS unsigned* st) {
    XcdBarrier b; b.bar = bar; b.x = xb_xcc_id(); b.st = st;
    if (threadIdx.x == 0) (void)xb_add(&bar[XB_XCNT(b.x)], 1u);
    return b;
}
__device__ __forceinline__ void xcd_barrier_complete(unsigned* bar, unsigned x, unsigned& nloc, unsigned& nx) {
    const unsigned G = gridDim.x * gridDim.y * gridDim.z;
    unsigned sum, cnt, mine, sp = 0u;
    for (;;) {
        sum = 0u; cnt = 0u; mine = 0u;
#pragma unroll
        for (unsigned j = 0; j < 16; ++j) { const unsigned c = xb_ld(&bar[XB_XCNT(j)]); sum += c; cnt += (c > 0u) ? 1u : 0u; mine = (j == x) ? c : mine; }
        if (sum == G) break;
        __builtin_amdgcn_s_sleep(1);
        if ((++sp & 255u) == 0u) { if (xb_ld(&bar[XB_TMO])) break; if (sp > XB_SPIN_CAP) { atomicAdd(&bar[XB_TMO], 1u); break; } }
    }
    nloc = mine > 0u ? mine : 1u; nx = cnt > 0u ? cnt : 1u;
}
__device__ __forceinline__ void xcd_barrier(const XcdBarrier& b) {
    asm volatile("s_waitcnt vmcnt(0)" ::: "memory");
    __syncthreads();
    if (threadIdx.x == 0) {
        unsigned* bar = b.bar;
        __builtin_amdgcn_s_waitcnt(0);
        unsigned nloc = b.st[0], nx = b.st[1];
        if (nloc == 0u) { xcd_barrier_complete(bar, b.x, nloc, nx); b.st[0] = nloc; b.st[1] = nx; }
        const unsigned old = xb_add(&bar[XB_XSUB(b.x)], 1u);
        const unsigned gen = old / nloc;
        if (old + 1u == (gen + 1u) * nloc) {
            __builtin_amdgcn_fence(__ATOMIC_RELEASE, "agent");
            asm volatile("s_waitcnt vmcnt(0)" ::: "memory");
            const unsigned og = xb_add(&bar[XB_TOP], 1u);
            const unsigned tg = og / nx;
            if (og + 1u == (tg + 1u) * nx) xb_add(&bar[XB_TOPGEN], 1u);
            else XB_SPIN(xb_ld(&bar[XB_TOPGEN]) == tg, bar);
            __builtin_amdgcn_fence(__ATOMIC_ACQUIRE, "agent");
            xb_add(&bar[XB_XGEN(b.x)], 1u);
            asm volatile("s_waitcnt vmcnt(0)" ::: "memory");
        } else {
            XB_SPIN(xb_ld(&bar[XB_XGEN(b.x)]) == gen, bar);
            __builtin_amdgcn_fence(__ATOMIC_ACQUIRE, "agent");
            asm volatile("s_waitcnt vmcnt(0)" ::: "memory");
        }
    }
    __syncthreads();
}

#ifndef REP_P4
#define REP_P4 1
#endif
#ifndef NSA_CALL
#define NSA_CALL nsa_unit(F, bg >> 1, bg & 1, c, args.rep);
#endif
#ifndef HGC_CALL
#define HGC_CALL ;
#endif
struct OneUnit { pg8::Unit u; __device__ __forceinline__ bool next(int i, pg8::Unit& o) const { if (i > 0) return false; o = u; return true; } };

__device__ __forceinline__ int queue_next(Frame& F, int cw) {
    LAS unsigned* mw = (LAS unsigned*)(F.lds + LDS_MISC);
    __syncthreads();
    if (F.tid == 0) mw[0] = __hip_atomic_fetch_add(F.ctl + cw, 1u, __ATOMIC_RELAXED, __HIP_MEMORY_SCOPE_AGENT);
    __syncthreads();
    return (int)mw[0];
}
__device__ __forceinline__ void ln_vals(f32x4 (&v)[4], const float* g, const float* b, int lane) {
    float s = 0.f;
#pragma unroll
    for (int j = 0; j < 4; ++j) s += (v[j][0] + v[j][1]) + (v[j][2] + v[j][3]);
    const float mean = wave_sum(s) * (1.f / 1024.f); float s2 = 0.f;
#pragma unroll
    for (int j = 0; j < 4; ++j) { v[j] = v[j] - mean; s2 += (v[j][0] * v[j][0] + v[j][1] * v[j][1]) + (v[j][2] * v[j][2] + v[j][3] * v[j][3]); }
    const float rstd = 1.0f / sqrtf(wave_sum(s2) * (1.f / 1024.f) + 1e-5f);
#pragma unroll
    for (int j = 0; j < 4; ++j) { const f32x4 gg = ((const f32x4*)g)[lane + 64 * j], bb = ((const f32x4*)b)[lane + 64 * j]; v[j] = v[j] * rstd * gg + bb; }
}

constexpr int N_PHASES_ = 15;
__device__ __forceinline__ void ln2_row(Frame& F, int m, f32x4 (&y)[4]) {
    float mean, rstd; row_stats((const float*)(F.ws + WS_STAT2), (size_t)m, mean, rstd);
    const u32x2* xr = (const u32x2*)((const bf16_t*)(F.ws + WS_RA) + (size_t)m * 1024) + F.lane; const f32x4* g = (const f32x4*)F.in[I_LN2G] + F.lane; const f32x4* b = (const f32x4*)F.in[I_LN2B] + F.lane;
#pragma unroll
    for (int j = 0; j < 4; ++j) { const u32x2 w = xr[64 * j]; y[j] = ((f32x4){bflo(w.x), bfhi(w.x), bflo(w.y), bfhi(w.y)} - mean) * rstd * g[64 * j] + b[64 * j]; }
}
__global__ void __launch_bounds__(NTHR, 2) mk_fwd(Args args) {
    extern __shared__ __attribute__((aligned(16))) unsigned char lds_raw[];
    cg::grid_group grid = cg::this_grid();
    Frame F;
    F.lds = (LAS unsigned char*)lds_raw; F.ws = args.ws; F.ctl = (unsigned*)(args.ws + WS_CTL); F.in = args.in; F.out = args.out;
    F.tid = threadIdx.x; F.lane = F.tid & 63; F.wave = __builtin_amdgcn_readfirstlane(F.tid >> 6); F.G = gridDim.x; F.bid = blockIdx.x;
    unsigned char* ws = args.ws;
    const int lo = args.ph_lo, hi = args.ph_hi;
    if (lo == -12345) grid.sync();
    if (F.tid < 4) ((LAS unsigned*)(F.lds + LDS_MISC))[16 + F.tid] = 0u;
    __syncthreads();
    const XcdBarrier xbar = xcd_barrier_post(F.ctl + CW_BAR + args.li * XCD_BAR_WORDS, (volatile LAS unsigned*)(F.lds + LDS_MISC) + 16);
    const int gw = F.bid * NWAVES + F.wave, NGW = F.G * NWAVES;
#ifndef PH_MASK
#define PH_MASK 0x7fff
#endif
#define IN(k) (((PH_MASK >> (k)) & 1) && lo <= (k) && (k) < hi)
#define SEAM(k) do { if (IN(k) && (IN((k) + 1) || ((k) == 5 && IN(7)) || ((k) == 7 && IN(9)))) xcd_barrier(xbar); } while (0)

    if (IN(0)) { p0_prep(F); } SEAM(0);
    if (IN(1)) {
        pg8::GridOrder S{(const char*)(ws + WS_RA), (const char*)(ws + WS_WIN), (size_t)256 * 1024 * 2, (size_t)256 * 1024 * 2, 128, 14, 128 * 14, F.G, F.bid};
        EpiInproj E{ws, (const float*)(ws + WS_LB), (args.rep & 0x200) ? 1 : 0};
        pg8::gemm_phase(F.lds, 1024, 1024, 1024, S, E);
    } SEAM(1);
    if (IN(2)) {
        for (int u = F.bid; u < ((args.rep & 0x4000) ? 0 : 48); u += F.G) {
            if (u < 32) { const int kv = u >> 4, pm = u & 15; OneUnit S; S.u.a = (const char*)(ws + (kv ? WS_VCIN : WS_KCIN)) + (size_t)pm * 256 * 1024 * 2; S.u.b = (const char*)(ws + (kv ? WS_W1V : WS_W1K)); S.u.pm = pm; S.u.pn = 0; S.u.aux = kv;
                EpiCmp1 E{ws}; pg8::gemm_phase(F.lds, 2048, 1024, 2048, S, E); }
            else { const int idx = u - 32, pm = idx >> 3, pn = idx & 7; OneUnit S; S.u.a = (const char*)(ws + WS_MEMB) + (size_t)pm * 256 * 1024 * 2; S.u.b = (const char*)(ws + WS_WK) + (size_t)pn * 256 * 1024 * 2; S.u.pm = pm; S.u.pn = pn; S.u.aux = 0;
                EpiMemKV E{ws}; pg8::gemm_phase(F.lds, 1024, 1024, 1024, S, E); }
        }
        { const int cw = CW_Q2 + 2 * (args.rep & 3); hgrn_a_loop(F, [&]() { const int u = queue_next(F, cw); return u < 2048 ? u : -1; }); }
    } SEAM(2);
    if (IN(3)) {
        for (int u = F.bid; u < 32; u += F.G) cmp2_unit(F, u >> 4, u & 15);
        hgrn_b(F);
    } SEAM(3);
    if (IN(4)) {
        if ((args.rep & 3) != 3) { const int bg0 = (int)(xb_xcc_id() & 3u);
            for (int kq = 0; kq < 4; ++kq) { const int bg = (bg0 + kq) & 3;
                for (;;) { const int tk = queue_next(F, CW_Q4 + 16 * (args.rep & 3) + bg); if (tk >= 256) break; const int c = 255 - tk; NSA_CALL } } }
        if (!(args.rep & 0x10) && (args.rep & 3) != 2) { const int cw = CW_Q4B + 16 * (args.rep & 3); hgrn_c_loop(F, [&]() { const int u = queue_next(F, cw); return u < 2048 ? u : -1; }); }
    } SEAM(4);
    if (IN(5)) {
        pg8::GridOrder S{(const char*)(ws + WS_RB), (const char*)(ws + WS_WOUT), (size_t)256 * 1024 * 2, (size_t)256 * 1024 * 2, 128, 4, 512, F.G, F.bid};
        EpiRes<0> E{F.in[I_X], nullptr, (bf16_t*)(ws + WS_RA), (float*)(ws + WS_STAT1), nullptr, nullptr, nullptr};
        pg8::gemm_phase(F.lds, 1024, 1024, 1024, S, E);
    } SEAM(5);
    if (IN(7)) {
        pg8::GridOrder S{(const char*)(ws + WS_RA), (const char*)(ws + WS_WQ), (size_t)256 * 1024 * 2, (size_t)256 * 1024 * 2, 128, 4, 512, F.G, F.bid};
        EpiQLn E{(bf16_t*)(ws + WS_RB), (const float*)(ws + WS_STAT1), (const float*)(ws + WS_QCS), (const float*)(ws + WS_QBQ), (args.rep & 0x200) ? 1 : 0};
        pg8::gemm_phase(F.lds, 1024, 1024, 1024, S, E);
        asm volatile("s_waitcnt vmcnt(0)" ::: "memory"); __syncthreads();
        { int a0 = 0, a1 = 0, a2 = 0, a3 = 0, nun = 0; pg8::Unit u0, u1;
          if (S.next(0, u0)) { const int b = u0.pm >> 6, t0 = (u0.pm & 63) * 2; a0 = (b * 4 + u0.pn) * 128 + t0; a1 = a0 + 1; nun = 2;
              if (S.next(1, u1)) { const int b1 = u1.pm >> 6, t1 = (u1.pm & 63) * 2; a2 = (b1 * 4 + u1.pn) * 128 + t1; a3 = a2 + 1; nun = 4; } }
          xattn_phase(F, a0, a1, a2, a3, nun); }
    } SEAM(8);
    if (IN(9)) {
        pg8::GridOrder S{(const char*)(ws + WS_RB), (const char*)(ws + WS_WO), (size_t)256 * 1024 * 2, (size_t)256 * 1024 * 2, 128, 4, 512, F.G, F.bid};
        EpiRes<1> E{nullptr, (const bf16_t*)(ws + WS_RA), (bf16_t*)(ws + WS_RA), (float*)(ws + WS_STAT2), (const float*)(ws + WS_STAT1), F.in[I_LN1G], F.in[I_LN1B]};
        pg8::gemm_phase(F.lds, 1024, 1024, 1024, S, E);
    } SEAM(9);
    if (IN(10)) {
        LAS unsigned* rl = (LAS unsigned*)(F.lds + LDS_MISC + 1024);
        LAS unsigned* lcnt = rl + 4 * 192; LAS unsigned* lbase = lcnt + 32;
        if (F.tid < 32) lcnt[F.tid] = 0u;
        __syncthreads();
        const bool skip = (args.rep & 0x800) != 0;
        router_phase(F, rl, lcnt, skip);
        __syncthreads();
        if (F.tid < 32) lbase[F.tid] = __hip_atomic_fetch_add(F.ctl + CW_ECNT + 32 * (32 * (args.rep & 1) + F.tid), lcnt[F.tid], __ATOMIC_RELAXED, __HIP_MEMORY_SCOPE_AGENT);
        __syncthreads();
        { int kslot = 0;
          for (int tg = gw; tg < (skip ? 0 : NTOK / 16); tg += NGW, ++kslot) if (F.lane < 16) { const LAS unsigned* r = rl + 4 * (F.wave * 24 + kslot * 16 + F.lane);
              *(u32x4*)(ws + WS_ROUTE + (size_t)(tg * 16 + F.lane) * 16) = (u32x4){r[0], r[1], lbase[r[0]] + r[2], lbase[r[1]] + r[3]}; } }
        __syncthreads();
    } SEAM(10);
    if (IN(11)) {
        moe_offsets(F);
        const LAS unsigned* off = (const LAS unsigned*)(F.lds + MOE_LDS);
        const f32x4* g2 = (const f32x4*)F.in[I_LN2G] + F.lane; const f32x4* b2p = (const f32x4*)F.in[I_LN2B] + F.lane;
        f32x4 gq[4], bq4[4];
#pragma unroll
        for (int j = 0; j < 4; ++j) { gq[j] = g2[64 * j]; bq4[j] = b2p[64 * j]; }
        for (int m0 = gw; m0 < NTOK; m0 += 4 * NGW) {
            u32x4 r[4]; f32x2 wv[4], st[4]; u32x2 xw[4][4];
#pragma unroll
            for (int q = 0; q < 4; ++q) { const int m = m0 + q * NGW; if (m < NTOK) { r[q] = *(const u32x4*)(ws + WS_ROUTE + (size_t)m * 16); wv[q] = *(const f32x2*)(ws + WS_ROUTEW + (size_t)m * 8);
                st[q] = *(const f32x2*)((const float*)(ws + WS_STAT2) + (size_t)m * 2); const u32x2* xr = (const u32x2*)((const bf16_t*)(ws + WS_RA) + (size_t)m * 1024) + F.lane;
#pragma unroll
                for (int j = 0; j < 4; ++j) xw[q][j] = xr[64 * j]; } }
#pragma unroll
            for (int q = 0; q < 4; ++q) { const int m = m0 + q * NGW; if (m < NTOK) {
                const unsigned s0 = off[r[q].x] + r[q].z, s1 = off[r[q].y] + r[q].w;
                const float mean = st[q][0] * (1.f / 1024.f), rstd = 1.0f / sqrtf(fmaxf(st[q][1] * (1.f / 1024.f) - mean * mean, 0.f) + 1e-5f);
                u32x2* d0 = (u32x2*)((bf16_t*)(ws + WS_XG) + (size_t)s0 * 1024); u32x2* d1 = (u32x2*)((bf16_t*)(ws + WS_XG) + (size_t)s1 * 1024);
#pragma unroll
                for (int j = 0; j < 4; ++j) { const u32x2 w = xw[q][j]; const f32x4 y = ((f32x4){bflo(w.x), bfhi(w.x), bflo(w.y), bfhi(w.y)} - mean) * rstd * gq[j] + bq4[j];
                    u32x2 o; o.x = cvtpk(y[0], y[1]); o.y = cvtpk(y[2], y[3]); d0[F.lane + 64 * j] = o; d1[F.lane + 64 * j] = o; }
                if (F.lane == 0) { *(u32x2*)(ws + WS_TOKSLOT + (size_t)m * 8) = (u32x2){s0, s1}; ((float*)(ws + WS_SLOTW))[s0] = wv[q][0]; ((float*)(ws + WS_SLOTW))[s1] = wv[q][1]; } } }
        }
    } SEAM(11);
    if (IN(12)) {
        moe_offsets(F);
        MoeOrder S{(const char*)(ws + WS_XG), (const char*)(ws + WS_WGU), (size_t)256 * 1024 * 2, (size_t)1024 * 1024 * 2, (size_t)256 * 1024 * 2, (const LAS unsigned*)(F.lds + MOE_LDS), F.G, F.bid};
        EpiGateUp E{(bf16_t*)(ws + WS_HIDM)};
        pg8::gemm_phase(F.lds, 1024, 1024, 1024, S, E);
    } SEAM(12);
    if (IN(13)) {
        moe_offsets(F);
        MoeOrder S{(const char*)(ws + WS_HIDM), (const char*)(ws + WS_WD), (size_t)256 * 512 * 2, (size_t)1024 * 512 * 2, (size_t)256 * 512 * 2, (const LAS unsigned*)(F.lds + MOE_LDS), F.G, F.bid};
        EpiDown E{(bf16_t*)(ws + WS_XG), (const float*)(ws + WS_SLOTW)};
        pg8::gemm_phase(F.lds, 512, 512, 512, S, E);
    } SEAM(13);
    if (IN(14)) {
        const f32x4* g2 = (const f32x4*)F.in[I_LN2G] + F.lane; const f32x4* b2p = (const f32x4*)F.in[I_LN2B] + F.lane;
        const f32x4* g3 = (const f32x4*)F.in[I_LN3G] + F.lane; const f32x4* b3p = (const f32x4*)F.in[I_LN3B] + F.lane;
        for (int m0 = gw; m0 < NTOK; m0 += 2 * NGW) {
            u32x2 xw[2][4], ya[2][4], yb[2][4]; f32x2 st[2];
#pragma unroll
            for (int q = 0; q < 2; ++q) { const int m = m0 + q * NGW; if (m < NTOK) { const u32x2 sl = *(const u32x2*)(ws + WS_TOKSLOT + (size_t)m * 8);
                st[q] = *(const f32x2*)((const float*)(ws + WS_STAT2) + (size_t)m * 2); const u32x2* xr = (const u32x2*)((const bf16_t*)(ws + WS_RA) + (size_t)m * 1024) + F.lane;
                const u32x2* y0 = (const u32x2*)((const bf16_t*)(ws + WS_XG) + (size_t)sl.x * 1024) + F.lane; const u32x2* y1 = (const u32x2*)((const bf16_t*)(ws + WS_XG) + (size_t)sl.y * 1024) + F.lane;
#pragma unroll
                for (int j = 0; j < 4; ++j) { xw[q][j] = xr[64 * j]; ya[q][j] = y0[64 * j]; yb[q][j] = y1[64 * j]; } } }
            f32x4 v[2][4];
#pragma unroll
            for (int q = 0; q < 2; ++q) { const float mean = st[q][0] * (1.f / 1024.f), rstd = 1.0f / sqrtf(fmaxf(st[q][1] * (1.f / 1024.f) - mean * mean, 0.f) + 1e-5f);
#pragma unroll
                for (int j = 0; j < 4; ++j) { const u32x2 w = xw[q][j], a = ya[q][j], b2 = yb[q][j]; const f32x4 x = ((f32x4){bflo(w.x), bfhi(w.x), bflo(w.y), bfhi(w.y)} - mean) * rstd * g2[64 * j] + b2p[64 * j];
                    v[q][j] = x * ALPHA + (f32x4){bflo(a.x) + bflo(b2.x), bfhi(a.x) + bfhi(b2.x), bflo(a.y) + bflo(b2.y), bfhi(a.y) + bfhi(b2.y)}; } }
            float s[2], s2[2], mean3[2], rstd3[2];
#pragma unroll
            for (int q = 0; q < 2; ++q) { s[q] = 0.f;
#pragma unroll
                for (int j = 0; j < 4; ++j) s[q] += (v[q][j][0] + v[q][j][1]) + (v[q][j][2] + v[q][j][3]); }
#pragma unroll
            for (int o = 1; o < 64; o <<= 1) { s[0] += __shfl_xor(s[0], o); s[1] += __shfl_xor(s[1], o); }
#pragma unroll
            for (int q = 0; q < 2; ++q) { mean3[q] = s[q] * (1.f / 1024.f); s2[q] = 0.f;
#pragma unroll
                for (int j = 0; j < 4; ++j) { v[q][j] = v[q][j] - mean3[q]; s2[q] += (v[q][j][0] * v[q][j][0] + v[q][j][1] * v[q][j][1]) + (v[q][j][2] * v[q][j][2] + v[q][j][3] * v[q][j][3]); } }
#pragma unroll
            for (int o = 1; o < 64; o <<= 1) { s2[0] += __shfl_xor(s2[0], o); s2[1] += __shfl_xor(s2[1], o); }
#pragma unroll
            for (int q = 0; q < 2; ++q) { const int m = m0 + q * NGW; rstd3[q] = 1.0f / sqrtf(s2[q] * (1.f / 1024.f) + 1e-5f);
                if (m < NTOK) {
#pragma unroll
                    for (int j = 0; j < 4; ++j) ((f32x4*)(F.out + (size_t)m * 1024))[F.lane + 64 * j] = v[q][j] * rstd3[q] * g3[64 * j] + b3p[64 * j]; } }
        }
    }
#ifdef PROBE_SYNCS
    if (hi == N_PHASES_) { for (int i = 0; i < PROBE_SYNCS; ++i) xcd_barrier(xbar); }
#endif
#undef IN
#undef SEAM
}

#ifndef MK_N_LAUNCHES
#define MK_N_LAUNCHES 1
#endif
constexpr int N_PHASES = 15;
extern "C" void kernel_launch(void* const* d_in, const int* in_sizes, int n_in, void* d_out, int out_size, void* d_ws, size_t ws_size, hipStream_t stream) {
    static int grid = 0;
    if (grid == 0) {
        if (n_in != 30 || ws_size < WS_TOTAL) { fprintf(stderr, "kernel_launch: unexpected n_in %d / ws %zu\n", n_in, ws_size); grid = -1; return; }
        int dev = 0, cus = 0, per_cu = 0;
        (void)hipGetDevice(&dev); (void)hipDeviceGetAttribute(&cus, hipDeviceAttributeMultiprocessorCount, dev);
        (void)hipFuncSetAttribute((const void*)mk_fwd, hipFuncAttributeMaxDynamicSharedMemorySize, LDS_BYTES);
        (void)hipOccupancyMaxActiveBlocksPerMultiprocessor(&per_cu, (const void*)mk_fwd, NTHR, LDS_BYTES);
        if (per_cu < 1) { fprintf(stderr, "kernel_launch: occupancy query says %d blocks per CU\n", per_cu); per_cu = 1; }
        grid = cus * per_cu;
    }
    if (grid < 0) return;
    (void)hipMemsetAsync((char*)d_ws + WS_CTL, 0, 128 * 1024, stream);
    Args a{};
    for (int i = 0; i < 30; ++i) a.in[i] = (const float*)d_in[i];
    a.out = (float*)d_out; a.ws = (unsigned char*)d_ws;
#ifdef PROBE_PHASE
#ifndef PROBE_LO
#define PROBE_LO PROBE_PHASE
#endif
#ifndef PROBE_REP
#define PROBE_REP 1
#endif
    const int seq[3][3] = {{0, PROBE_PHASE + 1, 0}, {PROBE_LO, PROBE_PHASE + 1, PROBE_REP}, {PROBE_PHASE + 1, N_PHASES, 0}};
    const int nl = (PROBE_PHASE + 1 < N_PHASES) ? 3 : 2;
#else
    const int seq[1][3] = {{0, N_PHASES, 0}};
    const int nl = 1;
#endif
    for (int li = 0; li < nl; ++li) {
        a.ph_lo = seq[li][0]; a.ph_hi = seq[li][1]; a.rep = seq[li][2]; a.li = li;
        void* kargs[] = {&a};
        hipError_t e = hipLaunchCooperativeKernel((const void*)mk_fwd, dim3(grid), dim3(NTHR), kargs, LDS_BYTES, stream);
        if (e != hipSuccess) { fprintf(stderr, "kernel_launch: cooperative launch failed: %s (grid %d)\n", hipGetErrorString(e), grid); break; }
    }
}
```

```cpp
#include <hip/hip_runtime.h>
#include <hip/hip_cooperative_groups.h>
#include <cstdio>
#include <cstdint>
namespace cg = cooperative_groups;

#define LAS __attribute__((address_space(3)))
typedef unsigned short bf16_t;
typedef short bf16x8 __attribute__((ext_vector_type(8)));
typedef short s16x4 __attribute__((ext_vector_type(4)));
typedef float f32x2 __attribute__((ext_vector_type(2)));
typedef float f32x4 __attribute__((ext_vector_type(4)));
typedef float f32x16 __attribute__((ext_vector_type(16)));
typedef unsigned u32x2 __attribute__((ext_vector_type(2)));
typedef unsigned u32x4 __attribute__((ext_vector_type(4)));
typedef __bf16 bf16x2_t __attribute__((ext_vector_type(2)));

constexpr int NB = 2, SEQ = 16384, NTOK = NB * SEQ, DM = 1024;
constexpr int NIN = 3584;
constexpr int NSELB = SEQ / 64;
constexpr int MOE_E = 32, MOE_FF = 512, MOE_CAP = 73728;
constexpr float ALPHA = 1.189207115002721f;
constexpr float QSCALE = 0.125f * 1.4426950408889634f;
constexpr float XSCALE = 0.0625f * 1.4426950408889634f;

constexpr size_t MiB = 1u << 20;
constexpr size_t WS_CTL = 0;
constexpr size_t WS_WIN = 1 * MiB;
constexpr size_t WS_WOUT = 8 * MiB, WS_WQ = 10 * MiB, WS_WK = 12 * MiB, WS_WV = 14 * MiB, WS_WO = 16 * MiB;
constexpr size_t WS_W1K = 18 * MiB, WS_W1V = 19 * MiB;
constexpr size_t WS_SMALL = 20 * MiB;
constexpr size_t WS_W2K = WS_SMALL, WS_W2V = WS_SMALL + 32768;
constexpr size_t WS_BIASK = WS_SMALL + 65536, WS_BIASV = WS_BIASK + 1024;
constexpr size_t WS_LB = WS_BIASV + 1024;
constexpr size_t WS_WRH = WS_SMALL + 512 * 1024, WS_WRL = WS_WRH + 128 * 1024;
constexpr size_t WS_RCS = WS_SMALL + 800 * 1024, WS_RCB = WS_RCS + 1024;
constexpr size_t WS_QCS = WS_SMALL + 256 * 1024, WS_QBQ = WS_QCS + 4096;
constexpr size_t WS_MEMB = 21 * MiB;
constexpr size_t WS_MEMK = 22 * MiB, WS_MEMV = 23 * MiB;
constexpr size_t WS_RA = 24 * MiB;
constexpr size_t WS_RB = 88 * MiB;
constexpr size_t WS_RC = 152 * MiB;
constexpr size_t WS_RD = 296 * MiB;
constexpr size_t WS_RE = 400 * MiB;
constexpr size_t WS_QN = WS_RC;
constexpr size_t WS_KS = WS_RC + 32 * MiB, WS_VS = WS_KS + 8 * MiB, WS_KW = WS_VS + 8 * MiB, WS_VW = WS_KW + 8 * MiB;
constexpr size_t WS_HQ = WS_RC + 64 * MiB;
constexpr size_t WS_HI = WS_RC + 96 * MiB;
constexpr size_t WS_KCIN = WS_RC + 128 * MiB, WS_VCIN = WS_RC + 136 * MiB;
constexpr size_t WS_PRE = WS_RC;
constexpr size_t WS_XG = WS_RC;
constexpr size_t WS_LOGF = WS_RD;
constexpr size_t WS_HGS = WS_RD + 64 * MiB;
constexpr size_t WS_GATE = WS_RD + 96 * MiB;
constexpr size_t WS_HID = WS_RD + 99 * MiB;
constexpr size_t WS_KC = WS_RD + 103 * MiB, WS_VC = WS_KC + 512 * 1024;
constexpr size_t WS_HIDM = WS_RD;
constexpr size_t WS_WGU = WS_RE;
constexpr size_t WS_WD = WS_RE + 64 * MiB;
constexpr int CW_Q2 = 64, CW_Q4 = 128, CW_Q4B = 192;
constexpr int CW_ECNT = 20480;
constexpr int CW_BAR = 8192;
constexpr int CW_DONE_A = 4096, CW_DONE_C = 4128, CW_DONE_B = 4160;
constexpr int CW_TILECNT = 1024;
constexpr size_t WS_HD = 496 * MiB;
constexpr size_t WS_ROUTE = 497 * MiB;
constexpr size_t WS_ROUTEW = WS_ROUTE + 512 * 1024;
constexpr size_t WS_TOKSLOT = WS_ROUTEW + 256 * 1024;
constexpr size_t WS_SLOTW = 498 * MiB;
constexpr size_t WS_STAT1 = 499 * MiB, WS_STAT2 = WS_STAT1 + MiB;
constexpr size_t WS_TOTAL = 507 * MiB;

__device__ __forceinline__ unsigned cvtpk(float lo, float hi) { f32x2 v = {lo, hi}; bf16x2_t b = __builtin_convertvector(v, bf16x2_t); return __builtin_bit_cast(unsigned, b); }
__device__ __forceinline__ float bf2f(unsigned short h) { return __uint_as_float((unsigned)h << 16); }
__device__ __forceinline__ float bflo(unsigned w) { return __uint_as_float(w << 16); }
__device__ __forceinline__ float bfhi(unsigned w) { return __uint_as_float(w & 0xffff0000u); }
__device__ __forceinline__ unsigned short f2bf(float f) { return (unsigned short)(cvtpk(f, 0.f) & 0xffffu); }
#define DPPADDW_(v, ctrl, rm) v += __int_as_float(__builtin_amdgcn_update_dpp(0, __float_as_int(v), ctrl, rm, 0xF, true))
__device__ __forceinline__ float wave_sum(float v) {
    DPPADDW_(v, 0x111, 0xF); DPPADDW_(v, 0x112, 0xF); DPPADDW_(v, 0x114, 0xF); DPPADDW_(v, 0x118, 0xF); DPPADDW_(v, 0x142, 0xA); DPPADDW_(v, 0x143, 0xC);
    return __int_as_float(__builtin_amdgcn_readlane(__float_as_int(v), 63));
}
__device__ __forceinline__ float fast_exp2(float x) { return __builtin_amdgcn_exp2f(x); }
__device__ __forceinline__ float sigmoidf_(float z) { return __builtin_amdgcn_rcpf(1.0f + __expf(-z)); }
namespace pg8 {
constexpr int BM = 256, BK = 64, HALF = 128, HTB = HALF * BK * 2, STAGE_BYTES = 8 * HTB;
__device__ __forceinline__ int lds_byte(int r, int c) { const int st = (r >> 4) * 2 + (c >> 5), rr = r & 15, cc = c & 31, ob = rr * 64 + cc * 2; return st * 1024 + (ob ^ (((ob >> 9) & 1) << 5)); }
__device__ __forceinline__ void stage_rc(int b, int& R, int& C) { const int st = b / 1024, sb = b % 1024, swz = sb ^ (((sb >> 9) & 1) << 5); R = (st >> 1) * 16 + swz / 64; C = (st & 1) * 32 + (swz % 64) / 2; }
__device__ __forceinline__ int perm32(int rho) { const int n = rho >> 4, i = rho & 15; return 8 * (i >> 2) + 4 * n + (i & 3); }

struct Unit { const char* a; const char* b; int pm, pn, aux; };

template <class Epi, class Sched>
__device__ __forceinline__ void gemm_phase(LAS unsigned char* lds, const int K, const int lda, const int ldb, const Sched& S, const Epi& E) {
    const int tid = threadIdx.x, wid = __builtin_amdgcn_readfirstlane(tid >> 6), lane = tid & 63, wr = wid >> 2, wc = wid & 3, fr = lane & 15, fq = lane >> 4;
    const int nt = K / BK;
    unsigned voffA[2], voffB[2];
#pragma unroll
    for (int i = 0; i < 2; ++i) { int R, C; stage_rc(tid * 16 + i * 8192, R, C); const int Rb = Epi::PERM ? ((R & ~31) + perm32(R & 31)) : R;
        voffA[i] = (unsigned)(R * lda + C) * 2u; voffB[i] = (unsigned)(Rb * ldb + C) * 2u; }
    const size_t kstep = (size_t)(BK * 2);
    const size_t hstepA = (size_t)HALF * lda * 2, hstepB = (size_t)HALF * ldb * 2;
    const unsigned ldsw = (unsigned)wid * 1024u;
    const int aoff = lds_byte(wr * 64 + fr, fq * 8), boff = lds_byte(wc * 32 + fr, fq * 8);
#define PG8_SA(b, h) (((b) * 2 + (h)) * HTB)
#define PG8_SB(b, h) ((4 + (b) * 2 + (h)) * HTB)
#define PG8_STAGE(bufoff, gbase, voff) do { _Pragma("unroll") for (int _i = 0; _i < 2; ++_i) \
        __builtin_amdgcn_global_load_lds((const unsigned*)((const char*)(gbase) + (voff)[_i]), (LAS unsigned*)(lds + (bufoff) + ldsw + _i * 8192), 16, 0, 0); } while (0)
#define PG8_LDA(dst, b, h) do { _Pragma("unroll") for (int m = 0; m < 4; ++m) _Pragma("unroll") for (int k = 0; k < 2; ++k) dst[m][k] = *(const LAS bf16x8*)(lds + PG8_SA(b, h) + aoff + m * 2048 + k * 1024); } while (0)
#define PG8_LDB(dst, b, h) do { _Pragma("unroll") for (int n = 0; n < 2; ++n) _Pragma("unroll") for (int k = 0; k < 2; ++k) dst[n][k] = *(const LAS bf16x8*)(lds + PG8_SB(b, h) + boff + n * 2048 + k * 1024); } while (0)
#define PG8_MMA(ai, bj, At, Bt) do { __builtin_amdgcn_s_setprio(1); _Pragma("unroll") for (int m = 0; m < 4; ++m) _Pragma("unroll") for (int n = 0; n < 2; ++n) _Pragma("unroll") for (int k = 0; k < 2; ++k) \
        acc[ai][bj][m][n] = __builtin_amdgcn_mfma_f32_16x16x32_bf16(Bt[n][k], At[m][k], acc[ai][bj][m][n], 0, 0, 0); __builtin_amdgcn_s_setprio(0); } while (0)
#define PG8_WAIT_V(n) asm volatile("s_waitcnt vmcnt(" #n ")" ::: "memory")
#define PG8_WAIT_L(n) asm volatile("s_waitcnt lgkmcnt(" #n ")" ::: "memory")
#define PG8_BAR __builtin_amdgcn_s_barrier()
#define PG8_SCHED __builtin_amdgcn_sched_barrier(0)
    Unit cur, nxt; int ui = 0;
    if (!S.next(0, cur)) return;
    f32x4 acc[2][2][4][2];
#pragma unroll
    for (int a = 0; a < 2; ++a)
#pragma unroll
        for (int b = 0; b < 2; ++b)
#pragma unroll
            for (int m = 0; m < 4; ++m)
#pragma unroll
                for (int n = 0; n < 2; ++n) acc[a][b][m][n] = (f32x4){0.f, 0.f, 0.f, 0.f};
    bf16x8 At[4][2], B0[2][2], B1[2][2];
    const char* cA = cur.a; const char* cB = cur.b;
    PG8_STAGE(PG8_SB(0, 0), cB, voffB); PG8_STAGE(PG8_SB(0, 1), cB + hstepB, voffB); PG8_STAGE(PG8_SA(0, 0), cA, voffA); PG8_STAGE(PG8_SA(0, 1), cA + hstepA, voffA);
    if (wr == 1) PG8_BAR;
    PG8_WAIT_V(2); PG8_BAR;
    PG8_STAGE(PG8_SB(1, 0), cB + kstep, voffB); PG8_STAGE(PG8_SA(1, 0), cA + kstep, voffA); PG8_STAGE(PG8_SB(1, 1), cB + hstepB + kstep, voffB);
    PG8_WAIT_V(6); PG8_BAR;
    for (;;) {
        const bool has_next = S.next(ui + 1, nxt);
        const char* nA = has_next ? nxt.a : cA; const char* nB = has_next ? nxt.b : cB;
        for (int t = 0; t < nt; t += 2) {
            const bool last = (t == nt - 2);
            const char* a1 = cA + (size_t)(t + 1) * kstep;
            const char* a2 = last ? nA : cA + (size_t)(t + 2) * kstep; const char* b2 = last ? nB : cB + (size_t)(t + 2) * kstep;
            const char* a3 = a2 + kstep; const char* b3 = b2 + kstep;
            PG8_LDB(B0, 0, 0); PG8_LDB(B1, 0, 1); PG8_SCHED; PG8_LDA(At, 0, 0); PG8_STAGE(PG8_SA(1, 1), a1 + hstepA, voffA);
            PG8_WAIT_V(8); PG8_WAIT_L(0); PG8_BAR; PG8_MMA(0, 0, At, B0); PG8_MMA(0, 1, At, B1); PG8_BAR; PG8_SCHED;
            PG8_LDA(At, 0, 1); PG8_STAGE(PG8_SB(0, 0), b2, voffB); PG8_STAGE(PG8_SB(0, 1), b2 + hstepB, voffB); PG8_STAGE(PG8_SA(0, 0), a2, voffA);
            PG8_WAIT_V(8); PG8_WAIT_L(0); PG8_BAR; PG8_MMA(1, 0, At, B0); PG8_MMA(1, 1, At, B1); PG8_BAR; PG8_SCHED;
            PG8_LDB(B0, 1, 0); PG8_LDB(B1, 1, 1); PG8_SCHED; PG8_LDA(At, 1, 0); PG8_STAGE(PG8_SA(0, 1), a2 + hstepA, voffA);
            PG8_WAIT_V(8); PG8_WAIT_L(0); PG8_BAR; PG8_MMA(0, 0, At, B0); PG8_MMA(0, 1, At, B1); PG8_BAR; PG8_SCHED;
            PG8_LDA(At, 1, 1); PG8_STAGE(PG8_SB(1, 0), b3, voffB); PG8_STAGE(PG8_SB(1, 1), b3 + hstepB, voffB); PG8_STAGE(PG8_SA(1, 0), a3, voffA);
            PG8_WAIT_V(8); PG8_WAIT_L(0); PG8_BAR; PG8_MMA(1, 0, At, B0); PG8_MMA(1, 1, At, B1); PG8_BAR; PG8_SCHED;
        }
        if (wr == 0) PG8_BAR;
        E(acc, cur, wr, wc, fr, fq);
        if (!has_next) break;
#pragma unroll
        for (int a = 0; a < 2; ++a)
#pragma unroll
            for (int b = 0; b < 2; ++b)
#pragma unroll
                for (int m = 0; m < 4; ++m)
#pragma unroll
                    for (int n = 0; n < 2; ++n) acc[a][b][m][n] = (f32x4){0.f, 0.f, 0.f, 0.f};
        cur = nxt; cA = nA; cB = nB; ++ui;
        if (wr == 1) PG8_BAR;
    }
    PG8_WAIT_V(0);
    PG8_BAR;
#undef PG8_SA
#undef PG8_SB
#undef PG8_STAGE
#undef PG8_LDA
#undef PG8_LDB
#undef PG8_MMA
#undef PG8_WAIT_V
#undef PG8_WAIT_L
#undef PG8_BAR
#undef PG8_SCHED
}

struct GridOrder {
    const char* A; const char* Bt; size_t atile, btile; int nM, nN, nwg, G, c;
    __device__ __forceinline__ bool next(int i, Unit& u) const {
        const long L = (long)i * G + c; if (L >= nwg) return false;
        int wgid = (int)L; { const int q = nwg / 8, r = nwg % 8, xcd = wgid % 8, off = wgid / 8; wgid = (xcd < r ? xcd * (q + 1) : r * (q + 1) + (xcd - r) * q) + off; }
        const int nig = 8 * nN, gid = wgid / nig, fm = gid * 8, gsz = (nM - fm) < 8 ? (nM - fm) : 8;
        u.pm = fm + ((wgid % nig) % gsz); u.pn = (wgid % nig) / gsz; u.aux = 0;
        u.a = A + (size_t)u.pm * atile; u.b = Bt + (size_t)u.pn * btile; return true;
    }
};
}
__device__ __forceinline__ float gelu_tanh(float x) {
    const float u = 0.7978845608028654f * (x + 0.044715f * x * x * x);
    const float e = __expf(2.0f * u);
    const float th = 1.0f - 2.0f * __builtin_amdgcn_rcpf(1.0f + e);
    return 0.5f * x * (1.0f + th);
}
__device__ __forceinline__ float silu_(float z) { return z * __builtin_amdgcn_rcpf(1.0f + __expf(-z)); }
#ifdef NO_NT_STORES
#define NTST(P, V) (*(P) = (V))
#else
#define NTST(P, V) __builtin_nontemporal_store((V), (P))
#endif
__device__ __forceinline__ u32x4 pack8(const f32x4 a, const f32x4 b) { u32x4 w; w.x = cvtpk(a[0], a[1]); w.y = cvtpk(a[2], a[3]); w.z = cvtpk(b[0], b[1]); w.w = cvtpk(b[2], b[3]); return w; }

__device__ __forceinline__ int kimg_off(int key, int dim) { return (dim >> 3) * 1024 + key * 16; }
__device__ __forceinline__ int vimg_off(int key, int dim) { return (dim >> 5) * 4096 + ((key >> 4) & 3) * 1024 + ((key >> 3) & 1) * 512 + (key & 7) * 64 + (dim & 31) * 2; }

__device__ __forceinline__ int kf_off(int key, int dim) { return ((((key >> 4) * 2 + (dim >> 5)) * 64 + (key & 15) + 16 * ((dim >> 3) & 3)) * 16) + (dim & 7) * 2; }
__device__ __forceinline__ int vf_off(int key, int dim) { return ((((dim >> 4) * 2 + (key >> 5)) * 64 + (dim & 15) + 16 * ((key >> 2) & 3)) * 16) + (((key >> 4) & 1) * 4 + (key & 3)) * 2; }
__device__ __forceinline__ void vf_store8(unsigned char* img, int key, int dim, const u32x4 w) {
    unsigned char* p = img + vf_off(key, dim);
    *(bf16_t*)(p) = (bf16_t)(w.x & 0xffffu); *(bf16_t*)(p + 16) = (bf16_t)(w.x >> 16); *(bf16_t*)(p + 32) = (bf16_t)(w.y & 0xffffu); *(bf16_t*)(p + 48) = (bf16_t)(w.y >> 16);
    *(bf16_t*)(p + 64) = (bf16_t)(w.z & 0xffffu); *(bf16_t*)(p + 80) = (bf16_t)(w.z >> 16); *(bf16_t*)(p + 96) = (bf16_t)(w.w & 0xffffu); *(bf16_t*)(p + 112) = (bf16_t)(w.w >> 16);
}
struct EpiInproj {
    static constexpr bool PERM = true;
    unsigned char* ws; const float* lb; int skip;
    __device__ __forceinline__ void operator()(const f32x4 (&acc)[2][2][4][2], const pg8::Unit& u, int wr, int wc, int fr, int fq) const {
        if (skip & 1) { if (acc[0][0][0][0][0] == 12345.678f) ws[0] = 1; return; }
        const int pn = u.pn;
        const int rbase = u.pm * 256 + wr * 64 + fr;
        const int cwl = wc * 32 + fq * 8;
        if (pn == 2) {
            const int g = wc >> 1, dim = (wc & 1) * 32 + fq * 8;
#pragma unroll
            for (int ai = 0; ai < 2; ++ai)
#pragma unroll
                for (int m = 0; m < 4; ++m) { const int row = rbase + ai * 128 + m * 16, b = row >> 14, t = row & 16383;
                    const size_t e = ((size_t)((b * 2 + g) * 16384 + t)) * 64 + dim;
                    NTST((u32x4*)((bf16_t*)(ws + WS_KCIN) + e), pack8(acc[ai][0][m][0], acc[ai][0][m][1]));
                    NTST((u32x4*)((bf16_t*)(ws + WS_VCIN) + e), pack8(acc[ai][1][m][0], acc[ai][1][m][1])); }
        } else if (pn == 3 || pn == 4) {
            unsigned char* Kimg = ws + (pn == 3 ? WS_KS : WS_KW); unsigned char* Vimg = ws + (pn == 3 ? WS_VS : WS_VW);
            const int g = wc >> 1, dim = (wc & 1) * 32 + fq * 8;
#pragma unroll
            for (int ai = 0; ai < 2; ++ai)
#pragma unroll
                for (int m = 0; m < 4; ++m) { const int row = rbase + ai * 128 + m * 16, b = row >> 14, t = row & 16383, blk = t >> 6, key = t & 63;
                    const size_t ib = (size_t)((b * 2 + g) * 256 + blk) * 8192;
                    NTST((u32x4*)(Kimg + ib + kf_off(key, dim)), pack8(acc[ai][0][m][0], acc[ai][0][m][1]));
                    if (!(skip & 2)) vf_store8(Vimg + ib, key, dim, pack8(acc[ai][1][m][0], acc[ai][1][m][1])); }
        } else if (pn == 7 || pn == 8) {
            float* LOGF = (float*)(ws + WS_LOGF);
#pragma unroll
            for (int bj = 0; bj < 2; ++bj) { const int col = (pn - 7) * 256 + bj * 128 + cwl;
                const f32x4 l0 = *(const f32x4*)(lb + col), l1 = *(const f32x4*)(lb + col + 4);
#pragma unroll
                for (int ai = 0; ai < 2; ++ai)
#pragma unroll
                    for (int m = 0; m < 4; ++m) { const int row = rbase + ai * 128 + m * 16; f32x4 o0, o1;
#pragma unroll
                        for (int j = 0; j < 4; ++j) { o0[j] = __logf(l0[j] + (1.0f - l0[j]) * sigmoidf_(acc[ai][bj][m][0][j])); o1[j] = __logf(l1[j] + (1.0f - l1[j]) * sigmoidf_(acc[ai][bj][m][1][j])); }
                        NTST((f32x4*)(LOGF + (size_t)row * 512 + col), o0); NTST((f32x4*)(LOGF + (size_t)row * 512 + col + 4), o1); } }
        } else if (pn == 13) {
            if (cwl < 24) { float* GATE = (float*)(ws + WS_GATE);
#pragma unroll
                for (int ai = 0; ai < 2; ++ai)
#pragma unroll
                    for (int m = 0; m < 4; ++m) { const int row = rbase + ai * 128 + m * 16; f32x4 o0, o1;
#pragma unroll
                        for (int j = 0; j < 4; ++j) { o0[j] = sigmoidf_(acc[ai][0][m][0][j]); o1[j] = sigmoidf_(acc[ai][0][m][1][j]); }
                        *(f32x4*)(GATE + (size_t)row * 24 + cwl) = o0; *(f32x4*)(GATE + (size_t)row * 24 + cwl + 4) = o1; } }
        } else {
            bf16_t* base; int coff; int mode;
            if (pn <= 1) { base = (bf16_t*)(ws + WS_QN); coff = pn * 256; mode = 0; }
            else if (pn <= 6) { base = (bf16_t*)(ws + WS_HQ); coff = (pn - 5) * 256; mode = 1; }
            else if (pn <= 10) { base = (bf16_t*)(ws + WS_HI); coff = (pn - 9) * 256; mode = 1; }
            else { base = (bf16_t*)(ws + WS_HGS); coff = (pn - 11) * 256; mode = 2; }
#pragma unroll
            for (int ai = 0; ai < 2; ++ai)
#pragma unroll
                for (int m = 0; m < 4; ++m) { const int row = rbase + ai * 128 + m * 16;
#pragma unroll
                    for (int bj = 0; bj < 2; ++bj) { f32x4 v0 = acc[ai][bj][m][0], v1 = acc[ai][bj][m][1];
                        if (mode == 0) { v0 = v0 * QSCALE; v1 = v1 * QSCALE; }
                        else if (mode == 2) {
#pragma unroll
                            for (int j = 0; j < 4; ++j) { v0[j] = silu_(v0[j]); v1[j] = silu_(v1[j]); } }
                        NTST((u32x4*)(base + (size_t)row * 512 + coff + bj * 128 + cwl), pack8(v0, v1)); } }
        }
    }
};

struct EpiMemKV {
    static constexpr bool PERM = true;
    unsigned char* ws;
    __device__ __forceinline__ void operator()(const f32x4 (&acc)[2][2][4][2], const pg8::Unit& u, int wr, int wc, int fr, int fq) const {
        const int isv = u.pn >> 2, head = u.pn & 3, b = u.pm;
        unsigned char* img = ws + (isv ? WS_MEMV : WS_MEMK) + (size_t)(b * 4 + head) * 4 * 32768;
#pragma unroll
        for (int ai = 0; ai < 2; ++ai)
#pragma unroll
            for (int m = 0; m < 4; ++m) { const int key = ai * 128 + wr * 64 + m * 16 + fr, kb = key >> 6, kl = key & 63;
#pragma unroll
                for (int bj = 0; bj < 2; ++bj) { const int dim = bj * 128 + wc * 32 + fq * 8;
                    const int off = isv ? vimg_off(kl, dim) : kimg_off(kl, dim);
                    *(u32x4*)(img + (size_t)kb * 32768 + off) = pack8(acc[ai][bj][m][0], acc[ai][bj][m][1]); } }
    }
};

struct EpiCmp1 {
    static constexpr bool PERM = true;
    unsigned char* ws;
    __device__ __forceinline__ void operator()(const f32x4 (&acc)[2][2][4][2], const pg8::Unit& u, int wr, int wc, int fr, int fq) const {
        const int kv = u.aux; const float* bias = (const float*)(ws + (kv ? WS_BIASV : WS_BIASK));
        bf16_t* HID = (bf16_t*)(ws + WS_HID) + (size_t)kv * 4096 * 256;
        f32x4 bb[2][2];
#pragma unroll
        for (int bj = 0; bj < 2; ++bj) { bb[bj][0] = *(const f32x4*)(bias + bj * 128 + wc * 32 + fq * 8); bb[bj][1] = *(const f32x4*)(bias + bj * 128 + wc * 32 + fq * 8 + 4); }
#pragma unroll
        for (int bj = 0; bj < 2; ++bj) { const int col = bj * 128 + wc * 32 + fq * 8;
            const f32x4 b0 = bb[bj][0], b1 = bb[bj][1];
#pragma unroll
            for (int ai = 0; ai < 2; ++ai)
#pragma unroll
                for (int m = 0; m < 4; ++m) { const int row = u.pm * 256 + ai * 128 + wr * 64 + m * 16 + fr; f32x4 v0, v1;
#pragma unroll
                    for (int j = 0; j < 4; ++j) { v0[j] = gelu_tanh(acc[ai][bj][m][0][j] + b0[j]); v1[j] = gelu_tanh(acc[ai][bj][m][1][j] + b1[j]); }
                    *(u32x4*)(HID + (size_t)row * 256 + col) = pack8(v0, v1); } }
    }
};

__device__ __forceinline__ f32x2 ld_stat4(const float* stat, size_t row) { const f32x4 a = *(const f32x4*)(stat + row * 8), b = *(const f32x4*)(stat + row * 8 + 4); return (f32x2){(a[0] + a[2]) + (b[0] + b[2]), (a[1] + a[3]) + (b[1] + b[3])}; }
__device__ __forceinline__ void row_stats(const float* stat, size_t row, float& mean, float& rstd) {
    const f32x2 v = ld_stat4(stat, row);
    mean = v[0] * (1.f / 1024.f); rstd = 1.0f / sqrtf(fmaxf(v[1] * (1.f / 1024.f) - mean * mean, 0.f) + 1e-5f);
}
template <int MODE>
struct EpiRes {
    static constexpr bool PERM = true;
    static constexpr int MB = (MODE == 1) ? 2 : 4;
    const float* base; const bf16_t* baseb; bf16_t* outb; float* stat; const float* pstat; const float* lg; const float* lb; LAS f32x2* red;
    __device__ __forceinline__ void operator()(const f32x4 (&acc)[2][2][4][2], const pg8::Unit& u, int wr, int wc, int fr, int fq) const {
        const int col0 = u.pn * 256 + wc * 32 + 8 * fq;
        f32x4 gv[2][2], bv[2][2];
        if (MODE == 1) {
#pragma unroll
            for (int bj = 0; bj < 2; ++bj)
#pragma unroll
                for (int n = 0; n < 2; ++n) { gv[bj][n] = *(const f32x4*)(lg + col0 + bj * 128 + n * 4); bv[bj][n] = *(const f32x4*)(lb + col0 + bj * 128 + n * 4); } }
        u32x4 bsa[2][4][2];
        if (MODE == 2) {
#pragma unroll
            for (int ai = 0; ai < 2; ++ai)
#pragma unroll
                for (int m = 0; m < 4; ++m) { const size_t off = (size_t)(u.pm * 256 + ai * 128 + wr * 64 + m * 16 + fr) * 1024 + col0;
#pragma unroll
                    for (int bj = 0; bj < 2; ++bj) bsa[ai][m][bj] = *(const u32x4*)(baseb + off + bj * 128); } }
#pragma unroll
        for (int ai = 0; ai < 2; ++ai)
#pragma unroll
          for (int mb = 0; mb < 4; mb += MB) {
            f32x2 st[4]; f32x4 bsf[4][2][2]; u32x4 bsw[4][2];
#pragma unroll
            for (int m = mb; m < mb + MB; ++m) { const size_t row = (size_t)(u.pm * 256 + ai * 128 + wr * 64 + m * 16 + fr); const size_t off = row * 1024 + col0;
                if (MODE == 1) st[m] = ld_stat4(pstat, row);
#pragma unroll
                for (int bj = 0; bj < 2; ++bj) { if (MODE == 0) { bsf[m][bj][0] = *(const f32x4*)(base + off + bj * 128); bsf[m][bj][1] = *(const f32x4*)(base + off + bj * 128 + 4); }
                                                 else if (MODE == 2) bsw[m][bj] = bsa[ai][m][bj];
                                                 else bsw[m][bj] = *(const u32x4*)(baseb + off + bj * 128); } }
#pragma unroll
            for (int m = mb; m < mb + MB; ++m) { const size_t row = (size_t)(u.pm * 256 + ai * 128 + wr * 64 + m * 16 + fr); const size_t off = row * 1024 + col0;
                float mean = 0.f, rstd = 1.f;
                if (MODE == 1) { mean = st[m][0] * (1.f / 1024.f); rstd = 1.0f / sqrtf(fmaxf(st[m][1] * (1.f / 1024.f) - mean * mean, 0.f) + 1e-5f); }
                float s1 = 0.f, s2 = 0.f;
#pragma unroll
                for (int bj = 0; bj < 2; ++bj) { f32x4 o[2];
#pragma unroll
                    for (int n = 0; n < 2; ++n) { f32x4 bs;
                        if (MODE == 0) bs = bsf[m][bj][n];
                        else if (MODE == 2) { const unsigned w0 = n ? bsw[m][bj].z : bsw[m][bj].x, w1 = n ? bsw[m][bj].w : bsw[m][bj].y; bs = (f32x4){bflo(w0), bfhi(w0), bflo(w1), bfhi(w1)}; }
                        else { const unsigned w0 = n ? bsw[m][bj].z : bsw[m][bj].x, w1 = n ? bsw[m][bj].w : bsw[m][bj].y; bs = ((f32x4){bflo(w0), bfhi(w0), bflo(w1), bfhi(w1)} - mean) * rstd * gv[bj][n] + bv[bj][n]; }
                        o[n] = bs * ALPHA + acc[ai][bj][m][n];
                        s1 += (o[n][0] + o[n][1]) + (o[n][2] + o[n][3]); s2 += (o[n][0] * o[n][0] + o[n][1] * o[n][1]) + (o[n][2] * o[n][2] + o[n][3] * o[n][3]); }
                    NTST((u32x4*)(outb + off + bj * 128), pack8(o[0], o[1])); }
                s1 += __shfl_xor(s1, 16); s1 += __shfl_xor(s1, 32); s2 += __shfl_xor(s2, 16); s2 += __shfl_xor(s2, 32);
                if (fq == 0) red[((((wr * 2 + ai) * 4 + m) * 16 + fr) << 2) + wc] = (f32x2){s1, s2}; } }
        asm volatile("s_waitcnt lgkmcnt(0)" ::: "memory"); __builtin_amdgcn_s_barrier();
        { const int lane = fr + 16 * fq; if (lane < 32) { const int ai = lane >> 4, f2 = lane & 15;
            const LAS f32x2* rp = red + ((((wr * 2 + ai) * 4 + wc) * 16 + f2) << 2); const f32x2 a = rp[0], b2 = rp[1], c2 = rp[2], d2 = rp[3];
            *(f32x2*)(stat + ((size_t)(u.pm * 256 + ai * 128 + wr * 64 + wc * 16 + f2) * 4 + u.pn) * 2) = (f32x2){(a[0] + b2[0]) + (c2[0] + d2[0]), (a[1] + b2[1]) + (c2[1] + d2[1])}; } }
    }
};

struct EpiQLn {
    static constexpr bool PERM = true;
    bf16_t* O; const float* stat; const float* cs; const float* bq; int skip;
    __device__ __forceinline__ void operator()(const f32x4 (&acc)[2][2][4][2], const pg8::Unit& u, int wr, int wc, int fr, int fq) const {
        if (skip) { if (acc[0][0][0][0][0] == 12345.678f) O[0] = 1; return; }
        const int col0 = u.pn * 256 + wc * 32 + 8 * fq;
        f32x4 c0[2], c1[2], b0[2], b1[2];
#pragma unroll
        for (int bj = 0; bj < 2; ++bj) { c0[bj] = *(const f32x4*)(cs + col0 + bj * 128); c1[bj] = *(const f32x4*)(cs + col0 + bj * 128 + 4); b0[bj] = *(const f32x4*)(bq + col0 + bj * 128); b1[bj] = *(const f32x4*)(bq + col0 + bj * 128 + 4); }
#pragma unroll
        for (int ai = 0; ai < 2; ++ai) { f32x2 st[4];
#pragma unroll
            for (int m = 0; m < 4; ++m) st[m] = ld_stat4(stat, (size_t)(u.pm * 256 + ai * 128 + wr * 64 + m * 16 + fr));
#pragma unroll
            for (int m = 0; m < 4; ++m) { const size_t row = (size_t)(u.pm * 256 + ai * 128 + wr * 64 + m * 16 + fr);
                const float mean = st[m][0] * (1.f / 1024.f), rstd = 1.0f / sqrtf(fmaxf(st[m][1] * (1.f / 1024.f) - mean * mean, 0.f) + 1e-5f);
                bf16_t* rowp = O + row * 1024 + col0;
#pragma unroll
                for (int bj = 0; bj < 2; ++bj) {
                    const f32x4 v0 = ((acc[ai][bj][m][0] - c0[bj] * mean) * rstd + b0[bj]) * XSCALE, v1 = ((acc[ai][bj][m][1] - c1[bj] * mean) * rstd + b1[bj]) * XSCALE;
                    *(u32x4*)(rowp + bj * 128) = pack8(v0, v1); } } }
    }
};

struct EpiScaleBf16 {
    static constexpr bool PERM = true;
    bf16_t* O; int ldc; float scale;
    __device__ __forceinline__ void operator()(const f32x4 (&acc)[2][2][4][2], const pg8::Unit& u, int wr, int wc, int fr, int fq) const {
#pragma unroll
        for (int ai = 0; ai < 2; ++ai)
#pragma unroll
            for (int m = 0; m < 4; ++m) { bf16_t* rowp = O + (size_t)(u.pm * 256 + ai * 128 + wr * 64 + m * 16 + fr) * ldc + u.pn * 256 + wc * 32 + 8 * fq;
#pragma unroll
                for (int bj = 0; bj < 2; ++bj) *(u32x4*)(rowp + bj * 128) = pack8(acc[ai][bj][m][0] * scale, acc[ai][bj][m][1] * scale); }
    }
};

struct EpiGateUp {
    static constexpr bool PERM = true;
    bf16_t* H;
    __device__ __forceinline__ void operator()(const f32x4 (&acc)[2][2][4][2], const pg8::Unit& u, int wr, int wc, int fr, int fq) const {
#pragma unroll
        for (int ai = 0; ai < 2; ++ai)
#pragma unroll
            for (int m = 0; m < 4; ++m) { f32x4 v0, v1;
#pragma unroll
                for (int j = 0; j < 4; ++j) { v0[j] = silu_(acc[ai][0][m][0][j]) * acc[ai][1][m][0][j]; v1[j] = silu_(acc[ai][0][m][1][j]) * acc[ai][1][m][1][j]; }
                NTST((u32x4*)(H + (size_t)(u.pm * 256 + ai * 128 + wr * 64 + m * 16 + fr) * 512 + u.pn * 128 + wc * 32 + 8 * fq), pack8(v0, v1)); }
    }
};

struct EpiDown {
    static constexpr bool PERM = true;
    bf16_t* Y; const float* sw;
    __device__ __forceinline__ void operator()(const f32x4 (&acc)[2][2][4][2], const pg8::Unit& u, int wr, int wc, int fr, int fq) const {
        float wv[2][4];
#pragma unroll
        for (int ai = 0; ai < 2; ++ai)
#pragma unroll
            for (int m = 0; m < 4; ++m) wv[ai][m] = sw[u.pm * 256 + ai * 128 + wr * 64 + m * 16 + fr];
#pragma unroll
        for (int ai = 0; ai < 2; ++ai)
#pragma unroll
            for (int m = 0; m < 4; ++m) { const int row = u.pm * 256 + ai * 128 + wr * 64 + m * 16 + fr; const float w = wv[ai][m];
                bf16_t* rowp = Y + (size_t)row * 1024 + u.pn * 256 + wc * 32 + 8 * fq;
#pragma unroll
                for (int bj = 0; bj < 2; ++bj) NTST((u32x4*)(rowp + bj * 128), pack8(acc[ai][bj][m][0] * w, acc[ai][bj][m][1] * w)); }
    }
};
struct Args { const float* in[30]; float* out; unsigned char* ws; int ph_lo, ph_hi, rep, li; };
enum { I_X = 0, I_MEM, I_WIN, I_PEK, I_PEV, I_W1K, I_W2K, I_W1V, I_W2V, I_NSAG, I_LBL, I_HGG, I_WOUT, I_LN1G, I_LN1B, I_XWQ, I_XWK, I_XWV, I_XWO, I_LN2G, I_LN2B,
       I_MWG, I_MBG, I_MWE, I_MBE, I_MGATE, I_MUP, I_MDOWN, I_LN3G, I_LN3B };
constexpr int NWAVES = 8, NTHR = 512;
constexpr int LDS_BYTES = 147456;

struct Frame {
    LAS unsigned char* lds; unsigned char* ws; unsigned* ctl; const float* const* in; float* out;
    int tid, lane, wave, G, bid;
};

template <bool STREAM = false, class Src>
__device__ __forceinline__ void transpose_item(const Src& src, int K, bf16_t* dst, int nblk, LAS float* scr, int item, int lane) {
    const int kb = item / nblk, nb = item % nblk, k0 = 64 * kb, n0 = 32 * nb;
    f32x4 v[8];
#pragma unroll
    for (int i = 0; i < 8; ++i) v[i] = src.ld4(k0 + 8 * i + (lane >> 3), n0 + 4 * (lane & 7));
#pragma unroll
    for (int i = 0; i < 8; ++i) { LAS float* d = scr + (8 * i + (lane >> 3)) * 33 + 4 * (lane & 7); d[0] = v[i][0]; d[1] = v[i][1]; d[2] = v[i][2]; d[3] = v[i][3]; }
    asm volatile("s_waitcnt lgkmcnt(0)" ::: "memory");
    const int c = lane & 7;
#pragma unroll
    for (int j = 0; j < 4; ++j) { const int n = (lane >> 3) + 8 * j; const LAS float* s = scr + (8 * c) * 33 + n;
        u32x4 o; o.x = cvtpk(s[0 * 33], s[1 * 33]); o.y = cvtpk(s[2 * 33], s[3 * 33]); o.z = cvtpk(s[4 * 33], s[5 * 33]); o.w = cvtpk(s[6 * 33], s[7 * 33]);
        if (STREAM) __builtin_nontemporal_store(o, (u32x4*)(dst + (size_t)(n0 + n) * K + k0 + 8 * c)); else *(u32x4*)(dst + (size_t)(n0 + n) * K + k0 + 8 * c) = o; }
    asm volatile("s_waitcnt lgkmcnt(0)" ::: "memory");
}
struct SrcPlain { const float* w; int ldn; __device__ __forceinline__ f32x4 ld4(int k, int n) const { return *(const f32x4*)(w + (size_t)k * ldn + n); } };
struct SrcScaled { const float* w; const float* g; int ldn; __device__ __forceinline__ f32x4 ld4(int k, int n) const { return *(const f32x4*)(w + (size_t)k * ldn + n) * g[k]; } };
struct SrcWin { const float* w; __device__ __forceinline__ f32x4 ld4(int k, int n) const {
    int sc; if (n < 1280) sc = n; else if (n < 3328) sc = n + 24; else { const int j = n - 3328; sc = j < 24 ? 1280 + j : -1; }
    return sc >= 0 ? *(const f32x4*)(w + (size_t)k * 3352 + sc) : (f32x4){0.f, 0.f, 0.f, 0.f}; } };
struct SrcGU { const float* wg; const float* wu; __device__ __forceinline__ f32x4 ld4(int k, int n) const {
    const int tile = n >> 8, i = n & 255; const long long d = (long long)(wu - wg) * (long long)((i >> 7) & 1); return *(const f32x4*)(wg + d + (size_t)k * 512 + tile * 128 + (i & 127)); } };

struct SrcPlainNT { const float* w; int ldn; __device__ __forceinline__ f32x4 ld4(int k, int n) const { return __builtin_nontemporal_load((const f32x4*)(w + (size_t)k * ldn + n)); } };
struct SrcGUNT { const float* wg; const float* wu; __device__ __forceinline__ f32x4 ld4(int k, int n) const {
    const int tile = n >> 8, i = n & 255; const long long d = (long long)(wu - wg) * (long long)((i >> 7) & 1); return __builtin_nontemporal_load((const f32x4*)(wg + d + (size_t)k * 512 + tile * 128 + (i & 127))); } };
constexpr int MOE_CONV_ITEMS = 32 * (16 * 32 + 8 * 32);
__device__ __forceinline__ void moe_conv_load(Frame& F, int it, f32x4 (&v)[8]) {
    constexpr int I_GU = 16 * 32, I_D = 8 * 32;
    const int e = it / (I_GU + I_D), r = it % (I_GU + I_D), lane = F.lane;
    if (r < I_GU) { const SrcGUNT src{F.in[I_MGATE] + (size_t)e * 1024 * 512, F.in[I_MUP] + (size_t)e * 1024 * 512}; const int k0 = 64 * (r / 32), n0 = 32 * (r % 32);
#pragma unroll
        for (int i = 0; i < 8; ++i) v[i] = src.ld4(k0 + 8 * i + (lane >> 3), n0 + 4 * (lane & 7)); }
    else { const int r2 = r - I_GU; const SrcPlainNT src{F.in[I_MDOWN] + (size_t)e * 512 * 1024, 1024}; const int k0 = 64 * (r2 / 32), n0 = 32 * (r2 % 32);
#pragma unroll
        for (int i = 0; i < 8; ++i) v[i] = src.ld4(k0 + 8 * i + (lane >> 3), n0 + 4 * (lane & 7)); }
}
__device__ __forceinline__ void moe_conv_store(Frame& F, int it, const f32x4 (&v)[8]) {
    constexpr int I_GU = 16 * 32, I_D = 8 * 32;
    LAS float* scr = (LAS float*)(F.lds + F.wave * 16384);
    const int e = it / (I_GU + I_D), r = it % (I_GU + I_D), lane = F.lane;
    const bool gu = r < I_GU; const int item = gu ? r : r - I_GU, K = gu ? 1024 : 512;
    bf16_t* dst = gu ? (bf16_t*)(F.ws + WS_WGU) + (size_t)e * 1024 * 1024 : (bf16_t*)(F.ws + WS_WD) + (size_t)e * 1024 * 512;
    const int k0 = 64 * (item / 32), n0 = 32 * (item % 32);
#pragma unroll
    for (int i = 0; i < 8; ++i) { LAS float* d = scr + (8 * i + (lane >> 3)) * 33 + 4 * (lane & 7); d[0] = v[i][0]; d[1] = v[i][1]; d[2] = v[i][2]; d[3] = v[i][3]; }
    asm volatile("s_waitcnt lgkmcnt(0)" ::: "memory");
    const int c = lane & 7;
#pragma unroll
    for (int j = 0; j < 4; ++j) { const int n = (lane >> 3) + 8 * j; const LAS float* sp = scr + (8 * c) * 33 + n;
        u32x4 o; o.x = cvtpk(sp[0 * 33], sp[1 * 33]); o.y = cvtpk(sp[2 * 33], sp[3 * 33]); o.z = cvtpk(sp[4 * 33], sp[5 * 33]); o.w = cvtpk(sp[6 * 33], sp[7 * 33]);
        __builtin_nontemporal_store(o, (u32x4*)(dst + (size_t)(n0 + n) * K + k0 + 8 * c)); }
    asm volatile("s_waitcnt lgkmcnt(0)" ::: "memory");
}
__device__ __forceinline__ void p0_prep(Frame& F) {
    LAS float* scr = (LAS float*)(F.lds + F.wave * 16384);
    const int gw = F.bid * NWAVES + F.wave, NGW = F.G * NWAVES;
    unsigned char* ws = F.ws;
    if (F.bid == 0) { const float* l = F.in[I_LBL]; ((float*)(ws + WS_LB))[F.tid] = 1.0f / (1.0f + __expf(l[512 + F.tid] - l[F.tid])); }
    { const int job = F.bid - 1;
      if (job >= 0 && job < 48) { LAS float* red = (LAS float*)(F.lds + 100 * 1024); const int cl = F.tid & 31, sl = F.tid >> 5; float a0 = 0.f, a1 = 0.f;
        if (job < 16) { const int kv = job >> 3, n = (job & 7) * 32 + cl; const float* pe = F.in[kv ? I_PEV : I_PEK]; const float* w1 = F.in[kv ? I_W1V : I_W1K];
#pragma unroll 8
            for (int k = sl * 128; k < sl * 128 + 128; ++k) a0 += pe[k] * w1[(size_t)k * 256 + n]; }
        else { const int n = (job - 16) * 32 + cl; const float* wq = F.in[I_XWQ]; const float* g1 = F.in[I_LN1G]; const float* b1 = F.in[I_LN1B];
#pragma unroll 8
            for (int k = sl * 64; k < sl * 64 + 64; ++k) { const float wv = wq[(size_t)k * 1024 + n]; a0 += bf2f(f2bf(wv * g1[k])); a1 += b1[k] * wv; } }
        red[F.tid] = a0; red[512 + F.tid] = a1;
        __syncthreads();
        if (F.tid < 32) { float s0 = 0.f, s1 = 0.f;
#pragma unroll
            for (int i = 0; i < 16; ++i) { s0 += red[i * 32 + F.tid]; s1 += red[512 + i * 32 + F.tid]; }
            if (job < 16) ((float*)(ws + ((job >> 3) ? WS_BIASV : WS_BIASK)))[(job & 7) * 32 + F.tid] = s0;
            else { ((float*)(ws + WS_QCS))[(job - 16) * 32 + F.tid] = s0; ((float*)(ws + WS_QBQ))[(job - 16) * 32 + F.tid] = s1; } }
        __syncthreads(); }
      if (job == 48) { LAS float* red = (LAS float*)(F.lds + 100 * 1024); const int cg = F.tid & 15, sl = F.tid >> 4;
        const float* wg = F.in[I_MWG]; const float* we = F.in[I_MWE]; const float* g2 = F.in[I_LN2G]; const float* b2 = F.in[I_LN2B];
        float a0[3] = {0.f, 0.f, 0.f}, a1[3] = {0.f, 0.f, 0.f};
#pragma unroll 8
        for (int k = sl * 32; k < sl * 32 + 32; ++k) { const float g = g2[k], bb = b2[k];
#pragma unroll
            for (int j = 0; j < 3; ++j) { const int c = cg + 16 * j; const float wv = c < 4 ? wg[k * 4 + c] : c < 36 ? we[k * 32 + (c - 4)] : 0.f; const float v = wv * g; const float h = bf2f(f2bf(v));
                a0[j] += h + bf2f(f2bf(v - h)); a1[j] += bb * wv; } }
#pragma unroll
        for (int j = 0; j < 3; ++j) { red[sl * 48 + cg + 16 * j] = a0[j]; red[1536 + sl * 48 + cg + 16 * j] = a1[j]; }
        __syncthreads();
        if (F.tid < 48) { float s0 = 0.f, s1 = 0.f;
#pragma unroll
            for (int i = 0; i < 32; ++i) { s0 += red[i * 48 + F.tid]; s1 += red[1536 + i * 48 + F.tid]; }
            const float bias = F.tid < 4 ? F.in[I_MBG][F.tid] : F.tid < 36 ? F.in[I_MBE][F.tid - 4] : 0.f;
            ((float*)(ws + WS_RCS))[F.tid] = s0; ((float*)(ws + WS_RCB))[F.tid] = s1 + bias; }
        __syncthreads(); } }
    constexpr int I_WINN = 16 * 112, I_SQ = 16 * 32, I_W1 = 32 * 8, I_W2 = 4 * 2;
    constexpr int NITEMS_A = I_WINN + 5 * I_SQ + 2 * I_W1 + 2 * I_W2;
    for (int it = gw; it < NITEMS_A; it += NGW) {
        int r = it;
        if (r < I_WINN) { transpose_item(SrcWin{F.in[I_WIN]}, 1024, (bf16_t*)(ws + WS_WIN), 112, scr, r, F.lane); continue; } r -= I_WINN;
        if (r < 5 * I_SQ) { const int w = r / I_SQ; const float* src = F.in[w == 0 ? I_WOUT : w == 1 ? I_XWQ : w == 2 ? I_XWK : w == 3 ? I_XWV : I_XWO];
            if (w == 1) transpose_item(SrcScaled{src, F.in[I_LN1G], 1024}, 1024, (bf16_t*)(ws + WS_WQ), 32, scr, r % I_SQ, F.lane);
            else transpose_item(SrcPlain{src, 1024}, 1024, (bf16_t*)(ws + WS_WOUT + (size_t)w * 2 * MiB), 32, scr, r % I_SQ, F.lane);
            continue; } r -= 5 * I_SQ;
        if (r < 2 * I_W1) { const int kv = r / I_W1; transpose_item(SrcPlain{F.in[kv ? I_W1V : I_W1K], 256}, 2048, (bf16_t*)(ws + (kv ? WS_W1V : WS_W1K)), 8, scr, r % I_W1, F.lane); continue; } r -= 2 * I_W1;
        { const int kv = r / I_W2; transpose_item(SrcPlain{F.in[kv ? I_W2V : I_W2K], 64}, 256, (bf16_t*)(ws + (kv ? WS_W2V : WS_W2K)), 2, scr, r % I_W2, F.lane); }
    }
    { bf16_t* WH = (bf16_t*)(ws + WS_WRH); bf16_t* WL = (bf16_t*)(ws + WS_WRL); const float* wg = F.in[I_MWG]; const float* we = F.in[I_MWE];
      for (size_t i = (size_t)F.bid * NTHR + F.tid; i < (size_t)48 * 1024; i += (size_t)F.G * NTHR) { const int c = (int)(i >> 10), k = (int)(i & 1023);
          const float v = (c < 4 ? wg[k * 4 + c] : c < 36 ? we[k * 32 + (c - 4)] : 0.f) * F.in[I_LN2G][k]; const bf16_t h = f2bf(v); WH[i] = h; WL[i] = f2bf(v - bf2f(h)); } }
    const size_t gt = (size_t)F.bid * NTHR + F.tid, NT = (size_t)F.G * NTHR;
    { const f32x4* x4 = (const f32x4*)F.in[I_X]; u32x4* o = (u32x4*)(ws + WS_RA);
      for (size_t i = gt; i < (size_t)NTOK * DM / 8; i += NT) o[i] = pack8(x4[2 * i], x4[2 * i + 1]); }
    { const f32x4* x4 = (const f32x4*)F.in[I_MEM]; u32x4* o = (u32x4*)(ws + WS_MEMB);
      for (size_t i = gt; i < (size_t)512 * DM / 8; i += NT) o[i] = pack8(x4[2 * i], x4[2 * i + 1]); }
}

__device__ __forceinline__ void ln_row(const float* src, const float* g, const float* b, int lane, f32x4 (&y)[4]) {
    const f32x4* xr = (const f32x4*)src + lane; f32x4 v[4]; float s = 0.f;
#pragma unroll
    for (int j = 0; j < 4; ++j) { v[j] = xr[64 * j]; s += (v[j][0] + v[j][1]) + (v[j][2] + v[j][3]); }
    const float mean = wave_sum(s) * (1.f / 1024.f); float s2 = 0.f;
#pragma unroll
    for (int j = 0; j < 4; ++j) { v[j] = v[j] - mean; s2 += (v[j][0] * v[j][0] + v[j][1] * v[j][1]) + (v[j][2] * v[j][2] + v[j][3] * v[j][3]); }
    const float rstd = 1.0f / sqrtf(wave_sum(s2) * (1.f / 1024.f) + 1e-5f);
#pragma unroll
    for (int j = 0; j < 4; ++j) { const f32x4 gg = ((const f32x4*)g)[lane + 64 * j], bb = ((const f32x4*)b)[lane + 64 * j]; y[j] = v[j] * rstd * gg + bb; }
}
__device__ __forceinline__ void store_row_f32_bf16(const f32x4 (&y)[4], float* of, bf16_t* ob, int lane) {
#pragma unroll
    for (int j = 0; j < 4; ++j) { ((f32x4*)of)[lane + 64 * j] = y[j]; u32x2 w; w.x = cvtpk(y[j][0], y[j][1]); w.y = cvtpk(y[j][2], y[j][3]); ((u32x2*)ob)[lane + 64 * j] = w; }
}
__device__ __forceinline__ int crow(int r, int hi) { return (r & 3) + 8 * (r >> 2) + 4 * hi; }
#define MFMA32(a, b, c) __builtin_amdgcn_mfma_f32_32x32x16_bf16((a), (b), (c), 0, 0, 0)
__device__ __forceinline__ int tsw(int row, int t) { return row * 72 + ((((t >> 3) ^ ((row >> 2) & 7)) << 3) | (t & 7)); }

__device__ __forceinline__ void chunk_cumsum(LAS float* lf, LAS float* seg_tot, int tid) {
    const int ch = tid & 127, seg = tid >> 7; float v[16];
#pragma unroll
    for (int i = 0; i < 16; ++i) v[i] = lf[(seg * 16 + i) * 128 + ch];
#pragma unroll
    for (int i = 1; i < 16; ++i) v[i] += v[i - 1];
#pragma unroll
    for (int i = 0; i < 16; ++i) lf[(seg * 16 + i) * 128 + ch] = v[i];
    seg_tot[seg * 128 + ch] = v[15];
}
#define DPPADD_(v, ctrl, rm) v += __int_as_float(__builtin_amdgcn_update_dpp(0, __float_as_int(v), ctrl, rm, 0xF, true))
__device__ __forceinline__ float half_sum_dpp(float v) { DPPADD_(v, 0x111, 0xF); DPPADD_(v, 0x112, 0xF); DPPADD_(v, 0x114, 0xF); DPPADD_(v, 0x118, 0xF); DPPADD_(v, 0x142, 0xA); return v; }

struct HAIn { f32x4 lfr[4]; u32x2 vr[4]; };
__device__ __forceinline__ void hgrn_a_load(Frame& F, int unit, int tid, HAIn& in) {
    const int bh = unit >> 8, c = unit & 255, b = bh >> 2, h = bh & 3; const size_t m0 = (size_t)b * SEQ + 64 * c; const int tr = tid >> 5, c4 = (tid & 31) * 4;
    const float* LOGF = (const float*)(F.ws + WS_LOGF) + m0 * 512 + h * 128; const bf16_t* HI = (const bf16_t*)(F.ws + WS_HI) + m0 * 512 + h * 128;
#pragma unroll
    for (int i = 0; i < 4; ++i) { const int t = 4 * tr + i; in.lfr[i] = *(const f32x4*)(LOGF + (size_t)t * 512 + c4); in.vr[i] = *(const u32x2*)(HI + (size_t)t * 512 + c4); }
}
template <class NextFn>
__device__ __forceinline__ void hgrn_a_loop(Frame& F, const NextFn& next_unit) {
    const int w = F.wave;
    LAS float* lf = (LAS float*)F.lds; LAS bf16_t* KeT = (LAS bf16_t*)(F.lds + 32768); LAS bf16_t* Vt = (LAS bf16_t*)(F.lds + 51200); LAS float* segt = (LAS float*)(F.lds + 69632);
    int unit = next_unit(); if (unit < 0) return;
    HAIn in; hgrn_a_load(F, unit, F.tid, in);
    for (;;) {
        const int un = next_unit();
        int tid = F.tid; asm volatile("" : "+v"(tid));
        const int lane = tid & 63, r32 = lane & 31, hi = lane >> 5, tr = tid >> 5, c4 = (tid & 31) * 4;
#pragma unroll
        for (int i = 0; i < 4; ++i) *(LAS f32x4*)(lf + (4 * tr + i) * 128 + c4) = in.lfr[i];
        __syncthreads();
        chunk_cumsum(lf, segt, tid);
        __syncthreads();
        { const f32x4 T0 = *(const LAS f32x4*)(segt + c4), T1 = *(const LAS f32x4*)(segt + 128 + c4), T2 = *(const LAS f32x4*)(segt + 256 + c4);
          const f32x4 bl = *(const LAS f32x4*)(lf + 63 * 128 + c4) + T0 + T1 + T2;
          if (tr == 0) *(f32x4*)((float*)(F.ws + WS_HD) + (size_t)unit * 128 + c4) = (f32x4){__expf(bl[0]), __expf(bl[1]), __expf(bl[2]), __expf(bl[3])};
          const int seg = tr >> 2;
          const f32x4 z4 = (f32x4){0.f, 0.f, 0.f, 0.f}; const f32x4 off = (seg > 0 ? T0 : z4) + (seg > 1 ? T1 : z4) + (seg > 2 ? T2 : z4);
          float ke[4][4];
#pragma unroll
          for (int i = 0; i < 4; ++i) { const f32x4 bt = *(const LAS f32x4*)(lf + (4 * tr + i) * 128 + c4) + off;
#pragma unroll
            for (int j = 0; j < 4; ++j) { const float kk = 1.0f - __expf(in.lfr[i][j]); ke[i][j] = kk * __expf(bl[j] - bt[j]); } }
#pragma unroll
          for (int j = 0; j < 4; ++j) { u32x2 wk; wk.x = cvtpk(ke[0][j], ke[1][j]); wk.y = cvtpk(ke[2][j], ke[3][j]); *(LAS u32x2*)(KeT + tsw(c4 + j, 4 * tr)) = wk; }
          { const unsigned x0 = in.vr[0].x, x1 = in.vr[1].x, x2 = in.vr[2].x, x3 = in.vr[3].x, y0 = in.vr[0].y, y1 = in.vr[1].y, y2 = in.vr[2].y, y3 = in.vr[3].y;
            *(LAS u32x2*)(Vt + tsw(c4 + 0, 4 * tr)) = (u32x2){(x0 & 0xffffu) | (x1 << 16), (x2 & 0xffffu) | (x3 << 16)};
            *(LAS u32x2*)(Vt + tsw(c4 + 1, 4 * tr)) = (u32x2){(x0 >> 16) | (x1 & 0xffff0000u), (x2 >> 16) | (x3 & 0xffff0000u)};
            *(LAS u32x2*)(Vt + tsw(c4 + 2, 4 * tr)) = (u32x2){(y0 & 0xffffu) | (y1 << 16), (y2 & 0xffffu) | (y3 << 16)};
            *(LAS u32x2*)(Vt + tsw(c4 + 3, 4 * tr)) = (u32x2){(y0 >> 16) | (y1 & 0xffff0000u), (y2 >> 16) | (y3 & 0xffff0000u)}; } }
        if (un >= 0) hgrn_a_load(F, un, tid, in);
        __syncthreads();
        { const int vt = w >> 1, kt0 = 2 * (w & 1); f32x16 a0 = {}, a1 = {};
#pragma unroll
          for (int ks = 0; ks < 4; ++ks) { const bf16x8 av = *(const LAS bf16x8*)(Vt + tsw(vt * 32 + r32, 16 * ks + 8 * hi));
            const bf16x8 b0 = *(const LAS bf16x8*)(KeT + tsw(kt0 * 32 + r32, 16 * ks + 8 * hi)), b1 = *(const LAS bf16x8*)(KeT + tsw((kt0 + 1) * 32 + r32, 16 * ks + 8 * hi));
            a0 = MFMA32(av, b0, a0); a1 = MFMA32(av, b1, a1); }
          bf16_t* HST = (bf16_t*)F.out + (size_t)unit * 16384;
#pragma unroll
          for (int r = 0; r < 16; ++r) { const int v = vt * 32 + crow(r, hi); HST[v * 128 + kt0 * 32 + r32] = f2bf(a0[r]); HST[v * 128 + (kt0 + 1) * 32 + r32] = f2bf(a1[r]); } }
        if (un < 0) break;
        unit = un;
    }
    __syncthreads();
}

__device__ __forceinline__ void hgrn_b(Frame& F, bool dry) {
    unsigned* HST = (unsigned*)F.out; const ptrdiff_t wofs = dry ? (ptrdiff_t)((unsigned*)(F.ws + WS_RE) - HST) : 0; const float* HD = (const float*)(F.ws + WS_HD);
    for (int e = F.bid * NTHR + F.tid; e < 8 * 8192; e += F.G * NTHR) {
        const int bh = e >> 13, rem = e & 8191, k2 = (rem & 63) * 2; float S0 = 0.f, S1 = 0.f;
        unsigned* hs = HST + (size_t)bh * 256 * 8192 + rem; const float* hd = HD + (size_t)bh * 256 * 128 + k2;
#define HB_LOAD(L, d, C0) do { _Pragma("unroll") for (int i = 0; i < 16; ++i) { L[i] = hs[(size_t)((C0) + i) * 8192]; d[i] = *(const f32x2*)(hd + (size_t)((C0) + i) * 128); } } while (0)
#define HB_SCAN(L, d, C0) do { _Pragma("unroll") for (int i = 0; i < 16; ++i) { hs[(size_t)((C0) + i) * 8192 + wofs] = cvtpk(S0, S1); S0 = d[i][0] * S0 + bflo(L[i]); S1 = d[i][1] * S1 + bfhi(L[i]); } } while (0)
        unsigned La[16], Lb[16]; f32x2 da[16], db[16];
        HB_LOAD(La, da, 0);
#pragma nounroll
        for (int c0 = 0; c0 < 256; c0 += 32) {
            HB_LOAD(Lb, db, c0 + 16);
            HB_SCAN(La, da, c0);
            if (c0 + 32 < 256) HB_LOAD(La, da, c0 + 32);
            HB_SCAN(Lb, db, c0 + 16);
        }
#undef HB_LOAD
#undef HB_SCAN
    }
}

struct HCIn { f32x4 lfr[4]; u32x2 vr[4], qv[4]; u32x4 stf[8]; };
template <int PART>
__device__ __forceinline__ void hgrn_c_load(Frame& F, int unit, HCIn& in) {
    const int bh = unit >> 8, c = unit & 255, b = bh >> 2, h = bh & 3, tid = F.tid, lane = F.lane, w = F.wave, r32 = lane & 31, hi = lane >> 5;
    const size_t m0 = (size_t)b * SEQ + 64 * c; const int tr = tid >> 5, c4 = (tid & 31) * 4, vt = w & 3;
    if (PART & 1) {
    const float* LOGF = (const float*)(F.ws + WS_LOGF) + m0 * 512 + h * 128; const bf16_t* HI = (const bf16_t*)(F.ws + WS_HI) + m0 * 512 + h * 128;
    const bf16_t* HQ = (const bf16_t*)(F.ws + WS_HQ) + m0 * 512 + h * 128;
#pragma unroll
    for (int i = 0; i < 4; ++i) { const int t = 4 * tr + i; in.lfr[i] = *(const f32x4*)(LOGF + (size_t)t * 512 + c4); in.vr[i] = *(const u32x2*)(HI + (size_t)t * 512 + c4);
        in.qv[i] = *(const u32x2*)(HQ + (size_t)t * 512 + c4); } }
    if (PART & 2) { const bf16_t* ST = (const bf16_t*)F.out + (size_t)unit * 16384 + (size_t)(vt * 32 + r32) * 128 + 8 * hi;
#pragma unroll
    for (int ks = 0; ks < 8; ++ks) in.stf[ks] = *(const u32x4*)(ST + 16 * ks); }
}
template <class NextFn>
__device__ __forceinline__ void hgrn_c_loop(Frame& F, const NextFn& next_unit) {
    const int w = F.wave;
    LAS float* lf = (LAS float*)F.lds; LAS bf16_t* Qe = (LAS bf16_t*)(F.lds + 32768); LAS bf16_t* Qi = (LAS bf16_t*)(F.lds + 50176); LAS bf16_t* Ki = (LAS bf16_t*)(F.lds + 67584);
    LAS bf16_t* Vt = (LAS bf16_t*)(F.lds + 84992); LAS bf16_t* att = (LAS bf16_t*)(F.lds + 103424); LAS float* ssb = (LAS float*)(F.lds + 112640); LAS float* segt = (LAS float*)(F.lds + 113664);
    const int tt = w >> 2, vt = w & 3;
    const float gg = F.in[I_HGG][vt * 32 + (F.lane & 31)];
    int unit = next_unit(); if (unit < 0) return;
    HCIn in; hgrn_c_load<3>(F, unit, in);
    for (;;) {
        const int un = next_unit();
        int tid = F.tid; asm volatile("" : "+v"(tid));
        const int lane = tid & 63, r32 = lane & 31, hi = lane >> 5, tr = tid >> 5, c4 = (tid & 31) * 4;
        const int bh = unit >> 8, c = unit & 255, b = bh >> 2, h = bh & 3; const size_t m0 = (size_t)b * SEQ + 64 * c;
        const bf16_t* HGS = (const bf16_t*)(F.ws + WS_HGS) + m0 * 512 + h * 128 + vt * 32 + r32;
#pragma unroll
        for (int i = 0; i < 4; ++i) *(LAS f32x4*)(lf + (4 * tr + i) * 128 + c4) = in.lfr[i];
        __syncthreads();
        chunk_cumsum(lf, segt, tid);
        __syncthreads();
        { const f32x4 T0 = *(const LAS f32x4*)(segt + c4), T1 = *(const LAS f32x4*)(segt + 128 + c4), T2 = *(const LAS f32x4*)(segt + 256 + c4);
          const f32x4 bm = *(const LAS f32x4*)(lf + 31 * 128 + c4) + T0;
          const int seg = tr >> 2; const f32x4 z4 = (f32x4){0.f, 0.f, 0.f, 0.f}; const f32x4 off = (seg > 0 ? T0 : z4) + (seg > 1 ? T1 : z4) + (seg > 2 ? T2 : z4);
#pragma unroll
          for (int i = 0; i < 4; ++i) { const int t = 4 * tr + i; const f32x4 bt = *(const LAS f32x4*)(lf + t * 128 + c4) + off;
            float q[4] = {bflo(in.qv[i].x), bfhi(in.qv[i].x), bflo(in.qv[i].y), bfhi(in.qv[i].y)}; float qe[4], qi[4], ki[4];
#pragma unroll
            for (int j = 0; j < 4; ++j) { const float kk = 1.0f - __expf(in.lfr[i][j]); qe[j] = q[j] * __expf(bt[j]); const float ed = __expf(fminf(fmaxf(bt[j] - bm[j], -80.f), 80.f)); qi[j] = q[j] * ed; ki[j] = kk * __builtin_amdgcn_rcpf(ed); }
            u32x2 o; o.x = cvtpk(qe[0], qe[1]); o.y = cvtpk(qe[2], qe[3]); *(LAS u32x2*)(Qe + t * 136 + c4) = o;
            o.x = cvtpk(qi[0], qi[1]); o.y = cvtpk(qi[2], qi[3]); *(LAS u32x2*)(Qi + t * 136 + c4) = o;
            o.x = cvtpk(ki[0], ki[1]); o.y = cvtpk(ki[2], ki[3]); *(LAS u32x2*)(Ki + t * 136 + c4) = o;
          }
          { const unsigned x0 = in.vr[0].x, x1 = in.vr[1].x, x2 = in.vr[2].x, x3 = in.vr[3].x, y0 = in.vr[0].y, y1 = in.vr[1].y, y2 = in.vr[2].y, y3 = in.vr[3].y;
            *(LAS u32x2*)(Vt + tsw(c4 + 0, 4 * tr)) = (u32x2){(x0 & 0xffffu) | (x1 << 16), (x2 & 0xffffu) | (x3 << 16)};
            *(LAS u32x2*)(Vt + tsw(c4 + 1, 4 * tr)) = (u32x2){(x0 >> 16) | (x1 & 0xffff0000u), (x2 >> 16) | (x3 & 0xffff0000u)};
            *(LAS u32x2*)(Vt + tsw(c4 + 2, 4 * tr)) = (u32x2){(y0 & 0xffffu) | (y1 << 16), (y2 & 0xffffu) | (y3 << 16)};
            *(LAS u32x2*)(Vt + tsw(c4 + 3, 4 * tr)) = (u32x2){(y0 >> 16) | (y1 & 0xffff0000u), (y2 >> 16) | (y3 & 0xffff0000u)}; } }
        __syncthreads();
        f32x16 acc = {};
#pragma unroll
        for (int ks = 0; ks < 8; ++ks) { const bf16x8 af = *(const LAS bf16x8*)(Qe + (tt * 32 + r32) * 136 + 16 * ks + 8 * hi);
            acc = MFMA32(af, __builtin_bit_cast(bf16x8, in.stf[ks]), acc); }
        unsigned short gs[16];
#pragma unroll
        for (int r = 0; r < 16; ++r) gs[r] = HGS[(size_t)(tt * 32 + crow(r, hi)) * 512];
        if (un >= 0) hgrn_c_load<1>(F, un, in);
        if (w < 4 && w != 1) { const int ti = w >> 1, si = w & 1; f32x16 a = {};
#pragma unroll
            for (int ks = 0; ks < 8; ++ks) { const bf16x8 af = *(const LAS bf16x8*)(Qi + (ti * 32 + r32) * 136 + 16 * ks + 8 * hi), bf = *(const LAS bf16x8*)(Ki + (si * 32 + r32) * 136 + 16 * ks + 8 * hi);
                a = MFMA32(af, bf, a); }
            const int sidx = si * 32 + r32;
#pragma unroll
            for (int r = 0; r < 16; ++r) { const int t = ti * 32 + crow(r, hi); att[t * 72 + sidx] = f2bf(sidx <= t ? a[r] : 0.f); } }
        __syncthreads();
#pragma unroll
        for (int ks = 0; ks < 4; ++ks) if (ks < 2 || tt == 1) { const bf16x8 af = *(const LAS bf16x8*)(att + (tt * 32 + r32) * 72 + 16 * ks + 8 * hi), bf = *(const LAS bf16x8*)(Vt + tsw(vt * 32 + r32, 16 * ks + 8 * hi));
            acc = MFMA32(af, bf, acc); }
#pragma unroll
        for (int r = 0; r < 16; ++r) { const float q = half_sum_dpp(acc[r] * acc[r]);
            if (r32 == 31) ssb[(tt * 32 + crow(r, hi)) * 4 + vt] = q; }
        if (un >= 0) hgrn_c_load<2>(F, un, in);
        __syncthreads();
        { bf16_t* MX = (bf16_t*)(F.ws + WS_RB) + m0 * 1024 + 512 + h * 128 + vt * 32 + r32;
#pragma unroll
          for (int r = 0; r < 16; ++r) { const int t = tt * 32 + crow(r, hi); const f32x4 s4 = *(const LAS f32x4*)(ssb + t * 4);
            const float rs = __builtin_amdgcn_rsqf(((s4[0] + s4[1]) + (s4[2] + s4[3])) * (1.f / 128.f) + 1e-6f);
            MX[(size_t)t * 1024] = f2bf(acc[r] * rs * gg * bf2f(gs[r])); } }
        if (un < 0) break;
        unit = un;
    }
    __syncthreads();
}
typedef short v4i16_t __attribute__((ext_vector_type(4)));
__device__ __forceinline__ s16x4 vtr(const LAS unsigned char* p) { return __builtin_bit_cast(s16x4, __builtin_amdgcn_ds_read_tr16_b64_v4i16((LAS v4i16_t*)p)); }
__device__ __forceinline__ float xhalf(float v) { return __shfl_xor(v, 32); }
__device__ __forceinline__ float dpp_x1(float v) { return __int_as_float(__builtin_amdgcn_update_dpp(0, __float_as_int(v), 0xB1, 0xF, 0xF, true)); }
__device__ __forceinline__ float dpp_x2(float v) { return __int_as_float(__builtin_amdgcn_update_dpp(0, __float_as_int(v), 0x4E, 0xF, 0xF, true)); }

#define DPPMAX_(v, ctrl, rm) v = fmaxf(v, __int_as_float(__builtin_amdgcn_update_dpp(__float_as_int(v), __float_as_int(v), ctrl, rm, 0xF, false)))
__device__ __forceinline__ float wave_max_bcast(float v) {
    DPPMAX_(v, 0x111, 0xF); DPPMAX_(v, 0x112, 0xF); DPPMAX_(v, 0x114, 0xF); DPPMAX_(v, 0x118, 0xF); DPPMAX_(v, 0x142, 0xA); DPPMAX_(v, 0x143, 0xC);
    return __int_as_float(__builtin_amdgcn_readlane(__float_as_int(v), 63));
}
#define LADD(p, v) (void)__hip_atomic_fetch_add((p), (v), __ATOMIC_RELAXED, __HIP_MEMORY_SCOPE_WORKGROUP)
struct FlashSt { f32x16 o0, o1; float m, l; };
__device__ __forceinline__ void flash_init(FlashSt& s) { s.o0 = (f32x16){}; s.o1 = (f32x16){}; s.m = -INFINITY; s.l = 0.f; }

__device__ __forceinline__ void qk_block64(const LAS unsigned char* Kimg, const bf16x8 (&qr)[4], f32x16& p0, f32x16& p1, int klo, int khi, bool nomask, int r32, int hi) {
    const LAS unsigned char* kb = Kimg + hi * 1024 + r32 * 16;
    p0 = (f32x16){}; p1 = (f32x16){};
#pragma unroll
    for (int d0 = 0; d0 < 4; ++d0) { const bf16x8 b0 = *(const LAS bf16x8*)(kb + d0 * 2048), b1 = *(const LAS bf16x8*)(kb + d0 * 2048 + 512);
        p0 = MFMA32(b0, qr[d0], p0); p1 = MFMA32(b1, qr[d0], p1); }
    if (!nomask) {
#pragma unroll
        for (int r = 0; r < 16; ++r) { const int k0 = crow(r, hi); if (k0 < klo || k0 > khi) p0[r] = -INFINITY; if (k0 + 32 < klo || k0 + 32 > khi) p1[r] = -INFINITY; } }
}
__device__ __forceinline__ float rowmax32(const f32x16& p0, const f32x16& p1) {
    float a = fmaxf(p0[0], p1[0]);
#pragma unroll
    for (int r = 1; r < 16; ++r) a = fmaxf(a, fmaxf(p0[r], p1[r]));
    return fmaxf(a, xhalf(a));
}
__device__ __forceinline__ void flash_block64(const LAS unsigned char* Kimg, const LAS unsigned char* Vimg, const bf16x8 (&qr)[4], FlashSt& st, int klo, int khi, bool nomask, int lane) {
    const int r32 = lane & 31, hi = lane >> 5;
    f32x16 p0, p1; qk_block64(Kimg, qr, p0, p1, klo, khi, nomask, r32, hi);
    const float mx = rowmax32(p0, p1), mnew = fmaxf(st.m, mx), msafe = (mnew == -INFINITY) ? 0.f : mnew;
    const float alpha = fast_exp2(st.m - msafe); st.m = mnew;
    float sum = 0.f;
#pragma unroll
    for (int r = 0; r < 16; ++r) { p0[r] = fast_exp2(p0[r] - msafe); p1[r] = fast_exp2(p1[r] - msafe); sum += p0[r] + p1[r]; }
    sum += xhalf(sum); st.l = st.l * alpha + sum;
    st.o0 = st.o0 * alpha; st.o1 = st.o1 * alpha;
    u32x4 pw[4];
    pw[0] = (u32x4){cvtpk(p0[0], p0[1]), cvtpk(p0[2], p0[3]), cvtpk(p0[4], p0[5]), cvtpk(p0[6], p0[7])};
    pw[1] = (u32x4){cvtpk(p0[8], p0[9]), cvtpk(p0[10], p0[11]), cvtpk(p0[12], p0[13]), cvtpk(p0[14], p0[15])};
    pw[2] = (u32x4){cvtpk(p1[0], p1[1]), cvtpk(p1[2], p1[3]), cvtpk(p1[4], p1[5]), cvtpk(p1[6], p1[7])};
    pw[3] = (u32x4){cvtpk(p1[8], p1[9]), cvtpk(p1[10], p1[11]), cvtpk(p1[12], p1[13]), cvtpk(p1[14], p1[15])};
    const LAS unsigned char* vp = Vimg + ((lane >> 4) & 1) * 32 + (lane & 3) * 8 + (4 * hi + ((lane & 15) >> 2)) * 64;
#pragma unroll
    for (int ks = 0; ks < 4; ++ks) { const bf16x8 pa = __builtin_bit_cast(bf16x8, pw[ks]);
        { const s16x4 lo = vtr(vp + ks * 1024), hh = vtr(vp + ks * 1024 + 512); const bf16x8 vf = (bf16x8){lo[0], lo[1], lo[2], lo[3], hh[0], hh[1], hh[2], hh[3]}; st.o0 = MFMA32(vf, pa, st.o0); }
        { const s16x4 lo = vtr(vp + 4096 + ks * 1024), hh = vtr(vp + 4096 + ks * 1024 + 512); const bf16x8 vf = (bf16x8){lo[0], lo[1], lo[2], lo[3], hh[0], hh[1], hh[2], hh[3]}; st.o1 = MFMA32(vf, pa, st.o1); } }
}

#define MFMA16(a, b, c) __builtin_amdgcn_mfma_f32_16x16x32_bf16((a), (b), (c), 0, 0, 0)
constexpr int LDS_MISC = 139264;
constexpr int NSA_IMPLD = 257, NSA_WREG = 8 * 4 * NSA_IMPLD * 2;
constexpr int NSA_OACC = 0, NSA_QT = 65536, NSA_ST16 = 98304, NSA_LREF = 131072, NSA_LACC = 132096, NSA_SELM = 133120, NSA_TOKM = NSA_SELM + 2048, NSA_ILT = NSA_TOKM, NSA_MISC = NSA_TOKM + 2048;
static_assert(NSA_MISC + (8 + 256) * 4 <= LDS_MISC && 8 * NSA_WREG <= NSA_SELM && NSA_LACC + 1024 <= NSA_SELM && NSA_WREG % 16 == 0, "NSA LDS map");
constexpr float NSA_REFUP = 40.f;
struct QS { f32x4 o[4]; f32x4 lacc; float m, l; };
__device__ __forceinline__ void qs_init(QS& s) { s.o[0] = (f32x4){0.f, 0.f, 0.f, 0.f}; s.o[1] = s.o[0]; s.o[2] = s.o[0]; s.o[3] = s.o[0]; s.lacc = s.o[0]; s.m = -INFINITY; s.l = 0.f; }
__device__ __forceinline__ float x16(float v) { return __shfl_xor(v, 16); }
__device__ __forceinline__ void quad_scores(const LAS unsigned char* KF, const bf16x8 (&qf)[2], f32x4 (&sc)[4], int klo, int khi, bool nomask, int lane, float negm = 0.f) {
#pragma unroll
    for (int kt = 0; kt < 4; ++kt) { sc[kt] = (f32x4){negm, negm, negm, negm};
#pragma unroll
        for (int ks = 0; ks < 2; ++ks) { const bf16x8 kf = *(const LAS bf16x8*)(KF + ((kt * 2 + ks) * 64 + lane) * 16); sc[kt] = MFMA16(kf, qf[ks], sc[kt]); } }
    if (!nomask) { const int g4 = lane >> 4;
#pragma unroll
        for (int kt = 0; kt < 4; ++kt)
#pragma unroll
            for (int i = 0; i < 4; ++i) { const int key = 16 * kt + 4 * g4 + i; if (key < klo || key > khi) sc[kt][i] = -INFINITY; } }
}
constexpr float QTHR = 6.0f;
#ifndef NSA_QTHR_IMP
#define NSA_QTHR_IMP 6.0f
#endif
constexpr float QTHR_IMP = NSA_QTHR_IMP;
template <bool IMP, class VLoad>
__device__ __forceinline__ float quad_core(f32x4 (&sc)[4], QS& st, const VLoad& vload, float (&pa)[4], float (&pe)[4]) {
    float moved = 1.f;
    float mxl = fmaxf(fmaxf(sc[0][0], sc[0][1]), fmaxf(sc[0][2], sc[0][3]));
#pragma unroll
    for (int kt = 1; kt < 4; ++kt) mxl = fmaxf(mxl, fmaxf(fmaxf(sc[kt][0], sc[kt][1]), fmaxf(sc[kt][2], sc[kt][3])));
    if (__any(st.m == -INFINITY ? (mxl > -INFINITY) : (mxl > (IMP ? QTHR_IMP : QTHR)))) {
        float mx = fmaxf(mxl, x16(mxl)); mx = fmaxf(mx, xhalf(mx));
        const float mold = (st.m == -INFINITY) ? 0.f : st.m;
        const float dl = (mx == -INFINITY) ? 0.f : fmaxf(mx, (st.m == -INFINITY) ? mx : 0.f);
        const float alpha = (st.m == -INFINITY) ? 0.f : fast_exp2(-dl);
        if (IMP) moved = (st.m == -INFINITY) ? 1.f : alpha;
        if (mx != -INFINITY) st.m = mold + dl;
        st.lacc = st.lacc * alpha;
#pragma unroll
        for (int dt = 0; dt < 4; ++dt) st.o[dt] = st.o[dt] * alpha;
#pragma unroll
        for (int kt = 0; kt < 4; ++kt) sc[kt] = sc[kt] - dl;
    }
#pragma unroll
    for (int kt = 0; kt < 4; ++kt)
#pragma unroll
        for (int i = 0; i < 4; ++i) sc[kt][i] = fast_exp2(sc[kt][i]);
    if (IMP) {
#pragma unroll
        for (int kt = 0; kt < 4; ++kt) { pa[kt] = (sc[kt][0] + sc[kt][1]) + (sc[kt][2] + sc[kt][3]); pe[kt] = sc[kt][3]; } }
    bf16x8 pb[2];
    pb[0] = __builtin_bit_cast(bf16x8, pack8(sc[0], sc[1])); pb[1] = __builtin_bit_cast(bf16x8, pack8(sc[2], sc[3]));
    const bf16x8 ones = (bf16x8){0x3f80, 0x3f80, 0x3f80, 0x3f80, 0x3f80, 0x3f80, 0x3f80, 0x3f80};
    st.lacc = MFMA16(ones, pb[0], st.lacc); st.lacc = MFMA16(ones, pb[1], st.lacc);
#pragma unroll
    for (int dt = 0; dt < 4; ++dt)
#pragma unroll
        for (int s2 = 0; s2 < 2; ++s2) st.o[dt] = MFMA16(vload(dt * 2 + s2), pb[s2], st.o[dt]);
    return moved;
}
__device__ __forceinline__ void qs_finish(QS& st) { st.l = st.lacc[0]; }
__device__ __forceinline__ void quad_block(const LAS unsigned char* KF, const LAS unsigned char* VF, const bf16x8 (&qf)[2], QS& st, int klo, int khi, bool nomask, int lane) {
    f32x4 sc[4]; quad_scores(KF, qf, sc, klo, khi, nomask, lane, (st.m == -INFINITY) ? 0.f : -st.m);
    float pa_[4], pe_[4]; (void)quad_core<false>(sc, st, [&](int f) { return *(const LAS bf16x8*)(VF + (f * 64 + lane) * 16); }, pa_, pe_);
    __builtin_amdgcn_sched_barrier(0);
}
template <bool IMP>
__device__ __forceinline__ float quad_block_ri(const bf16x8 (&kfr)[8], const bf16x8 (&vfr)[8], const bf16x8 (&qf)[2], QS& st, int klo, int khi, int lane, float (&pa)[4], float (&pe)[4]) {
    f32x4 sc[4]; const float negm = (st.m == -INFINITY) ? 0.f : -st.m;
#pragma unroll
    for (int kt = 0; kt < 4; ++kt) { sc[kt] = (f32x4){negm, negm, negm, negm};
#pragma unroll
        for (int ks = 0; ks < 2; ++ks) sc[kt] = MFMA16(kfr[kt * 2 + ks], qf[ks], sc[kt]); }
    if (!__all(khi >= 63 && klo <= 0)) { const int g4 = lane >> 4;
#pragma unroll
        for (int kt = 0; kt < 4; ++kt)
#pragma unroll
            for (int i = 0; i < 4; ++i) { const int key = 16 * kt + 4 * g4 + i; if (key > khi || key < klo) sc[kt][i] = -INFINITY; } }
    const float mv = quad_core<IMP>(sc, st, [&](int f) { return vfr[f]; }, pa, pe);
    __builtin_amdgcn_sched_barrier(0);
    return mv;
}
__device__ __forceinline__ void quad_block_r(const bf16x8 (&kfr)[8], const bf16x8 (&vfr)[8], const bf16x8 (&qf)[2], QS& st, int klo, int khi, int lane) {
    float pa_[4], pe_[4]; (void)quad_block_ri<false>(kfr, vfr, qf, st, klo, khi, lane, pa_, pe_);
}

__device__ __forceinline__ void quad_fixed(const bf16x8 (&kfr)[8], const bf16x8 (&vfr)[8], const bf16x8 (&qf)[2], float negref, f32x4 (&o)[4], f32x4& lacc) {
    f32x4 sc[4];
#pragma unroll
    for (int kt = 0; kt < 4; ++kt) { sc[kt] = (f32x4){negref, negref, negref, negref};
#pragma unroll
        for (int ks = 0; ks < 2; ++ks) sc[kt] = MFMA16(kfr[kt * 2 + ks], qf[ks], sc[kt]); }
#pragma unroll
    for (int kt = 0; kt < 4; ++kt)
#pragma unroll
        for (int i = 0; i < 4; ++i) sc[kt][i] = fast_exp2(sc[kt][i]);
    bf16x8 pb[2];
    pb[0] = __builtin_bit_cast(bf16x8, pack8(sc[0], sc[1])); pb[1] = __builtin_bit_cast(bf16x8, pack8(sc[2], sc[3]));
    const bf16x8 ones = (bf16x8){0x3f80, 0x3f80, 0x3f80, 0x3f80, 0x3f80, 0x3f80, 0x3f80, 0x3f80};
    const f32x4 z = (f32x4){0.f, 0.f, 0.f, 0.f};
    lacc = MFMA16(ones, pb[0], z); lacc = MFMA16(ones, pb[1], lacc);
#pragma unroll
    for (int dt = 0; dt < 4; ++dt) { o[dt] = MFMA16(vfr[dt * 2], pb[0], z); o[dt] = MFMA16(vfr[dt * 2 + 1], pb[1], o[dt]); }
    __builtin_amdgcn_sched_barrier(0);
}
#define WAVE_LDS_FENCE() do { __builtin_amdgcn_wave_barrier(); asm volatile("s_waitcnt lgkmcnt(0)" ::: "memory"); } while (0)
__device__ __forceinline__ void load_frags(const unsigned char* img, int lane, bf16x8 (&fr)[8]) {
    const u32x4* p = (const u32x4*)img + lane;
#pragma unroll
    for (int f = 0; f < 8; ++f) fr[f] = __builtin_bit_cast(bf16x8, p[f * 64]);
}
__device__ __forceinline__ int nsa_lane(const Frame& F) { int l = F.lane; asm volatile("" : "+v"(l)); return l; }
__device__ __forceinline__ void nsa_unit(Frame& F, int b, int g, int c, int flags) {
    const int tid = F.tid, lane = F.lane, w = F.wave, q16 = lane & 15, g4 = lane >> 4;
    const int tq = q16 >> 2, hh = q16 & 3;
    const int tokA = 8 * w + tq, tokB = tokA + 4;
    const int tA = 64 * c + tokA, tB = tA + 4; const size_t mA = (size_t)b * SEQ + tA;
    const int bg = b * 2 + g;
    LAS unsigned char* lds = F.lds;
    LAS unsigned char* wreg = lds + w * NSA_WREG;
    LAS unsigned short* imph = (LAS unsigned short*)wreg; LAS float* ilt = (LAS float*)(lds + NSA_ILT) + w * 32;
    LAS unsigned* selm = (LAS unsigned*)(lds + NSA_SELM);
    LAS unsigned* misc = (LAS unsigned*)(lds + NSA_MISC);
    unsigned char* ws = F.ws;
    bf16x8 qfA[2], qfB[2];
    { const bf16_t* Q = (const bf16_t*)(ws + WS_QN) + mA * 512 + (g * 4 + hh) * 64 + 8 * g4;
      qfA[0] = *(const bf16x8*)Q; qfA[1] = *(const bf16x8*)(Q + 32); qfB[0] = *(const bf16x8*)(Q + 4 * 512); qfB[1] = *(const bf16x8*)(Q + 4 * 512 + 32); }
    bf16_t* SO = (flags & 0x10) ? (bf16_t*)F.out : (bf16_t*)((unsigned char*)F.out + 80 * MiB);
#define GATE_(QD, BR) (((const LAS float*)(lds + LDS_MISC + 2048))[(w * 32 + q16 + 16 * (QD)) * 3 + (BR)])
    QS sA, sB;
    { const int ln_ = nsa_lane(F), q_ = ln_ & 15;
      if (ln_ < 16) { const float* gp = (const float*)(ws + WS_GATE) + ((size_t)b * SEQ + 64 * c + 8 * w + (q_ >> 2)) * 24 + (g * 4 + (q_ & 3)) * 3;
        const float a0 = gp[0], a1 = gp[1], a2 = gp[2], b0 = gp[96], b1 = gp[97], b2 = gp[98];
        LAS float* gw = (LAS float*)(lds + LDS_MISC + 2048) + (w * 32 + q_) * 3; gw[0] = a0; gw[1] = a1; gw[2] = a2; gw[48] = b0; gw[49] = b1; gw[50] = b2; } }
#define OCV_(ROW, DT) ((LAS f32x4*)(oacc + (ROW) * 64 + (((4 * (DT) + g4) ^ ((ROW) & 15)) << 2)))

#define NMAXA_ ((64 * c + tokA >= 31) ? ((64 * c + tokA - 31) >> 4) : -1)
#define NMAXB_ ((64 * c + tokB >= 31) ? ((64 * c + tokB - 31) >> 4) : -1)
    const int ncb = (((64 * c + 8 * w + 7 - 31) >> 4) >> 6) + 1;
    const unsigned char* KCb = ws + WS_KC + (size_t)bg * 16 * 8192; const unsigned char* VCb = ws + WS_VC + (size_t)bg * 16 * 8192;
    qs_init(sA); qs_init(sB);
    const bool want_imp = (c >= 16) && !(flags & 0x40);
    if (!(flags & 0x80)) { const int lane = nsa_lane(F), q16 = lane & 15, g4 = lane >> 4, tq = q16 >> 2, hh = q16 & 3, tokA = 8 * w + tq, tokB = tokA + 4; (void)q16; (void)g4; (void)tq; (void)hh; (void)tokA; (void)tokB; const int nmaxA = NMAXA_, nmaxB = NMAXB_;
        float carA = 0.f, carB = 0.f;
#pragma nounroll
        for (int kb = 0; kb < ncb; ++kb) { bf16x8 kfr[8], vfr[8]; load_frags(KCb + (size_t)kb * 8192, lane, kfr); load_frags(VCb + (size_t)kb * 8192, lane, vfr);
            if (want_imp) {
#pragma unroll
                for (int qd = 0; qd < 2; ++qd) { float pa[4], pe[4];
                    const float al = quad_block_ri<true>(kfr, vfr, qd ? qfB : qfA, qd ? sB : sA, 0, (qd ? nmaxB : nmaxA) - 64 * kb, lane, pa, pe);
                    float car = (qd ? carB : carA) * al; LAS unsigned short* hrow = imph + ((tq + 4 * qd) * 4 + hh) * NSA_IMPLD + g4;
                    if (__any(al != 1.f)) {
#pragma nounroll
                        for (int e = 0; e < 4 * kb; ++e) { LAS unsigned short* hp = hrow + 4 * e; *hp = __builtin_bit_cast(unsigned short, (_Float16)((float)__builtin_bit_cast(_Float16, *hp) * al)); } }
                    hrow += 16 * kb;
#pragma unroll
                    for (int kt = 0; kt < 4; ++kt) { const float offer = (g4 == 3) ? (kt == 0 ? car : pe[kt - 1]) : pe[kt];
                        const float got = __shfl(offer, (lane - 16) & 63);
                        hrow[4 * kt] = __builtin_bit_cast(unsigned short, (_Float16)(pa[kt] + got)); }
                    if (qd) carB = pe[3]; else carA = pe[3]; }
            } else { quad_block_r(kfr, vfr, qfA, sA, 0, nmaxA - 64 * kb, lane); quad_block_r(kfr, vfr, qfB, sB, 0, nmaxB - 64 * kb, lane); } } }
    qs_finish(sA); qs_finish(sB);
    if (want_imp) { const int lane = nsa_lane(F), q16 = lane & 15, g4 = lane >> 4, tq = q16 >> 2, hh = q16 & 3, tokA = 8 * w + tq, tokB = tokA + 4; (void)q16; (void)g4; (void)tq; (void)hh; (void)tokA; (void)tokB;
      if (g4 == 0) { ilt[tq * 4 + hh] = sA.l > 0.f ? 1.0f / sA.l : 0.f; ilt[(tq + 4) * 4 + hh] = sB.l > 0.f ? 1.0f / sB.l : 0.f; }
        WAVE_LDS_FENCE();
        { const int tk = lane >> 3, s8 = lane & 7; unsigned kv[32];
          { const LAS unsigned short* h0 = imph + (tk * 4) * NSA_IMPLD; const f32x4 il4 = *(const LAS f32x4*)(ilt + tk * 4);
#pragma unroll
            for (int i = 0; i < 32; ++i) { const int j = s8 + 8 * i; unsigned key = 0u;
                if (j >= 1 && j <= c - 2) { const float a = ((float)__builtin_bit_cast(_Float16, h0[j]) * il4[0] + (float)__builtin_bit_cast(_Float16, h0[NSA_IMPLD + j]) * il4[1])
                                            + ((float)__builtin_bit_cast(_Float16, h0[2 * NSA_IMPLD + j]) * il4[2] + (float)__builtin_bit_cast(_Float16, h0[3 * NSA_IMPLD + j]) * il4[3]);
                    key = ((unsigned)__float_as_int(fmaxf(a, 0.f)) & 0xffffff00u) | (unsigned)(255 - j); }
                kv[i] = key; } }
          WAVE_LDS_FENCE();
          LAS unsigned* krow = (LAS unsigned*)wreg + tk * 264;
#pragma unroll
          for (int i = 0; i < 32; ++i) krow[s8 + 8 * i] = kv[i];
          selm[(8 * w) * 8 + lane] = 0u;
          WAVE_LDS_FENCE();
#pragma nounroll
          for (int it = 0; it < ((flags & 0x400) ? 1 : 13); ++it) {
              u32x4 r[8];
#pragma unroll
              for (int k = 0; k < 8; ++k) r[k] = *(const LAS u32x4*)(krow + 4 * (s8 + 8 * k));
              unsigned m = 0u;
#pragma unroll
              for (int k = 0; k < 8; ++k) { const unsigned a = r[k].x > r[k].y ? r[k].x : r[k].y, b2 = r[k].z > r[k].w ? r[k].z : r[k].w; const unsigned ab = a > b2 ? a : b2; m = m > ab ? m : ab; }
              const unsigned mine = m;
#define KEYMAX_(ctrl) do { const unsigned o_ = (unsigned)__builtin_amdgcn_update_dpp(0, (int)m, ctrl, 0xF, 0xF, true); m = o_ > m ? o_ : m; } while (0)
              KEYMAX_(0xB1); KEYMAX_(0x4E); KEYMAX_(0x141);
#undef KEYMAX_
              if (mine == m && m != 0u) { const int j = 255 - (int)(m & 255u); krow[j] = 0u;
                  (void)__hip_atomic_fetch_or(selm + (8 * w + tk) * 8 + (j >> 5), 1u << (j & 31), __ATOMIC_RELAXED, __HIP_MEMORY_SCOPE_WORKGROUP); }
          }
          WAVE_LDS_FENCE();
          if (lane < 8) { LAS unsigned* sm = selm + (8 * w + lane) * 8; sm[0] |= 1u; sm[(c - 1) >> 5] |= 1u << ((c - 1) & 31); sm[c >> 5] |= 1u << (c & 31); } }
    } else { const int lane = nsa_lane(F), q16 = lane & 15, g4 = lane >> 4, tq = q16 >> 2, hh = q16 & 3, tokA = 8 * w + tq, tokB = tokA + 4; (void)q16; (void)g4; (void)tq; (void)hh; (void)tokA; (void)tokB;
        if (lane < 8) {
#pragma unroll
            for (int i = 0; i < 8; ++i) selm[(8 * w + lane) * 8 + i] = (i == 0) ? ((2u << (c < 16 ? c : 15)) - 1u) : 0u; }
    }
    LAS float* oacc = (LAS float*)(lds + NSA_OACC); LAS float* lref = (LAS float*)(lds + NSA_LREF); LAS float* lac = (LAS float*)(lds + NSA_LACC);
    LAS unsigned char* qt = lds + NSA_QT; LAS u32x2* st16 = (LAS u32x2*)(lds + NSA_ST16) + w * 512; LAS unsigned* tokm = (LAS unsigned*)(lds + NSA_TOKM); LAS unsigned* tlock = misc + 8;
    const unsigned char* KSb = ws + WS_KS + (size_t)bg * 256 * 8192; const unsigned char* VSb = ws + WS_VS + (size_t)bg * 256 * 8192;
    __syncthreads();
    { const int lane = nsa_lane(F), q16 = lane & 15, g4 = lane >> 4, tq = q16 >> 2, hh = q16 & 3, tokA = 8 * w + tq, tokB = tokA + 4; (void)q16; (void)g4; (void)tq; (void)hh; (void)tokA; (void)tokB;
      const int rowA = tokA * 4 + hh, rowB = tokB * 4 + hh;
      { const float scA = sA.l > 0.f ? GATE_(0, 0) / sA.l : 0.f, scB = sB.l > 0.f ? GATE_(1, 0) / sB.l : 0.f;
#pragma unroll
        for (int dt = 0; dt < 4; ++dt) { const f32x4 a = sA.o[dt] * scA, b2 = sB.o[dt] * scB; u32x2 pa, pb2; pa.x = cvtpk(a[0], a[1]); pa.y = cvtpk(a[2], a[3]); pb2.x = cvtpk(b2[0], b2[1]); pb2.y = cvtpk(b2[2], b2[3]);
            st16[dt * 64 + lane] = pa; st16[(4 + dt) * 64 + lane] = pb2; } }
      *(LAS bf16x8*)(qt + rowA * 128 + 16 * g4) = qfA[0]; *(LAS bf16x8*)(qt + rowA * 128 + 64 + 16 * g4) = qfA[1];
      *(LAS bf16x8*)(qt + rowB * 128 + 16 * g4) = qfB[0]; *(LAS bf16x8*)(qt + rowB * 128 + 64 + 16 * g4) = qfB[1];
      { const unsigned sv = selm[lane * 8 + w]; unsigned mlo = 0u, mhi = 0u;
#pragma unroll
        for (int bit = 0; bit < 32; ++bit) { const unsigned long long bm = __ballot((sv >> bit) & 1u); if (lane == bit) { mlo = (unsigned)bm; mhi = (unsigned)(bm >> 32); } }
        if (lane < 32) { tokm[(32 * w + lane) * 2] = mlo; tokm[(32 * w + lane) * 2 + 1] = mhi; } }
      if (tid == 0) misc[1] = 0u;
      if (tid < 64) tlock[tid] = 0u;
      qs_init(sA); qs_init(sB);
      if (!(flags & 0x20)) { const int nf = c >= 2 ? 3 : c + 1;
#pragma nounroll
          for (int f = 0; f < nf; ++f) { const int j = (f == 0) ? 0 : (f == nf - 1 ? c : c - 1);
              bf16x8 kfr[8], vfr[8]; load_frags(KSb + (size_t)j * 8192, lane, kfr); load_frags(VSb + (size_t)j * 8192, lane, vfr);
              quad_block_r(kfr, vfr, qfA, sA, 0, (j == c) ? tokA : 63, lane); quad_block_r(kfr, vfr, qfB, sB, 0, (j == c) ? tokB : 63, lane); } }
      qs_finish(sA); qs_finish(sB);
      { const float dn = __builtin_amdgcn_exp2f(-NSA_REFUP);
#pragma unroll
        for (int dt = 0; dt < 4; ++dt)
            { *OCV_(rowA, dt) = sA.o[dt] * dn; *OCV_(rowB, dt) = sB.o[dt] * dn; }
        if (g4 == 0) { lref[rowA] = ((sA.m == -INFINITY) ? 0.f : sA.m) + NSA_REFUP; lref[rowB] = ((sB.m == -INFINITY) ? 0.f : sB.m) + NSA_REFUP; lac[rowA] = sA.l * dn; lac[rowB] = sB.l * dn; } }
    }
    __syncthreads();
    if (!(flags & 0x20)) { const int lane = nsa_lane(F), q16 = lane & 15, g4 = lane >> 4, tq = q16 >> 2, hh = q16 & 3, tokA = 8 * w + tq, tokB = tokA + 4; (void)q16; (void)g4; (void)tq; (void)hh; (void)tokA; (void)tokB;
#define NSA_TAKE(J, MLO, MHI) do { for (;;) { unsigned tk_ = 0u; if (lane == 0) tk_ = __hip_atomic_fetch_add(misc + 1, 1u, __ATOMIC_RELAXED, __HIP_MEMORY_SCOPE_WORKGROUP); \
            J = 1 + __builtin_amdgcn_readfirstlane((int)tk_); if (J > c - 2) { J = -1; break; } \
            MLO = (unsigned)__builtin_amdgcn_readfirstlane((int)tokm[2 * J]); MHI = (unsigned)__builtin_amdgcn_readfirstlane((int)tokm[2 * J + 1]); if ((MLO | MHI) != 0u) break; } } while (0)
#define NSA_PROC(kfr, vfr, MLO, MHI) do { unsigned long long tm = ((unsigned long long)(MHI) << 32) | (MLO); \
            _Pragma("nounroll") \
            while (tm) { int t4[4]; \
            _Pragma("unroll") \
                for (int k = 0; k < 4; ++k) { t4[k] = tm ? (int)__builtin_ctzll(tm) : -1; tm &= tm - 1ull; } \
                const int tsel = (tq == 0) ? t4[0] : (tq == 1) ? t4[1] : (tq == 2) ? t4[2] : t4[3]; \
                const bool valid = tsel >= 0; const int row = (valid ? tsel : 0) * 4 + hh; \
                bf16x8 qf[2]; qf[0] = *(const LAS bf16x8*)(qt + row * 128 + 16 * g4); qf[1] = *(const LAS bf16x8*)(qt + row * 128 + 64 + 16 * g4); \
                f32x4 o[4], la; quad_fixed(kfr, vfr, qf, -lref[row], o, la); \
 \
 \
                asm volatile("" : "+v"(o[0]), "+v"(o[1]), "+v"(o[2]), "+v"(o[3]), "+v"(la) :: "memory"); \
                const int tl = (lane == 0) ? t4[0] : (lane == 1) ? t4[1] : (lane == 2) ? t4[2] : t4[3]; const bool locker = lane < 4 && tl >= 0; \
                { unsigned old_ = 1u; if (locker) old_ = __hip_atomic_fetch_or(tlock + tl, 1u, __ATOMIC_RELAXED, __HIP_MEMORY_SCOPE_WORKGROUP); \
                  const bool got = locker && old_ == 0u; \
                  if (__ballot(got) != __ballot(locker)) { \
                      if (got) __hip_atomic_store(tlock + tl, 0u, __ATOMIC_RELAXED, __HIP_MEMORY_SCOPE_WORKGROUP); \
                      if (lane == 0) { \
            _Pragma("unroll") \
                          for (int k = 0; k < 4; ++k) if (t4[k] >= 0) { while (__hip_atomic_fetch_or(tlock + t4[k], 1u, __ATOMIC_RELAXED, __HIP_MEMORY_SCOPE_WORKGROUP) != 0u) __builtin_amdgcn_s_sleep(1); } } } } \
                asm volatile("" ::: "memory"); \
                if (valid) { f32x4 cv[4]; \
            _Pragma("unroll") \
                    for (int dt = 0; dt < 4; ++dt) cv[dt] = *OCV_(row, dt); \
                    float lv = 0.f; if (g4 == 0) lv = lac[row]; \
                    asm volatile("" ::: "memory"); \
            _Pragma("unroll") \
                    for (int dt = 0; dt < 4; ++dt) *OCV_(row, dt) = cv[dt] + o[dt]; \
                    if (g4 == 0) lac[row] = lv + la[0]; } \
                asm volatile("" ::: "memory"); \
                if (locker) __hip_atomic_store(tlock + tl, 0u, __ATOMIC_RELAXED, __HIP_MEMORY_SCOPE_WORKGROUP); \
            } \
        } while (0)
        bf16x8 kA[8], vA[8], kB[8], vB[8]; int j0 = -1, j1 = -1; unsigned m0l = 0u, m0h = 0u, m1l = 0u, m1h = 0u;
        NSA_TAKE(j0, m0l, m0h);
        if (j0 >= 0) { load_frags(KSb + (size_t)j0 * 8192, lane, kA); load_frags(VSb + (size_t)j0 * 8192, lane, vA); }
#pragma nounroll
        while (j0 >= 0) {
            NSA_TAKE(j1, m1l, m1h);
            if (j1 >= 0) { load_frags(KSb + (size_t)j1 * 8192, lane, kB); load_frags(VSb + (size_t)j1 * 8192, lane, vB); }
            NSA_PROC(kA, vA, m0l, m0h);
            if (j1 < 0) break;
            NSA_TAKE(j0, m0l, m0h);
            if (j0 >= 0) { load_frags(KSb + (size_t)j0 * 8192, lane, kA); load_frags(VSb + (size_t)j0 * 8192, lane, vA); }
            NSA_PROC(kB, vB, m1l, m1h);
        }
#undef NSA_TAKE
#undef NSA_PROC
    }
    __syncthreads();
    { const int lane = nsa_lane(F), q16 = lane & 15, g4 = lane >> 4, tq = q16 >> 2, hh = q16 & 3, tokA = 8 * w + tq, tokB = tokA + 4; (void)q16; (void)g4; (void)tq; (void)hh; (void)tokA; (void)tokB;
      const int rowA = tokA * 4 + hh, rowB = tokB * 4 + hh;
      const float lA = lac[rowA], lB = lac[rowB];
      const float scA = lA > 0.f ? GATE_(0, 1) / lA : 0.f, scB = lB > 0.f ? GATE_(1, 1) / lB : 0.f;
#pragma unroll
      for (int dt = 0; dt < 4; ++dt) { const u32x2 pa = st16[dt * 64 + lane], pb2 = st16[(4 + dt) * 64 + lane];
          const f32x4 ca = (f32x4){bflo(pa.x), bfhi(pa.x), bflo(pa.y), bfhi(pa.y)}, cb = (f32x4){bflo(pb2.x), bfhi(pb2.x), bflo(pb2.y), bfhi(pb2.y)};
          { LAS f32x4* pA_ = OCV_(rowA, dt); *pA_ = *pA_ * scA + ca; LAS f32x4* pB_ = OCV_(rowB, dt); *pB_ = *pB_ * scB + cb; } }
    }
    const int jw0 = c >= 8 ? c - 8 : 0;
    const unsigned char* KWb = ws + WS_KW + (size_t)bg * 256 * 8192; const unsigned char* VWb = ws + WS_VW + (size_t)bg * 256 * 8192;
    qs_init(sA); qs_init(sB);
    if (!(flags & 0x100)) { const int lane = nsa_lane(F), q16 = lane & 15, g4 = lane >> 4, tq = q16 >> 2, hh = q16 & 3, tokA = 8 * w + tq, tokB = tokA + 4; (void)q16; (void)g4; (void)tq; (void)hh; (void)tokA; (void)tokB;
#pragma nounroll
        for (int j = jw0; j <= c; ++j) { bf16x8 kfr[8], vfr[8]; load_frags(KWb + (size_t)j * 8192, lane, kfr); load_frags(VWb + (size_t)j * 8192, lane, vfr);
            int klA = 0, khA = 63, klB = 0, khB = 63;
            if (j == c) { khA = tokA; khB = tokB; } else if (j == c - 8) { klA = tokA + 1; klB = tokB + 1; }
            quad_block_r(kfr, vfr, qfA, sA, klA, khA, lane); quad_block_r(kfr, vfr, qfB, sB, klB, khB, lane); } }
    qs_finish(sA); qs_finish(sB);
    { const int lane = nsa_lane(F), q16 = lane & 15, g4 = lane >> 4, tq = q16 >> 2, hh = q16 & 3, tokA = 8 * w + tq, tokB = tokA + 4; (void)q16; (void)g4; (void)tq; (void)hh; (void)tokA; (void)tokB; const int rowA = tokA * 4 + hh, rowB = tokB * 4 + hh;
      const float scA = sA.l > 0.f ? GATE_(0, 2) / sA.l : 0.f, scB = sB.l > 0.f ? GATE_(1, 2) / sB.l : 0.f;
      LAS unsigned char* og = (LAS unsigned char*)st16;
#pragma unroll
      for (int dt = 0; dt < 4; ++dt) { const f32x4 a = *OCV_(rowA, dt) + sA.o[dt] * scA, bq2 = *OCV_(rowB, dt) + sB.o[dt] * scB;
          u32x2 wa; wa.x = cvtpk(a[0], a[1]); wa.y = cvtpk(a[2], a[3]); *(LAS u32x2*)(og + tq * 512 + hh * 128 + 32 * dt + 8 * g4) = wa;
          u32x2 wb; wb.x = cvtpk(bq2[0], bq2[1]); wb.y = cvtpk(bq2[2], bq2[3]); *(LAS u32x2*)(og + (tq + 4) * 512 + hh * 128 + 32 * dt + 8 * g4) = wb; }
      WAVE_LDS_FENCE();
      bf16_t* ob = SO + ((size_t)b * SEQ + 64 * c + 8 * w + (lane >> 5)) * 512 + g * 256 + 8 * (lane & 31);
#pragma unroll
      for (int it = 0; it < 4; ++it) *(u32x4*)(ob + (size_t)(2 * it) * 512) = *(const LAS u32x4*)(og + 1024 * it + 16 * lane);
      WAVE_LDS_FENCE(); }
#undef OCV_
#undef GATE_
#undef NMAXA_
#undef NMAXB_
    if (flags & 0x10) { __syncthreads(); return; }
    asm volatile("s_waitcnt vmcnt(0)" ::: "memory");
    __syncthreads();
    if (tid == 0) { __builtin_amdgcn_fence(__ATOMIC_RELEASE, "agent"); asm volatile("s_waitcnt vmcnt(0)" ::: "memory");
        const unsigned tk = __hip_atomic_fetch_add(F.ctl + CW_TILECNT + b * 256 + c, 1u, __ATOMIC_RELAXED, __HIP_MEMORY_SCOPE_AGENT);
        if (tk & 1u) { __builtin_amdgcn_fence(__ATOMIC_ACQUIRE, "agent"); asm volatile("s_waitcnt vmcnt(0)" ::: "memory"); }
        misc[0] = tk & 1u; }
    __syncthreads();
    if (misc[0] == 1u) { const float* gnorm = F.in[I_NSAG];
        const size_t mm0 = (size_t)b * SEQ + 64 * c + 8 * w;
        u32x4 rw[8];
#pragma unroll
        for (int tk = 0; tk < 8; ++tk) rw[tk] = *((const u32x4*)(SO + (mm0 + tk) * 512) + lane);
        const f32x4 g0 = ((const f32x4*)gnorm)[2 * lane], g1 = ((const f32x4*)gnorm)[2 * lane + 1];
#pragma unroll
        for (int tk = 0; tk < 8; ++tk) {
            const f32x4 v0 = (f32x4){bflo(rw[tk].x), bfhi(rw[tk].x), bflo(rw[tk].y), bfhi(rw[tk].y)}, v1 = (f32x4){bflo(rw[tk].z), bfhi(rw[tk].z), bflo(rw[tk].w), bfhi(rw[tk].w)};
            float ss = (v0[0] * v0[0] + v0[1] * v0[1]) + (v0[2] * v0[2] + v0[3] * v0[3]) + (v1[0] * v1[0] + v1[1] * v1[1]) + (v1[2] * v1[2] + v1[3] * v1[3]);
            ss = wave_sum(ss); const float rs = __builtin_amdgcn_rsqf(ss * (1.f / 512.f) + 1e-6f);
            bf16_t* MX = (bf16_t*)(ws + WS_RB) + (mm0 + tk) * 1024;
            ((u32x4*)MX)[lane] = pack8(v0 * rs * g0, v1 * rs * g1); } }
    __syncthreads();
}

__device__ __forceinline__ void cmp2_unit(Frame& F, int kv, int pm) {
    int lane = F.lane; asm volatile("" : "+v"(lane));
    const int w = F.wave, r32 = lane & 31, hi = lane >> 5;
    const bf16_t* W2 = (const bf16_t*)(F.ws + (kv ? WS_W2V : WS_W2K)); const bf16_t* HID = (const bf16_t*)(F.ws + WS_HID) + ((size_t)kv * 4096 + pm * 256 + w * 32 + r32) * 256;
    f32x16 a0 = {}, a1 = {};
#pragma unroll
    for (int ks = 0; ks < 16; ++ks) { const bf16x8 hb = *(const bf16x8*)(HID + 16 * ks + 8 * hi);
        const bf16x8 w0 = *(const bf16x8*)(W2 + (size_t)r32 * 256 + 16 * ks + 8 * hi), w1 = *(const bf16x8*)(W2 + (size_t)(32 + r32) * 256 + 16 * ks + 8 * hi);
        a0 = MFMA32(w0, hb, a0); a1 = MFMA32(w1, hb, a1); }
    const int bg = pm >> 2, i = (pm & 3) * 256 + w * 32 + r32, blk = i >> 6, key = i & 63;
    unsigned char* img = F.ws + (kv ? WS_VC : WS_KC) + (size_t)(bg * 16 + blk) * 8192;
    if (i == 1023) { a0 = (f32x16){}; a1 = (f32x16){}; }
#pragma unroll
    for (int k = 0; k < 4; ++k) { u32x2 o0, o1; o0.x = cvtpk(a0[4 * k], a0[4 * k + 1]); o0.y = cvtpk(a0[4 * k + 2], a0[4 * k + 3]); o1.x = cvtpk(a1[4 * k], a1[4 * k + 1]); o1.y = cvtpk(a1[4 * k + 2], a1[4 * k + 3]);
        const int d0 = 8 * k + 4 * hi, d1 = 32 + d0;
        if (kv == 0) { *(u32x2*)(img + kf_off(key, d0)) = o0; *(u32x2*)(img + kf_off(key, d1)) = o1; }
        else { *(bf16_t*)(img + vf_off(key, d0)) = (bf16_t)(o0.x & 0xffffu); *(bf16_t*)(img + vf_off(key, d0 + 1)) = (bf16_t)(o0.x >> 16); *(bf16_t*)(img + vf_off(key, d0 + 2)) = (bf16_t)(o0.y & 0xffffu); *(bf16_t*)(img + vf_off(key, d0 + 3)) = (bf16_t)(o0.y >> 16);
               *(bf16_t*)(img + vf_off(key, d1)) = (bf16_t)(o1.x & 0xffffu); *(bf16_t*)(img + vf_off(key, d1 + 1)) = (bf16_t)(o1.x >> 16); *(bf16_t*)(img + vf_off(key, d1 + 2)) = (bf16_t)(o1.y & 0xffffu); *(bf16_t*)(img + vf_off(key, d1 + 3)) = (bf16_t)(o1.y >> 16); } }
}

__device__ __forceinline__ void xattn_phase(Frame& F, int ul0, int ul1, int ul2, int ul3, int nun, size_t qo_off) {
    const int w = F.wave, tg = w >> 1, dh = w & 1;
    LAS unsigned char* lds = F.lds;
    const int nsteps = 4 * nun;
    if (nsteps <= 0) return;
#define XA_UNIT(G_) ((G_) == 0 ? ul0 : (G_) == 1 ? ul1 : (G_) == 2 ? ul2 : ul3)
#define XA_SRC(S, I) ({ const int u_ = XA_UNIT((S) >> 2), bh_ = u_ >> 7, kb_ = (S) & 3; \
        (const u32x4*)(F.ws + ((I) < 4 ? WS_MEMK : WS_MEMV) + ((size_t)bh_ * 4 + kb_) * 32768) + F.tid + 512 * ((I) & 3); })
    const int wu = __builtin_amdgcn_readfirstlane(w);
#define XA_DMA(S, BUFI) do { _Pragma("unroll") for (int i_ = 0; i_ < 8; ++i_) \
        __builtin_amdgcn_global_load_lds((const unsigned*)XA_SRC(S, i_), (LAS unsigned*)(lds + (BUFI) * 65536 + (i_ >> 2) * 32768 + (wu * 64 + 512 * (i_ & 3)) * 16), 16, 0, 0); } while (0)
    XA_DMA(0, 0);
    asm volatile("s_waitcnt vmcnt(0)" ::: "memory");
    __syncthreads();
    bf16x8 qr[16]; f32x16 o[4]; float mrun = -INFINITY, lrun = 0.f; bf16_t* QO = nullptr;
    LAS float* xm = (LAS float*)(lds + 131072);
    for (int s = 0; s < nsteps; ++s) {
        int tid = F.tid; asm volatile("" : "+v"(tid));
        const int lane = tid & 63, r32 = lane & 31, hi = lane >> 5;
        const int u = XA_UNIT(s >> 2), tile = u & 127, bh = u >> 7, kb = s & 3;
        if (kb == 0) { const size_t m = (size_t)(bh >> 2) * SEQ + 128 * tile + 32 * tg + r32; QO = (bf16_t*)(F.ws + qo_off) + m * 1024 + (bh & 3) * 256;
#pragma unroll
            for (int d0 = 0; d0 < 16; ++d0) qr[d0] = *(const bf16x8*)(QO + 16 * d0 + 8 * hi);
            o[0] = (f32x16){}; o[1] = (f32x16){}; o[2] = (f32x16){}; o[3] = (f32x16){}; mrun = -INFINITY; lrun = 0.f; }
        const bool more = (s + 1 < nsteps);
        LAS unsigned char* buf = lds + (s & 1) * 65536;
        f32x16 p0 = {};
        const LAS unsigned char* kp = buf + hi * 1024 + r32 * 16 + 512 * dh;
#pragma unroll
        for (int d0 = 0; d0 < 16; ++d0) p0 = MFMA32(*(const LAS bf16x8*)(kp + d0 * 2048), qr[d0], p0);
        float mxl = p0[0];
#pragma unroll
        for (int r2 = 1; r2 < 16; ++r2) mxl = fmaxf(mxl, p0[r2]);
        mxl = fmaxf(mxl, xhalf(mxl));
        if (hi == 0) xm[w * 32 + r32] = mxl;
        __syncthreads();
        const float mx = fmaxf(mxl, xm[(w ^ 1) * 32 + r32]);
        if (__any(mx > mrun + QTHR)) { const float mnew = fmaxf(mrun, mx), alpha = fast_exp2(mrun - mnew); mrun = mnew; lrun = lrun * alpha;
#pragma unroll
            for (int i = 0; i < 4; ++i) o[i] = o[i] * alpha; }
        float sum = 0.f;
#pragma unroll
        for (int r2 = 0; r2 < 16; ++r2) { p0[r2] = fast_exp2(p0[r2] - mrun); sum += p0[r2]; }
        sum += xhalf(sum); lrun += sum;
        u32x4 pm[2];
        pm[0] = (u32x4){cvtpk(p0[0], p0[1]), cvtpk(p0[2], p0[3]), cvtpk(p0[4], p0[5]), cvtpk(p0[6], p0[7])};
        pm[1] = (u32x4){cvtpk(p0[8], p0[9]), cvtpk(p0[10], p0[11]), cvtpk(p0[12], p0[13]), cvtpk(p0[14], p0[15])};
        { LAS u32x4* px = (LAS u32x4*)(buf + w * 2048) + lane * 2; px[0] = pm[0]; px[1] = pm[1]; }
        if (kb == 3 && hi == 0) xm[256 + w * 32 + r32] = lrun;
        if (more) XA_DMA(s + 1, (s + 1) & 1);
        __syncthreads();
        u32x4 po[2];
        { const LAS u32x4* px = (const LAS u32x4*)(buf + (w ^ 1) * 2048) + lane * 2; po[0] = px[0]; po[1] = px[1]; }
        u32x4 pw[4];
        pw[0] = dh ? po[0] : pm[0]; pw[1] = dh ? po[1] : pm[1]; pw[2] = dh ? pm[0] : po[0]; pw[3] = dh ? pm[1] : po[1];
        const LAS unsigned char* vp = buf + 32768 + dh * 16384 + ((lane >> 4) & 1) * 32 + (lane & 3) * 8 + (4 * hi + ((lane & 15) >> 2)) * 64;
#pragma unroll
        for (int ks = 0; ks < 4; ++ks) { const bf16x8 pa = __builtin_bit_cast(bf16x8, pw[ks]);
#pragma unroll
            for (int i = 0; i < 4; ++i) { const s16x4 lo = vtr(vp + i * 4096 + ks * 1024), hh2 = vtr(vp + i * 4096 + ks * 1024 + 512);
                const bf16x8 vf = (bf16x8){lo[0], lo[1], lo[2], lo[3], hh2[0], hh2[1], hh2[2], hh2[3]}; o[i] = MFMA32(vf, pa, o[i]); } }
        if (kb == 3) lrun += xm[256 + (w ^ 1) * 32 + r32];
        asm volatile("s_waitcnt vmcnt(0)" ::: "memory");
        __syncthreads();
        if (kb == 3) { const float inv = 1.0f / lrun;
            LAS unsigned char* stg = buf + w * 8192;
#pragma unroll
            for (int i = 0; i < 4; ++i)
#pragma unroll
                for (int k = 0; k < 4; ++k) { u32x2 ov; ov.x = cvtpk(o[i][4 * k] * inv, o[i][4 * k + 1] * inv); ov.y = cvtpk(o[i][4 * k + 2] * inv, o[i][4 * k + 3] * inv);
                    *(LAS u32x2*)(stg + r32 * 256 + (((4 * i + k) ^ (r32 & 15)) << 4) + 8 * hi) = ov; }
            WAVE_LDS_FENCE();
            bf16_t* Ob = (bf16_t*)(F.ws + qo_off) + ((size_t)(bh >> 2) * SEQ + 128 * tile + 32 * tg) * 1024 + (bh & 3) * 256 + 128 * dh + 8 * (lane & 15);
#pragma unroll
            for (int it = 0; it < 8; ++it) { const int row = 4 * it + (lane >> 4);
                const u32x4 v = *(const LAS u32x4*)(stg + row * 256 + (((lane & 15) ^ (row & 15)) << 4));
                *(u32x4*)(Ob + (size_t)row * 1024) = v; }
            WAVE_LDS_FENCE(); }
    }
#undef XA_SRC
#undef XA_DMA
#undef XA_UNIT
}
__device__ __forceinline__ void router_phase(Frame& F, LAS unsigned* rl, LAS unsigned* lcnt, bool skip) {
    const int lane = F.lane, w = F.wave, r16 = lane & 15, q4 = lane >> 4;
    LAS float* gb = (LAS float*)F.lds; LAS float* lg = (LAS float*)(F.lds + 8192 + w * 3072);
    LAS unsigned char* wimg = F.lds + 32768;
    constexpr int WQB = 96 * 512;
    const int wu = __builtin_amdgcn_readfirstlane(w);
    const int gwv = F.bid * NWAVES + w, NGWv = F.G * NWAVES, ngr = skip ? 0 : NTOK / 16;
    unsigned wsrc[6];
#pragma unroll
    for (int i = 0; i < 6; ++i) { const int row = 2 * (w + 8 * i) + (lane >> 5), pch = lane & 31, part = row >= 48 ? 1 : 0;
        wsrc[i] = (unsigned)(part * (int)(WS_WRL - WS_WRH) + ((row - 48 * part) * 1024 + 8 * (pch ^ (row & 15))) * 2); }
#define RT_STAGE(Q, B) do { _Pragma("unroll") for (int i_ = 0; i_ < 6; ++i_) \
        __builtin_amdgcn_global_load_lds((const unsigned*)(F.ws + WS_WRH + wsrc[i_] + 512 * (Q)), (LAS unsigned*)(wimg + (B) * WQB + (wu + 8 * i_) * 1024), 16, 0, 0); } while (0)
    int kslot = 0;
    for (int tg0 = 0; tg0 < ngr; tg0 += NGWv, ++kslot) {
        const int tg = tg0 + gwv; const bool act = tg < ngr;
        const int m = (act ? tg : 0) * 16 + r16;
        const f32x2 st = ld_stat4((const float*)(F.ws + WS_STAT2), (size_t)m);
        const u32x4* xp = (const u32x4*)((const bf16_t*)(F.ws + WS_RA) + (size_t)m * 1024 + 8 * q4);
        u32x4 xr[32];
#pragma unroll
        for (int i = 0; i < 32; ++i) xr[i] = xp[4 * i];
        __syncthreads();
        RT_STAGE(0, 0);
        const float mean = st[0] * (1.f / 1024.f), rstd = 1.0f / sqrtf(fmaxf(st[1] * (1.f / 1024.f) - mean * mean, 0.f) + 1e-5f);
        f32x4 acc[3]; acc[0] = (f32x4){0.f, 0.f, 0.f, 0.f}; acc[1] = acc[0]; acc[2] = acc[0];
#pragma unroll
        for (int h = 0; h < 4; ++h) {
            asm volatile("s_waitcnt vmcnt(0)" ::: "memory");
            __syncthreads();
            if (h < 3) RT_STAGE(h + 1, (h + 1) & 1);
            const LAS unsigned char* wf = wimg + (h & 1) * WQB + r16 * 512;
#pragma unroll
            for (int u = 0; u < 8; ++u) { const int s = 8 * h + u;
                const bf16x8 ah = __builtin_bit_cast(bf16x8, xr[s]);
                const int co = 16 * ((4 * u + q4) ^ r16);
#pragma unroll
                for (int ct = 0; ct < 3; ++ct) { const bf16x8 bh = *(const LAS bf16x8*)(wf + (16 * ct) * 512 + co), bl = *(const LAS bf16x8*)(wf + (48 + 16 * ct) * 512 + co);
                    acc[ct] = MFMA16(ah, bh, acc[ct]); acc[ct] = MFMA16(ah, bl, acc[ct]); }
            }
        }
#pragma unroll
        for (int ct = 0; ct < 3; ++ct)
#pragma unroll
            for (int i = 0; i < 4; ++i) lg[(4 * q4 + i) * 48 + 16 * ct + r16] = acc[ct][i];
        WAVE_LDS_FENCE();
        if (act && lane < 16) { const LAS float* L = lg + lane * 48; const int t = tg * 16 + lane; const float* rcs = (const float*)(F.ws + WS_RCS); const float* rcb = (const float*)(F.ws + WS_RCB);
            float gl[4];
#pragma unroll
            for (int i = 0; i < 4; ++i) gl[i] = rstd * (L[i] - mean * rcs[i]) + rcb[i];
            int gi = 0; float gm = gl[0];
#pragma unroll
            for (int i = 1; i < 4; ++i) if (gl[i] > gm) { gm = gl[i]; gi = i; }
            float gden = 0.f;
#pragma unroll
            for (int i = 0; i < 4; ++i) gden += __expf(gl[i] - gm);
            const float gw = 1.0f / gden;
            float el[8];
#pragma unroll
            for (int e = 0; e < 8; ++e) el[e] = rstd * (L[4 + gi * 8 + e] - mean * rcs[4 + gi * 8 + e]) + rcb[4 + gi * 8 + e];
            int i0 = 0; float m0 = el[0];
#pragma unroll
            for (int i = 1; i < 8; ++i) if (el[i] > m0) { m0 = el[i]; i0 = i; }
            int i1 = -1; float m1 = -INFINITY;
#pragma unroll
            for (int i = 0; i < 8; ++i) if (i != i0 && el[i] > m1) { m1 = el[i]; i1 = i; }
            const float e1 = __expf(m1 - m0), w0 = 1.0f / (1.0f + e1), w1 = e1 * w0;
            const unsigned ea = (unsigned)(gi * 8 + i0), eb = (unsigned)(gi * 8 + i1);
            LAS unsigned* r = rl + 4 * (w * 24 + kslot * 16 + lane);
            r[0] = ea; r[1] = eb;
            r[2] = __hip_atomic_fetch_add(lcnt + ea, 1u, __ATOMIC_RELAXED, __HIP_MEMORY_SCOPE_WORKGROUP);
            r[3] = __hip_atomic_fetch_add(lcnt + eb, 1u, __ATOMIC_RELAXED, __HIP_MEMORY_SCOPE_WORKGROUP);
            *(f32x2*)(F.ws + WS_ROUTEW + (size_t)t * 8) = (f32x2){gw * w0, gw * w1}; }
        WAVE_LDS_FENCE();
    }
}

#undef RT_STAGE
constexpr int MOE_LDS = LDS_MISC + 1024;
__device__ __forceinline__ void moe_offsets(Frame& F) {
    LAS unsigned* off = (LAS unsigned*)(F.lds + MOE_LDS); LAS unsigned* tmp = off + 64;
    LAS unsigned* xoff = off + 448; LAS unsigned* xc = off + 704;
    if (F.tid < 256) xc[F.tid] = __hip_atomic_load(F.ctl + CW_ECNT + 16 * F.tid, __ATOMIC_RELAXED, __HIP_MEMORY_SCOPE_AGENT);
    __syncthreads();
    if (F.tid < 32) { unsigned s = 0;
#pragma unroll
        for (int x = 0; x < 8; ++x) { xoff[x * 32 + F.tid] = s; s += xc[x * 32 + F.tid]; }
        tmp[F.tid] = (s + 255u) & ~255u; }
    __syncthreads();
    if (F.tid == 0) { unsigned s = 0;
#pragma unroll
        for (int e = 0; e < 32; ++e) { off[e] = s; s += tmp[e]; }
        off[32] = s; }
    __syncthreads();
    if (F.tid < 288) { const unsigned slot0 = (unsigned)F.tid << 8; int e = 0;
#pragma unroll
        for (int k = 1; k < 32; ++k) e = (off[k] <= slot0) ? k : e;
        off[128 + F.tid] = (unsigned)e; }
    __syncthreads();
}
struct MoeOrder {
    const char* A; const char* W; size_t atile, wexp, wtile; const LAS unsigned* off; int G, c;
    __device__ __forceinline__ bool next(int i, pg8::Unit& u) const {
        const unsigned L = (unsigned)(i * G + c), ntile = off[32] >> 8; if (L >= ntile * 4u) return false;
        const unsigned mt = L >> 2, pn = L & 3u; const int e = (int)off[128 + mt];
        u.pm = (int)mt; u.pn = (int)pn; u.aux = e; u.a = A + (size_t)mt * atile; u.b = W + (size_t)e * wexp + (size_t)pn * wtile; return true;
    }
};
#define XB_TMO      128
#define XB_XCNT(j)  (256  + 64 * (j))
#define XB_XSUB(j)  (1280 + 64 * (j))
#define XB_XGEN(j)  (2304 + 64 * (j))
#define XB_TOP      3328
#define XB_TOPGEN   3392
#define XCD_BAR_WORDS 4096
#define XB_SPIN_CAP (1u << 22)
__device__ __forceinline__ unsigned xb_ld(unsigned* p)              { return __hip_atomic_load(p, __ATOMIC_RELAXED, __HIP_MEMORY_SCOPE_AGENT); }
__device__ __forceinline__ unsigned xb_add(unsigned* p, unsigned v) { return __hip_atomic_fetch_add(p, v, __ATOMIC_RELAXED, __HIP_MEMORY_SCOPE_AGENT); }
__device__ __forceinline__ unsigned xb_xcc_id() { return (unsigned)__builtin_amdgcn_s_getreg((3 << 11) | 20) & 0xFu; }
#define XB_SPIN(cond, bar) do { unsigned _sp = 0; while (cond) { __builtin_amdgcn_s_sleep(1); \
    if ((++_sp & 255u) == 0u) { if (xb_ld(&(bar)[XB_TMO])) break; if (_sp > XB_SPIN_CAP) { atomicAdd(&(bar)[XB_TMO], 1u); break; } } } } while (0)
struct XcdBarrier { unsigned* bar; unsigned x; volatile LAS unsigned* st; };
__device__ __forceinline__ XcdBarrier xcd_barrier_post(unsigned* bar, volatile LAS unsigned* st) {
    XcdBarrier b; b.bar = bar; b.x = xb_xcc_id(); b.st = st;
    if (threadIdx.x == 0) (void)xb_add(&bar[XB_XCNT(b.x)], 1u);
    return b;
}
__device__ __forceinline__ void xcd_barrier_complete(unsigned* bar, unsigned x, unsigned& nloc, unsigned& nx) {
    const unsigned G = gridDim.x * gridDim.y * gridDim.z;
    unsigned sum, cnt, mine, sp = 0u;
    for (;;) {
        sum = 0u; cnt = 0u; mine = 0u;
#pragma unroll
        for (unsigned j = 0; j < 16; ++j) { const unsigned c = xb_ld(&bar[XB_XCNT(j)]); sum += c; cnt += (c > 0u) ? 1u : 0u; mine = (j == x) ? c : mine; }
        if (sum == G) break;
        __builtin_amdgcn_s_sleep(1);
        if ((++sp & 255u) == 0u) { if (xb_ld(&bar[XB_TMO])) break; if (sp > XB_SPIN_CAP) { atomicAdd(&bar[XB_TMO], 1u); break; } }
    }
    nloc = mine > 0u ? mine : 1u; nx = cnt > 0u ? cnt : 1u;
}
__device__ __forceinline__ void xcd_barrier(const XcdBarrier& b) {
    asm volatile("s_waitcnt vmcnt(0)" ::: "memory");
    __syncthreads();
    if (threadIdx.x == 0) {
        unsigned* bar = b.bar;
        __builtin_amdgcn_s_waitcnt(0);
        unsigned nloc = b.st[0], nx = b.st[1];
        if (nloc == 0u) { xcd_barrier_complete(bar, b.x, nloc, nx); b.st[0] = nloc; b.st[1] = nx; }
        const unsigned old = xb_add(&bar[XB_XSUB(b.x)], 1u);
        const unsigned gen = old / nloc;
        if (old + 1u == (gen + 1u) * nloc) {
            __builtin_amdgcn_fence(__ATOMIC_RELEASE, "agent");
            asm volatile("s_waitcnt vmcnt(0)" ::: "memory");
            const unsigned og = xb_add(&bar[XB_TOP], 1u);
            const unsigned tg = og / nx;
            if (og + 1u == (tg + 1u) * nx) xb_add(&bar[XB_TOPGEN], 1u);
            else XB_SPIN(xb_ld(&bar[XB_TOPGEN]) == tg, bar);
            __builtin_amdgcn_fence(__ATOMIC_ACQUIRE, "agent");
            xb_add(&bar[XB_XGEN(b.x)], 1u);
            asm volatile("s_waitcnt vmcnt(0)" ::: "memory");
        } else {
            XB_SPIN(xb_ld(&bar[XB_XGEN(b.x)]) == gen, bar);
            __builtin_amdgcn_fence(__ATOMIC_ACQUIRE, "agent");
            asm volatile("s_waitcnt vmcnt(0)" ::: "memory");
        }
    }
    __syncthreads();
}

#ifndef REP_P4
#define REP_P4 1
#endif
#ifndef NSA_CALL
#define NSA_CALL nsa_unit(F, bg >> 1, bg & 1, c, args.rep);
#endif
#ifndef HGC_CALL
#define HGC_CALL ;
#endif
struct OneUnit { pg8::Unit u; __device__ __forceinline__ bool next(int i, pg8::Unit& o) const { if (i > 0) return false; o = u; return true; } };

__device__ __forceinline__ int queue_next(Frame& F, int cw) {
    LAS unsigned* mw = (LAS unsigned*)(F.lds + LDS_MISC);
    __syncthreads();
    if (F.tid == 0) mw[0] = __hip_atomic_fetch_add(F.ctl + cw, 1u, __ATOMIC_RELAXED, __HIP_MEMORY_SCOPE_AGENT);
    __syncthreads();
    return (int)mw[0];
}
__device__ __forceinline__ void queue_prime(Frame& F, int cw, unsigned& pend) { pend = 0u; if (F.tid == 0) pend = __hip_atomic_fetch_add(F.ctl + cw, 1u, __ATOMIC_RELAXED, __HIP_MEMORY_SCOPE_AGENT); }
__device__ __forceinline__ int queue_next2(Frame& F, int cw, unsigned& pend) {
    LAS unsigned* mw = (LAS unsigned*)(F.lds + LDS_MISC);
    __syncthreads();
    if (F.tid == 0) { mw[0] = pend; pend = __hip_atomic_fetch_add(F.ctl + cw, 1u, __ATOMIC_RELAXED, __HIP_MEMORY_SCOPE_AGENT); }
    __syncthreads();
    return (int)mw[0];
}
__device__ __forceinline__ void ln_vals(f32x4 (&v)[4], const float* g, const float* b, int lane) {
    float s = 0.f;
#pragma unroll
    for (int j = 0; j < 4; ++j) s += (v[j][0] + v[j][1]) + (v[j][2] + v[j][3]);
    const float mean = wave_sum(s) * (1.f / 1024.f); float s2 = 0.f;
#pragma unroll
    for (int j = 0; j < 4; ++j) { v[j] = v[j] - mean; s2 += (v[j][0] * v[j][0] + v[j][1] * v[j][1]) + (v[j][2] * v[j][2] + v[j][3] * v[j][3]); }
    const float rstd = 1.0f / sqrtf(wave_sum(s2) * (1.f / 1024.f) + 1e-5f);
#pragma unroll
    for (int j = 0; j < 4; ++j) { const f32x4 gg = ((const f32x4*)g)[lane + 64 * j], bb = ((const f32x4*)b)[lane + 64 * j]; v[j] = v[j] * rstd * gg + bb; }
}

constexpr int N_PHASES_ = 15;
__device__ __forceinline__ void ln2_row(Frame& F, int m, f32x4 (&y)[4]) {
    float mean, rstd; row_stats((const float*)(F.ws + WS_STAT2), (size_t)m, mean, rstd);
    const u32x2* xr = (const u32x2*)((const bf16_t*)(F.ws + WS_RA) + (size_t)m * 1024) + F.lane; const f32x4* g = (const f32x4*)F.in[I_LN2G] + F.lane; const f32x4* b = (const f32x4*)F.in[I_LN2B] + F.lane;
#pragma unroll
    for (int j = 0; j < 4; ++j) { const u32x2 w = xr[64 * j]; y[j] = ((f32x4){bflo(w.x), bfhi(w.x), bflo(w.y), bfhi(w.y)} - mean) * rstd * g[64 * j] + b[64 * j]; }
}
__device__ __forceinline__ void wg_signal(Frame& F, int cw) {
    asm volatile("s_waitcnt vmcnt(0)" ::: "memory"); __syncthreads();
    if (F.tid == 0) { __builtin_amdgcn_fence(__ATOMIC_RELEASE, "agent"); asm volatile("s_waitcnt vmcnt(0)" ::: "memory");
        (void)__hip_atomic_fetch_add(F.ctl + cw, 1u, __ATOMIC_RELAXED, __HIP_MEMORY_SCOPE_AGENT); }
}
__device__ __forceinline__ void wg_wait(Frame& F, int cw, unsigned target) {
    if (F.tid == 0) { while (__hip_atomic_load(F.ctl + cw, __ATOMIC_RELAXED, __HIP_MEMORY_SCOPE_AGENT) < target) __builtin_amdgcn_s_sleep(8);
        __builtin_amdgcn_fence(__ATOMIC_ACQUIRE, "agent"); }
    __syncthreads();
}
__global__ void __launch_bounds__(NTHR, 2) mk_fwd(Args args) {
    extern __shared__ __attribute__((aligned(16))) unsigned char lds_raw[];
    cg::grid_group grid = cg::this_grid();
    Frame F;
    F.lds = (LAS unsigned char*)lds_raw; F.ws = args.ws; F.ctl = (unsigned*)(args.ws + WS_CTL); F.in = args.in; F.out = args.out;
    F.tid = threadIdx.x; F.lane = F.tid & 63; F.wave = __builtin_amdgcn_readfirstlane(F.tid >> 6); F.G = gridDim.x; F.bid = blockIdx.x;
    unsigned char* ws = args.ws;
    const int lo = args.ph_lo, hi = args.ph_hi;
    if (lo == -12345) grid.sync();
    if (F.tid < 4) ((LAS unsigned*)(F.lds + LDS_MISC))[16 + F.tid] = 0u;
    __syncthreads();
    const XcdBarrier xbar = xcd_barrier_post(F.ctl + CW_BAR + args.li * XCD_BAR_WORDS, (volatile LAS unsigned*)(F.lds + LDS_MISC) + 16);
    const int gw = F.bid * NWAVES + F.wave, NGW = F.G * NWAVES;
#ifndef PH_MASK
#define PH_MASK 0x7fff
#endif
#define IN(k) (((PH_MASK >> (k)) & 1) && lo <= (k) && (k) < hi)
#define SEAM(k) do { if (IN(k) && (IN((k) + 1) || ((k) == 5 && IN(7)) || ((k) == 7 && IN(9)))) xcd_barrier(xbar); } while (0)

    if (IN(0)) { p0_prep(F); } SEAM(0);
    if (IN(1)) {
        pg8::GridOrder S{(const char*)(ws + WS_RA), (const char*)(ws + WS_WIN), (size_t)256 * 1024 * 2, (size_t)256 * 1024 * 2, 128, 14, 128 * 14, F.G, F.bid};
        EpiInproj E{ws, (const float*)(ws + WS_LB), ((args.rep & 0x200) ? 1 : 0) | ((args.rep & 0x4000) ? 2 : 0)};
        pg8::gemm_phase(F.lds, 1024, 1024, 1024, S, E);
    } SEAM(1);
    if (IN(2)) {
        for (int u = F.bid; u < ((args.rep & 0x4000) ? 0 : 48); u += F.G) {
            if (u < 32) { const int kv = u >> 4, pm = u & 15; OneUnit S; S.u.a = (const char*)(ws + (kv ? WS_VCIN : WS_KCIN)) + (size_t)pm * 256 * 1024 * 2; S.u.b = (const char*)(ws + (kv ? WS_W1V : WS_W1K)); S.u.pm = pm; S.u.pn = 0; S.u.aux = kv;
                EpiCmp1 E{ws}; pg8::gemm_phase(F.lds, 2048, 1024, 2048, S, E);
                  asm volatile("s_waitcnt vmcnt(0)" ::: "memory"); __syncthreads(); if (F.tid == 0) __builtin_amdgcn_fence(__ATOMIC_SEQ_CST, "agent"); __syncthreads();
                  cmp2_unit(F, kv, pm); }
            else { const int idx = u - 32, pm = idx >> 3, pn = idx & 7; OneUnit S; S.u.a = (const char*)(ws + WS_MEMB) + (size_t)pm * 256 * 1024 * 2; S.u.b = (const char*)(ws + WS_WK) + (size_t)pn * 256 * 1024 * 2; S.u.pm = pm; S.u.pn = pn; S.u.aux = 0;
                EpiMemKV E{ws}; pg8::gemm_phase(F.lds, 1024, 1024, 1024, S, E); }
        }
        if (F.bid < 32) wg_signal(F, CW_DONE_C);
        { const int cw = CW_Q2 + 2 * (args.rep & 3); unsigned pend; queue_prime(F, cw, pend); hgrn_a_loop(F, [&]() { const int u = queue_next2(F, cw, pend); return u < 2048 ? u : -1; }); }
        wg_signal(F, CW_DONE_A);
    }
    if (IN(4)) {
        if (!(args.rep & 0x10) && (size_t)F.bid * NTHR < (size_t)8 * 8192) { wg_wait(F, CW_DONE_A, (unsigned)F.G); hgrn_b(F, (args.rep & 1) != 0); wg_signal(F, CW_DONE_B); }
        wg_wait(F, CW_DONE_C, (unsigned)(F.G < 32 ? F.G : 32));
        if (!(args.rep & 0x10)) { const bool sub = F.G == 256;
            const bool mine = sub ? (F.bid >= 128 && ((F.bid >> 3) & 1) == 0) : true;
            const int nconv = sub ? 64 : F.G, ci = sub ? (((F.bid - 128) >> 4) << 3) + (F.bid & 7) : F.bid;
            if (mine) { const int st_ = nconv * NWAVES; int it = ci * NWAVES + F.wave;
                f32x4 va[8], vb[8];
                if (it < MOE_CONV_ITEMS) moe_conv_load(F, it, va);
#pragma nounroll
                for (; it < MOE_CONV_ITEMS; it += 2 * st_) {
                    if (it + st_ < MOE_CONV_ITEMS) moe_conv_load(F, it + st_, vb);
                    moe_conv_store(F, it, va);
                    if (it + st_ >= MOE_CONV_ITEMS) break;
                    if (it + 2 * st_ < MOE_CONV_ITEMS) moe_conv_load(F, it + 2 * st_, va);
                    moe_conv_store(F, it + st_, vb);
                }
                __syncthreads(); } }
        if ((args.rep & 3) != 3) { const int bg0 = (int)(xb_xcc_id() & 3u);
            for (int kq = 0; kq < 4; ++kq) { const int bg = (bg0 + kq) & 3;
                const int cwq = CW_Q4 + 16 * (args.rep & 3) + bg; unsigned pend; queue_prime(F, cwq, pend);
                for (;;) { const int tk = queue_next2(F, cwq, pend); if (tk >= 256) break; const int c = 255 - tk; NSA_CALL } } }
        if (!(args.rep & 0x10) && (args.rep & 3) != 2) { const int cw = CW_Q4B + 16 * (args.rep & 3); wg_wait(F, CW_DONE_B, (unsigned)(F.G < 128 ? F.G : 128)); unsigned pend; queue_prime(F, cw, pend); hgrn_c_loop(F, [&]() { const int u = queue_next2(F, cw, pend); return u < 2048 ? u : -1; }); }
    } SEAM(4);
    if (IN(5)) {
        pg8::GridOrder S{(const char*)(ws + WS_RB), (const char*)(ws + WS_WOUT), (size_t)256 * 1024 * 2, (size_t)256 * 1024 * 2, 128, 4, 512, F.G, F.bid};
        EpiRes<2> E{nullptr, (const bf16_t*)(ws + WS_RA), (bf16_t*)(ws + ((args.rep & 1) ? WS_RC + 4 * MiB : WS_RA)), (float*)(ws + ((args.rep & 1) ? WS_RC : WS_STAT1)), nullptr, nullptr, nullptr, (LAS f32x2*)(F.lds + 131072)};
        pg8::gemm_phase(F.lds, 1024, 1024, 1024, S, E);
    } SEAM(5);
    if (IN(7)) {
        pg8::GridOrder S{(const char*)(ws + WS_RA), (const char*)(ws + WS_WQ), (size_t)256 * 1024 * 2, (size_t)256 * 1024 * 2, 128, 4, 512, F.G, F.bid};
        const size_t qo_off = (args.rep & 1) ? WS_RC + 8 * MiB : WS_RB;
        EpiQLn E{(bf16_t*)(ws + qo_off), (const float*)(ws + WS_STAT1), (const float*)(ws + WS_QCS), (const float*)(ws + WS_QBQ), (args.rep & 0x200) ? 1 : 0};
        pg8::gemm_phase(F.lds, 1024, 1024, 1024, S, E);
        asm volatile("s_waitcnt vmcnt(0)" ::: "memory"); __syncthreads();
        { int a0 = 0, a1 = 0, a2 = 0, a3 = 0, nun = 0; pg8::Unit u0, u1;
          if (S.next(0, u0)) { const int b = u0.pm >> 6, t0 = (u0.pm & 63) * 2; a0 = (b * 4 + u0.pn) * 128 + t0; a1 = a0 + 1; nun = 2;
              if (S.next(1, u1)) { const int b1 = u1.pm >> 6, t1 = (u1.pm & 63) * 2; a2 = (b1 * 4 + u1.pn) * 128 + t1; a3 = a2 + 1; nun = 4; } }
          if (!(args.rep & 0x2000)) xattn_phase(F, a0, a1, a2, a3, nun, qo_off); }
    } SEAM(8);
    if (IN(9)) {
        pg8::GridOrder S{(const char*)(ws + WS_RB), (const char*)(ws + WS_WO), (size_t)256 * 1024 * 2, (size_t)256 * 1024 * 2, 128, 4, 512, F.G, F.bid};
        EpiRes<1> E{nullptr, (const bf16_t*)(ws + WS_RA), (bf16_t*)(ws + ((args.rep & 1) ? WS_RC + 4 * MiB : WS_RA)), (float*)(ws + ((args.rep & 1) ? WS_RC : WS_STAT2)), (const float*)(ws + WS_STAT1), F.in[I_LN1G], F.in[I_LN1B], (LAS f32x2*)(F.lds + 131072)};
        pg8::gemm_phase(F.lds, 1024, 1024, 1024, S, E);
    } SEAM(9);
    if (IN(10)) {
        LAS unsigned* rl = (LAS unsigned*)(F.lds + LDS_MISC + 1024);
        LAS unsigned* lcnt = rl + 4 * 192; LAS unsigned* lbase = lcnt + 32;
        if (F.tid < 32) lcnt[F.tid] = 0u;
        __syncthreads();
        const bool skip = (args.rep & 0x800) != 0;
        router_phase(F, rl, lcnt, skip);
        __syncthreads();
        const unsigned xs = xb_xcc_id() & 7u;
        if (F.tid < 32) lbase[F.tid] = ((args.rep & 0x4000) ? 0u : __hip_atomic_fetch_add(F.ctl + CW_ECNT + 16 * (((args.rep & 1) * 8 + (int)xs) * 32 + F.tid), lcnt[F.tid], __ATOMIC_RELAXED, __HIP_MEMORY_SCOPE_AGENT)) | (xs << 24);
        __syncthreads();
        { int kslot = 0;
          for (int tg = gw; tg < ((skip || (args.rep & 0x4000)) ? 0 : NTOK / 16); tg += NGW, ++kslot) if (F.lane < 16) { const LAS unsigned* r = rl + 4 * (F.wave * 24 + kslot * 16 + F.lane);
              *(u32x4*)(ws + WS_ROUTE + (size_t)(tg * 16 + F.lane) * 16) = (u32x4){r[0], r[1], lbase[r[0]] + r[2], lbase[r[1]] + r[3]}; } }
        __syncthreads();
    } SEAM(10);
    if (IN(11)) {
        moe_offsets(F);
        const LAS unsigned* off = (const LAS unsigned*)(F.lds + MOE_LDS);
        const f32x4* g2 = (const f32x4*)F.in[I_LN2G] + F.lane; const f32x4* b2p = (const f32x4*)F.in[I_LN2B] + F.lane;
        f32x4 gq[4], bq4[4];
#pragma unroll
        for (int j = 0; j < 4; ++j) { gq[j] = g2[64 * j]; bq4[j] = b2p[64 * j]; }
        for (int m0 = gw; m0 < NTOK; m0 += 4 * NGW) {
            u32x4 r[4]; f32x2 wv[4], st[4]; u32x2 xw[4][4];
#pragma unroll
            for (int q = 0; q < 4; ++q) { const int m = m0 + q * NGW; if (m < NTOK) { r[q] = *(const u32x4*)(ws + WS_ROUTE + (size_t)m * 16); wv[q] = *(const f32x2*)(ws + WS_ROUTEW + (size_t)m * 8);
                st[q] = ld_stat4((const float*)(ws + WS_STAT2), (size_t)m); const u32x2* xr = (const u32x2*)((const bf16_t*)(ws + WS_RA) + (size_t)m * 1024) + F.lane;
#pragma unroll
                for (int j = 0; j < 4; ++j) xw[q][j] = xr[64 * j]; } }
#pragma unroll
            for (int q = 0; q < 4; ++q) { const int m = m0 + q * NGW; if (m < NTOK) {
                const unsigned s0 = off[r[q].x] + off[448 + (r[q].z >> 24) * 32 + r[q].x] + (r[q].z & 0xffffffu), s1 = off[r[q].y] + off[448 + (r[q].w >> 24) * 32 + r[q].y] + (r[q].w & 0xffffffu);
                const float mean = st[q][0] * (1.f / 1024.f), rstd = 1.0f / sqrtf(fmaxf(st[q][1] * (1.f / 1024.f) - mean * mean, 0.f) + 1e-5f);
                u32x2* d0 = (u32x2*)((bf16_t*)(ws + WS_XG) + (size_t)s0 * 1024); u32x2* d1 = (u32x2*)((bf16_t*)(ws + WS_XG) + (size_t)s1 * 1024);
#pragma unroll
                for (int j = 0; j < 4; ++j) { const u32x2 w = xw[q][j]; const f32x4 y = ((f32x4){bflo(w.x), bfhi(w.x), bflo(w.y), bfhi(w.y)} - mean) * rstd * gq[j] + bq4[j];
                    u32x2 o; o.x = cvtpk(y[0], y[1]); o.y = cvtpk(y[2], y[3]); NTST(d0 + F.lane + 64 * j, o); NTST(d1 + F.lane + 64 * j, o); }
                if (F.lane == 0) { *(u32x2*)(ws + WS_TOKSLOT + (size_t)m * 8) = (u32x2){s0, s1}; ((float*)(ws + WS_SLOTW))[s0] = wv[q][0]; ((float*)(ws + WS_SLOTW))[s1] = wv[q][1]; } } }
        }
    } SEAM(11);
    if (IN(12)) {
        if (!IN(11)) moe_offsets(F);
        MoeOrder S{(const char*)(ws + WS_XG), (const char*)(ws + WS_WGU), (size_t)256 * 1024 * 2, (size_t)1024 * 1024 * 2, (size_t)256 * 1024 * 2, (const LAS unsigned*)(F.lds + MOE_LDS), F.G, F.bid};
        EpiGateUp E{(bf16_t*)(ws + WS_HIDM)};
        pg8::gemm_phase(F.lds, 1024, 1024, 1024, S, E);
    } SEAM(12);
    if (IN(13)) {
        if (!IN(11) && !IN(12)) moe_offsets(F);
        MoeOrder S{(const char*)(ws + WS_HIDM), (const char*)(ws + WS_WD), (size_t)256 * 512 * 2, (size_t)1024 * 512 * 2, (size_t)256 * 512 * 2, (const LAS unsigned*)(F.lds + MOE_LDS), F.G, F.bid};
        EpiDown E{(bf16_t*)(ws + WS_XG), (const float*)(ws + WS_SLOTW)};
        pg8::gemm_phase(F.lds, 512, 512, 512, S, E);
    } SEAM(13);
    if (IN(14)) {
        const f32x4* g2 = (const f32x4*)F.in[I_LN2G] + F.lane; const f32x4* b2p = (const f32x4*)F.in[I_LN2B] + F.lane;
        const f32x4* g3 = (const f32x4*)F.in[I_LN3G] + F.lane; const f32x4* b3p = (const f32x4*)F.in[I_LN3B] + F.lane;
        u32x2 sln[2];
#pragma unroll
        for (int q = 0; q < 2; ++q) { const int m = gw + q * NGW; sln[q] = (m < NTOK) ? *(const u32x2*)(ws + WS_TOKSLOT + (size_t)m * 8) : (u32x2){0u, 0u}; }
        for (int m0 = gw; m0 < NTOK; m0 += 2 * NGW) {
            u32x2 xw[2][4], ya[2][4], yb[2][4]; f32x2 st[2];
#pragma unroll
            for (int q = 0; q < 2; ++q) { const int m = m0 + q * NGW; if (m < NTOK) { const u32x2 sl = sln[q];
                st[q] = ld_stat4((const float*)(ws + WS_STAT2), (size_t)m); const u32x2* xr = (const u32x2*)((const bf16_t*)(ws + WS_RA) + (size_t)m * 1024) + F.lane;
                const u32x2* y0 = (const u32x2*)((const bf16_t*)(ws + WS_XG) + (size_t)sl.x * 1024) + F.lane; const u32x2* y1 = (const u32x2*)((const bf16_t*)(ws + WS_XG) + (size_t)sl.y * 1024) + F.lane;
#pragma unroll
                for (int j = 0; j < 4; ++j) { xw[q][j] = xr[64 * j]; ya[q][j] = y0[64 * j]; yb[q][j] = y1[64 * j]; } } }
#pragma unroll
            for (int q = 0; q < 2; ++q) { const int mn = m0 + 2 * NGW + q * NGW; if (mn < NTOK) sln[q] = *(const u32x2*)(ws + WS_TOKSLOT + (size_t)mn * 8); }
            f32x4 v[2][4];
#pragma unroll
            for (int q = 0; q < 2; ++q) { const float mean = st[q][0] * (1.f / 1024.f), rstd = 1.0f / sqrtf(fmaxf(st[q][1] * (1.f / 1024.f) - mean * mean, 0.f) + 1e-5f);
#pragma unroll
                for (int j = 0; j < 4; ++j) { const u32x2 w = xw[q][j], a = ya[q][j], b2 = yb[q][j]; const f32x4 x = ((f32x4){bflo(w.x), bfhi(w.x), bflo(w.y), bfhi(w.y)} - mean) * rstd * g2[64 * j] + b2p[64 * j];
                    v[q][j] = x * ALPHA + (f32x4){bflo(a.x) + bflo(b2.x), bfhi(a.x) + bfhi(b2.x), bflo(a.y) + bflo(b2.y), bfhi(a.y) + bfhi(b2.y)}; } }
            float s[2], s2[2], mean3[2], rstd3[2];
#pragma unroll
            for (int q = 0; q < 2; ++q) { s[q] = 0.f;
#pragma unroll
                for (int j = 0; j < 4; ++j) s[q] += (v[q][j][0] + v[q][j][1]) + (v[q][j][2] + v[q][j][3]); }
#pragma unroll
            for (int o = 1; o < 64; o <<= 1) { s[0] += __shfl_xor(s[0], o); s[1] += __shfl_xor(s[1], o); }
#pragma unroll
            for (int q = 0; q < 2; ++q) { mean3[q] = s[q] * (1.f / 1024.f); s2[q] = 0.f;
#pragma unroll
                for (int j = 0; j < 4; ++j) { v[q][j] = v[q][j] - mean3[q]; s2[q] += (v[q][j][0] * v[q][j][0] + v[q][j][1] * v[q][j][1]) + (v[q][j][2] * v[q][j][2] + v[q][j][3] * v[q][j][3]); } }
#pragma unroll
            for (int o = 1; o < 64; o <<= 1) { s2[0] += __shfl_xor(s2[0], o); s2[1] += __shfl_xor(s2[1], o); }
#pragma unroll
            for (int q = 0; q < 2; ++q) { const int m = m0 + q * NGW; rstd3[q] = 1.0f / sqrtf(s2[q] * (1.f / 1024.f) + 1e-5f);
                if (m < NTOK) {
#pragma unroll
                    for (int j = 0; j < 4; ++j) NTST((f32x4*)(F.out + (size_t)m * 1024) + F.lane + 64 * j, v[q][j] * rstd3[q] * g3[64 * j] + b3p[64 * j]); } }
        }
    }
#ifdef PROBE_SYNCS
    if (hi == N_PHASES_) { for (int i = 0; i < PROBE_SYNCS; ++i) xcd_barrier(xbar); }
#endif
#undef IN
#undef SEAM
}

#ifndef MK_N_LAUNCHES
#define MK_N_LAUNCHES 1
#endif
constexpr int N_PHASES = 15;
extern "C" void kernel_launch(void* const* d_in, const int* in_sizes, int n_in, void* d_out, int out_size, void* d_ws, size_t ws_size, hipStream_t stream) {
    static int grid = 0;
    if (grid == 0) {
        if (n_in != 30 || ws_size < WS_TOTAL) { fprintf(stderr, "kernel_launch: unexpected n_in %d / ws %zu\n", n_in, ws_size); grid = -1; return; }
        int dev = 0, cus = 0, per_cu = 0;
        (void)hipGetDevice(&dev); (void)hipDeviceGetAttribute(&cus, hipDeviceAttributeMultiprocessorCount, dev);
        (void)hipFuncSetAttribute((const void*)mk_fwd, hipFuncAttributeMaxDynamicSharedMemorySize, LDS_BYTES);
        (void)hipOccupancyMaxActiveBlocksPerMultiprocessor(&per_cu, (const void*)mk_fwd, NTHR, LDS_BYTES);
        if (per_cu < 1) { fprintf(stderr, "kernel_launch: occupancy query says %d blocks per CU\n", per_cu); per_cu = 1; }
        grid = cus * per_cu;
    }
    if (grid < 0) return;
    (void)hipMemsetAsync((char*)d_ws + WS_CTL, 0, 128 * 1024, stream);
    Args a{};
    for (int i = 0; i < 30; ++i) a.in[i] = (const float*)d_in[i];
    a.out = (float*)d_out; a.ws = (unsigned char*)d_ws;
#ifdef PROBE_PHASE
#ifndef PROBE_LO
#define PROBE_LO PROBE_PHASE
#endif
#ifndef PROBE_REP
#define PROBE_REP 1
#endif
    const int seq[3][3] = {{0, PROBE_PHASE + 1, 0}, {PROBE_LO, PROBE_PHASE + 1, PROBE_REP}, {PROBE_PHASE + 1, N_PHASES, 0}};
    const int nl = (PROBE_PHASE + 1 < N_PHASES) ? 3 : 2;
#else
    const int seq[1][3] = {{0, N_PHASES, 0}};
    const int nl = 1;
#endif
    for (int li = 0; li < nl; ++li) {
        a.ph_lo = seq[li][0]; a.ph_hi = seq[li][1]; a.rep = seq[li][2]; a.li = li;
        void* kargs[] = {&a};
        hipError_t e = hipLaunchCooperativeKernel((const void*)mk_fwd, dim3(grid), dim3(NTHR), kargs, LDS_BYTES, stream);
        if (e != hipSuccess) { fprintf(stderr, "kernel_launch: cooperative launch failed: %s (grid %d)\n", hipGetErrorString(e), grid); break; }
    }
}
```
